# Optimizing an MI355X kernel written in HIP

```python
import jax
import jax.numpy as jnp
from jax import lax
import numpy as np

D_MODEL = 2048
BATCH = 8
SEQ = 2048
DEPTH = 4
DEC_BATCH = 8
DEC_SEQ = 4096
PAST_LEN = 128

N_MIXERS = 3
N_MLA_LAYERS = (DEPTH + 2) // N_MIXERS
N_HGRN_LAYERS = (DEPTH + 1) // N_MIXERS
N_FNET_LAYERS = DEPTH // N_MIXERS

MLA_HEADS = 16
Q_LORA_RANK = 512
KV_LORA_RANK = 512
QK_NOPE_DIM = 128
QK_ROPE_DIM = 64
QK_HEAD_DIM = QK_NOPE_DIM + QK_ROPE_DIM
V_HEAD_DIM = 128
ROPE_THETA = 10000.0
Q_BLOCK = 128

HGRN_HEADS = 16
HGRN_KEY_DIM = 128
HGRN_VAL_DIM = D_MODEL // HGRN_HEADS
HGRN_KEY_WIDTH = HGRN_HEADS * HGRN_KEY_DIM
HGRN_CHUNK = 64

FNET_GROUPS = 4
FNET_GROUP_DIM = D_MODEL // FNET_GROUPS

MEM_TOKENS = 256
MEM_HEADS = 4
MEM_HEAD_DIM = 128

D_FF = 4 * D_MODEL
EPS = 1e-6

kernel_name = 'hybrid_mla_hgrn2_fnet_encoder'


def rms_norm(x, g):
    xf = x.astype(jnp.float32)
    y = xf * lax.rsqrt(jnp.mean(xf * xf, axis=-1, keepdims=True) + EPS)
    return (y * g.astype(jnp.float32)).astype(x.dtype)


def rope_cos_sin(length, dim):
    inv = 1.0 / (ROPE_THETA ** (jnp.arange(0, dim, 2, dtype=jnp.float32) / dim))
    ang = jnp.arange(length, dtype=jnp.float32)[:, None] * inv[None, :]
    return jnp.cos(ang), jnp.sin(ang)


def apply_rope(x, cos, sin):
    half = x.shape[-1] // 2
    xf = x.astype(jnp.float32)
    x1, x2 = xf[..., :half], xf[..., half:]
    c = cos[None, :, None, :]
    s = sin[None, :, None, :]
    return jnp.concatenate([x1 * c - x2 * s, x1 * s + x2 * c], axis=-1).astype(x.dtype)


def dense_bidirectional_attention(q, k, v, scale):
    B, L, H, Dk = q.shape
    nb = L // Q_BLOCK
    qb = q.reshape(B, nb, Q_BLOCK, H, Dk).transpose(1, 0, 2, 3, 4)

    def one_block(qi):
        s = jnp.einsum('bqhd,bkhd->bhqk', qi, k, preferred_element_type=jnp.float32) * scale
        p = jax.nn.softmax(s, axis=-1)
        return jnp.einsum('bhqk,bkhd->bqhd', p.astype(v.dtype), v)

    o = lax.map(one_block, qb)
    return o.transpose(1, 0, 2, 3, 4).reshape(B, L, H, v.shape[-1])


def mla_mixer(h, w_in, q_a_g, kv_a_g, w_q_b, w_kv_b, q_n_g, k_n_g, w_o):
    B, L, _ = h.shape
    proj = h @ w_in
    q_lat, kv_lat, k_rope = jnp.split(proj, [Q_LORA_RANK, Q_LORA_RANK + KV_LORA_RANK], axis=-1)
    q = (rms_norm(q_lat, q_a_g) @ w_q_b).reshape(B, L, MLA_HEADS, QK_HEAD_DIM)
    kv = (rms_norm(kv_lat, kv_a_g) @ w_kv_b).reshape(B, L, MLA_HEADS, QK_NOPE_DIM + V_HEAD_DIM)
    k_nope, v = jnp.split(kv, [QK_NOPE_DIM], axis=-1)
    k_rope = jnp.broadcast_to(k_rope[:, :, None, :], (B, L, MLA_HEADS, QK_ROPE_DIM))
    k = jnp.concatenate([k_nope, k_rope], axis=-1)
    q = rms_norm(q, q_n_g)
    k = rms_norm(k, k_n_g)
    cos, sin = rope_cos_sin(L, QK_ROPE_DIM)
    q = jnp.concatenate([q[..., :QK_NOPE_DIM], apply_rope(q[..., QK_NOPE_DIM:], cos, sin)], axis=-1)
    k = jnp.concatenate([k[..., :QK_NOPE_DIM], apply_rope(k[..., QK_NOPE_DIM:], cos, sin)], axis=-1)
    o = dense_bidirectional_attention(q, k, v, QK_HEAD_DIM ** -0.5)
    return o.reshape(B, L, MLA_HEADS * V_HEAD_DIM) @ w_o


def chunk_gated_scan(q, k, v, log_f):
    B, L, H, K = q.shape
    V = v.shape[-1]
    C = HGRN_CHUNK
    nc = L // C

    def to_chunks(a):
        return a.reshape(B, nc, C, H, a.shape[-1]).transpose(1, 0, 3, 2, 4)

    mask = jnp.tril(jnp.ones((C, C), dtype=bool))[None, None, :, :, None]

    def step(S, inp):
        qi, ki, vi, gi = inp
        b = jnp.cumsum(gi, axis=2)
        diff = b[:, :, :, None, :] - b[:, :, None, :, :]
        decay = jnp.exp(jnp.where(mask, diff, -jnp.inf))
        att = jnp.einsum('bhtk,bhsk,bhtsk->bhts', qi, ki, decay)
        o_intra = jnp.einsum('bhts,bhsv->bhtv', att, vi)
        o_inter = jnp.einsum('bhtk,bhkv->bhtv', qi * jnp.exp(b), S)
        b_last = b[:, :, -1:, :]
        S_new = jnp.exp(b_last)[:, :, 0, :, None] * S + jnp.einsum('bhsk,bhsv->bhkv', ki * jnp.exp(b_last - b), vi)
        return S_new, o_intra + o_inter

    S0 = jnp.zeros((B, H, K, V), jnp.float32)
    _, o = lax.scan(step, S0, (to_chunks(q), to_chunks(k), to_chunks(v), to_chunks(log_f)))
    return o.transpose(1, 0, 3, 2, 4).reshape(B, L, H, V)


def forget_gate(f_logits, lb):
    z = f_logits.astype(jnp.float32)
    log_f = jnp.logaddexp(jnp.log(lb), jnp.log1p(-lb) + jax.nn.log_sigmoid(z))
    k = (1.0 - lb) * jax.nn.sigmoid(-z)
    return log_f, k


def hgrn2_mixer(h, w_in, lb_fwd, lb_bwd, o_norm_g, w_o):
    B, L, _ = h.shape
    kw = HGRN_KEY_WIDTH
    q, f_fw, f_bw, i_in, g = jnp.split(h @ w_in, [kw, 2 * kw, 3 * kw, 3 * kw + D_MODEL], axis=-1)

    def heads(a):
        return a.reshape(B, L, HGRN_HEADS, -1)

    def flip(a):
        return jnp.flip(a, axis=1)

    q = heads(q.astype(jnp.float32))
    v = heads(i_in.astype(jnp.float32))
    lf_f, k_f = forget_gate(f_fw, lb_fwd)
    lf_b, k_b = forget_gate(f_bw, lb_bwd)
    o_fwd = chunk_gated_scan(q, heads(k_f), v, heads(lf_f))
    o_bwd = flip(chunk_gated_scan(flip(q), flip(heads(k_b)), flip(v), flip(heads(lf_b))))
    o = rms_norm(o_fwd + o_bwd, o_norm_g) * jax.nn.silu(heads(g.astype(jnp.float32)))
    return o.reshape(B, L, D_MODEL).astype(h.dtype) @ w_o


def fourier_mixer(h, w_o):
    B, L, _ = h.shape
    hg = h.astype(jnp.float32).reshape(B, L, FNET_GROUPS, FNET_GROUP_DIM)
    mixed = jnp.fft.fftn(hg, axes=(1, 3), norm='ortho').real
    return mixed.reshape(B, L, D_MODEL).astype(h.dtype) @ w_o


def memory_cross_attention(h, m, w_q, w_kv, q_g, k_g, w_o):
    B, L, _ = h.shape
    M = m.shape[1]
    q = rms_norm((h @ w_q).reshape(B, L, MEM_HEADS, MEM_HEAD_DIM), q_g)
    k, v = jnp.split(m @ w_kv, 2, axis=-1)
    k = rms_norm(k.reshape(B, M, MEM_HEADS, MEM_HEAD_DIM), k_g)
    v = v.reshape(B, M, MEM_HEADS, MEM_HEAD_DIM)
    s = jnp.einsum('bqhd,bkhd->bhqk', q, k, preferred_element_type=jnp.float32) * (MEM_HEAD_DIM ** -0.5)
    p = jax.nn.softmax(s, axis=-1)
    o = jnp.einsum('bhqk,bkhd->bqhd', p.astype(v.dtype), v)
    return o.reshape(B, L, MEM_HEADS * MEM_HEAD_DIM) @ w_o


def squared_relu_mlp(h, w1, w2):
    return jnp.square(jax.nn.relu(h @ w1)) @ w2


def run_trunk(x, mem, p):
    lb_all = jnp.cumsum(jax.nn.softmax(p['hgrn_lb_logits'].astype(jnp.float32), axis=0), axis=0)
    lb_all = lb_all - lb_all[:1]
    for i in range(DEPTH):
        kind = i % N_MIXERS
        j = i // N_MIXERS
        h = rms_norm(x, p['norm_mix_g'][i])
        if kind == 0:
            y = mla_mixer(h, p['mla_w_in'][j], p['mla_q_a_norm_g'][j], p['mla_kv_a_norm_g'][j],
                          p['mla_w_q_b'][j], p['mla_w_kv_b'][j], p['mla_q_norm_g'][j],
                          p['mla_k_norm_g'][j], p['mla_w_o'][j])
        elif kind == 1:
            y = hgrn2_mixer(h, p['hgrn_w_in'][j], lb_all[i, 0], lb_all[i, 1],
                            p['hgrn_o_norm_g'][j], p['hgrn_w_o'][j])
        else:
            y = fourier_mixer(h, p['fnet_w_o'][j])
        x = x + y
        x = x + memory_cross_attention(rms_norm(x, p['norm_xq_g'][i]), rms_norm(mem, p['norm_mem_g'][i]),
                                       p['mem_w_q'][i], p['mem_w_kv'][i], p['mem_q_norm_g'][i],
                                       p['mem_k_norm_g'][i], p['mem_w_o'][i])
        x = x + squared_relu_mlp(rms_norm(x, p['norm_mlp_g'][i]), p['mlp_w1'][i], p['mlp_w2'][i])
    return x


def setup_inputs(seed: int = 0) -> dict:
    key = jax.random.key(seed)
    ks = iter(jax.random.split(key, 48))

    def w(shape):
        return jax.random.normal(next(ks), shape, jnp.float32) * (shape[-2] ** -0.5)

    def gain(shape):
        return 1.0 + 0.02 * jax.random.normal(next(ks), shape, jnp.float32)

    def act(shape):
        return jax.random.normal(next(ks), shape, jnp.float32)

    na, nb, nf = N_MLA_LAYERS, N_HGRN_LAYERS, N_FNET_LAYERS
    return {
        'x_prompt': act((BATCH, SEQ, D_MODEL)),
        'x_sample': act((DEC_BATCH, DEC_SEQ, D_MODEL)),
        'mem_prompt': act((BATCH, MEM_TOKENS, D_MODEL)),
        'mem_sample': act((DEC_BATCH, MEM_TOKENS, D_MODEL)),
        'norm_mix_g': gain((DEPTH, D_MODEL)),
        'mla_w_in': w((na, D_MODEL, Q_LORA_RANK + KV_LORA_RANK + QK_ROPE_DIM)),
        'mla_q_a_norm_g': gain((na, Q_LORA_RANK)),
        'mla_kv_a_norm_g': gain((na, KV_LORA_RANK)),
        'mla_w_q_b': w((na, Q_LORA_RANK, MLA_HEADS * QK_HEAD_DIM)),
        'mla_w_kv_b': w((na, KV_LORA_RANK, MLA_HEADS * (QK_NOPE_DIM + V_HEAD_DIM))),
        'mla_q_norm_g': gain((na, QK_HEAD_DIM)),
        'mla_k_norm_g': gain((na, QK_HEAD_DIM)),
        'mla_w_o': w((na, MLA_HEADS * V_HEAD_DIM, D_MODEL)),
        'hgrn_w_in': w((nb, D_MODEL, 3 * HGRN_KEY_WIDTH + 2 * D_MODEL)),
        'hgrn_lb_logits': jax.random.normal(next(ks), (DEPTH, 2, HGRN_KEY_WIDTH), jnp.float32),
        'hgrn_o_norm_g': gain((nb, HGRN_VAL_DIM)),
        'hgrn_w_o': w((nb, D_MODEL, D_MODEL)),
        'fnet_w_o': w((nf, D_MODEL, D_MODEL)),
        'norm_xq_g': gain((DEPTH, D_MODEL)),
        'norm_mem_g': gain((DEPTH, D_MODEL)),
        'mem_w_q': w((DEPTH, D_MODEL, MEM_HEADS * MEM_HEAD_DIM)),
        'mem_w_kv': w((DEPTH, D_MODEL, 2 * MEM_HEADS * MEM_HEAD_DIM)),
        'mem_q_norm_g': gain((DEPTH, MEM_HEAD_DIM)),
        'mem_k_norm_g': gain((DEPTH, MEM_HEAD_DIM)),
        'mem_w_o': w((DEPTH, MEM_HEADS * MEM_HEAD_DIM, D_MODEL)),
        'norm_mlp_g': gain((DEPTH, D_MODEL)),
        'mlp_w1': w((DEPTH, D_MODEL, D_FF)),
        'mlp_w2': w((DEPTH, D_FF, D_MODEL)),
    }


def reference(x_prompt, x_sample, mem_prompt, mem_sample, norm_mix_g, mla_w_in, mla_q_a_norm_g,
              mla_kv_a_norm_g, mla_w_q_b, mla_w_kv_b, mla_q_norm_g, mla_k_norm_g, mla_w_o,
              hgrn_w_in, hgrn_lb_logits, hgrn_o_norm_g, hgrn_w_o, fnet_w_o, norm_xq_g, norm_mem_g,
              mem_w_q, mem_w_kv, mem_q_norm_g, mem_k_norm_g, mem_w_o, norm_mlp_g, mlp_w1, mlp_w2):
    p = dict(norm_mix_g=norm_mix_g, mla_w_in=mla_w_in, mla_q_a_norm_g=mla_q_a_norm_g,
             mla_kv_a_norm_g=mla_kv_a_norm_g, mla_w_q_b=mla_w_q_b, mla_w_kv_b=mla_w_kv_b,
             mla_q_norm_g=mla_q_norm_g, mla_k_norm_g=mla_k_norm_g, mla_w_o=mla_w_o,
             hgrn_w_in=hgrn_w_in, hgrn_lb_logits=hgrn_lb_logits, hgrn_o_norm_g=hgrn_o_norm_g,
             hgrn_w_o=hgrn_w_o, fnet_w_o=fnet_w_o, norm_xq_g=norm_xq_g, norm_mem_g=norm_mem_g,
             mem_w_q=mem_w_q, mem_w_kv=mem_w_kv, mem_q_norm_g=mem_q_norm_g,
             mem_k_norm_g=mem_k_norm_g, mem_w_o=mem_w_o, norm_mlp_g=norm_mlp_g,
             mlp_w1=mlp_w1, mlp_w2=mlp_w2)
    y_prompt = run_trunk(x_prompt, mem_prompt, p)
    y_sample = run_trunk(x_sample, mem_sample, p)
    return (y_prompt, y_sample)
```

```cpp
#include <hip/hip_runtime.h>
#include <cstdio>
#include <cstdint>

#ifndef PHMASK
#define PHMASK 0xFFFFFFFFFFFFFFFFull
#endif
#ifndef REPMASK
#define REPMASK 0x0ull
#endif
#ifndef N_LAUNCH_MODE
#define N_LAUNCH_MODE 0
#endif

#define LAS __attribute__((address_space(3)))
#define GAS __attribute__((address_space(1)))
typedef unsigned short bf16;
typedef short bf16x8 __attribute__((ext_vector_type(8)));
typedef short s16x4 __attribute__((ext_vector_type(4)));
typedef float f32x4 __attribute__((ext_vector_type(4)));
typedef float f32x2 __attribute__((ext_vector_type(2)));
typedef float f32x16 __attribute__((ext_vector_type(16)));
typedef unsigned u32x4 __attribute__((ext_vector_type(4)));
typedef unsigned u32x2 __attribute__((ext_vector_type(2)));

constexpr int D = 2048, T = 49152, TPR = 16384, CH = 16384, DFF = 8192, NWAVES = 8;
constexpr float EPS = 1e-6f;
__host__ __device__ __forceinline__ int seq_row0(int s) { return s < 8 ? s * 2048 : 16384 + (s - 8) * 4096; }
__host__ __device__ __forceinline__ int seq_len(int s) { return s < 8 ? 2048 : 4096; }

constexpr size_t MiB = 1u << 20;
constexpr size_t WS_CTL = 0, CTL_BYTES = 4 * MiB;
constexpr size_t WS_SS0 = 1 * MiB, WS_RSTD = 2 * MiB;
constexpr size_t WS_ROPE = 4 * MiB;
constexpr size_t WS_MEMRS = 5 * MiB;
constexpr size_t WS_MLA_WIN = 6 * MiB, WS_MLA_WQB = 16 * MiB, WS_MLA_WKVB = 22 * MiB, WS_MLA_WO = 32 * MiB;
constexpr size_t WS_HG_WIN = 48 * MiB, WS_HG_WO = 88 * MiB, WS_FN_WO = 96 * MiB;
constexpr size_t WS_MEM_WQ = 104 * MiB, WS_MEM_WKV = 112 * MiB, WS_MEM_WO = 128 * MiB;
constexpr size_t WS_W1 = 136 * MiB, WS_W2 = 168 * MiB;
constexpr size_t WS_DC = 200 * MiB, WS_DL2 = 204 * MiB, WS_DL4 = 220 * MiB;
constexpr size_t WS_MEMB = 284 * MiB, WS_MEMKV = 300 * MiB;
constexpr size_t WS_H = 332 * MiB;
constexpr size_t WS_S = 524 * MiB;
constexpr size_t WS_SSP = 1036 * MiB;
constexpr size_t WS_END = 1044 * MiB;
constexpr size_t S_P = WS_S, S_QC = WS_S + 120 * MiB, S_KVC = WS_S + 216 * MiB;
constexpr size_t S_Z = WS_S, S_OF = WS_S + 320 * MiB, S_OB = WS_S + 384 * MiB;
constexpr size_t S_HE = WS_S, S_HO = WS_S + 96 * MiB, S_T1 = WS_S + 192 * MiB;
constexpr size_t WS_XCMID = WS_MEMRS + 65536;
constexpr size_t S_QM = WS_S, S_OM = WS_S + 48 * MiB;
constexpr size_t S_HID = WS_S;
constexpr int CW_TMO = 0, CW_BAR = 4096;

typedef __bf16 bf16x2_t __attribute__((ext_vector_type(2)));
__device__ __forceinline__ unsigned cvt_pk_bf16(float lo, float hi) { const f32x2 f = {lo, hi}; const bf16x2_t v = __builtin_convertvector(f, bf16x2_t); return __builtin_bit_cast(unsigned, v); }
__device__ __forceinline__ float bf2f(unsigned short b) { return __uint_as_float(((unsigned)b) << 16); }
__device__ __forceinline__ float bflo(unsigned w) { return __uint_as_float(w << 16); }
__device__ __forceinline__ float bfhi(unsigned w) { return __uint_as_float(w & 0xffff0000u); }
__device__ __forceinline__ float shx(float v, int m, int lane) { return __int_as_float(__builtin_amdgcn_ds_bpermute((lane ^ m) << 2, __float_as_int(v))); }
__device__ __forceinline__ float shl_(float v, int src) { return __int_as_float(__builtin_amdgcn_ds_bpermute(src << 2, __float_as_int(v))); }
__device__ __forceinline__ float wave_sum(float v, int lane) {
#pragma unroll
    for (int o = 1; o < 64; o <<= 1) v += shx(v, o, lane);
    return v;
}
__device__ __forceinline__ int opaque_tid() { int t = threadIdx.x; asm volatile("" : "+v"(t)); return t; }
__device__ __forceinline__ const float* in_ptr(int i) {
    const __attribute__((address_space(4))) char* ka = (const __attribute__((address_space(4))) char*)__builtin_amdgcn_kernarg_segment_ptr();
    int off = i * 8; asm volatile("" : "+s"(off));
    const float* p = *(const float* const __attribute__((address_space(4)))*)(ka + off);
    return (const float*)(const __attribute__((address_space(1))) float*)p;
}
__device__ __forceinline__ size_t LO(size_t v) { asm volatile("" : "+s"(v)); return v; }
__device__ __forceinline__ int launder_i(int v) { asm volatile("" : "+s"(v)); return v; }
__device__ __forceinline__ unsigned char* launder_p(unsigned char* p) { unsigned z = 0u; asm volatile("" : "+s"(z)); return p + z; }
#define LDS_WAIT() asm volatile("s_waitcnt lgkmcnt(0)" ::: "memory")
#define VM_WAIT() asm volatile("s_waitcnt vmcnt(0)" ::: "memory")

namespace pg8 {
constexpr int BM = 256, BK = 64, HALF = 128, HTB = HALF * BK * 2, STAGE_BYTES = 8 * HTB, NXCD = 8;
__host__ __device__ __forceinline__ int lds_byte(int r, int c) { const int st = (r >> 4) * 2 + (c >> 5), rr = r & 15, cc = c & 31, ob = rr * 64 + cc * 2; return st * 1024 + (ob ^ (((ob >> 9) & 1) << 5)); }
__host__ __device__ __forceinline__ void stage_rc(int b, int& R, int& C) { const int st = b / 1024, sb = b % 1024, swz = sb ^ (((sb >> 9) & 1) << 5); R = (st >> 1) * 16 + swz / 64; C = (st & 1) * 32 + (swz % 64) / 2; }
__host__ __device__ __forceinline__ int perm32(int rho) { const int n = rho >> 4, i = rho & 15; return 8 * (i >> 2) + 4 * n + (i & 3); }

struct Unit { int pm, pn; const char* a; const char* b; long ooff; long aoff; int roff; };

struct TileOrder {
    const char* A; const char* B; int lda, ldb, nM, nN, nwg, G, c, pm0, WGM;
    __device__ __forceinline__ void init(const void* A_, int lda_, const void* B_, int ldb_, int pm0_, int nM_, int nN_, int G_, int c_, int wgm_ = 4) {
        A = (const char*)A_; B = (const char*)B_; lda = lda_; ldb = ldb_; pm0 = pm0_; nM = nM_; nN = nN_; nwg = nM_ * nN_; G = G_; c = c_; WGM = wgm_; }
    __device__ __forceinline__ bool next(int i, Unit& u) const {
        const long L = (long)i * G + c; if (L >= nwg) return false;
        int wgid = (int)L; { const int q = nwg / NXCD, r = nwg % NXCD, xcd = wgid % NXCD, off = wgid / NXCD; wgid = (xcd < r ? xcd * (q + 1) : r * (q + 1) + (xcd - r) * q) + off; }
        const int nig = WGM * nN, gid = wgid / nig, fm = gid * WGM, gsz = (nM - fm) < WGM ? (nM - fm) : WGM;
        u.pm = pm0 + fm + ((wgid % nig) % gsz); u.pn = (wgid % nig) / gsz;
        u.a = A + (size_t)u.pm * 256 * lda * 2; u.b = B + (size_t)u.pn * 256 * ldb * 2; u.ooff = 0; u.aoff = 0; u.roff = 0; return true;
    }
};

template <int RS  , int ACT  > struct EpiBf16 {
    static constexpr bool PERM = true;
    bf16* O; int ldc; const float* rs; int rsw; float cs;
    __device__ __forceinline__ void operator()(const f32x4 (&acc)[2][2][4][2], const Unit& u, int wr, int wc, int fr, int fq) const {
        const int row0 = u.pm * BM + wr * 64 + fr, col0 = u.pn * BM + wc * 32 + 8 * fq;
#pragma unroll
        for (int ai = 0; ai < 2; ++ai)
#pragma unroll
            for (int m = 0; m < 4; ++m) { const int row = row0 + ai * HALF + m * 16; float s = cs;
                if (RS == 1) s *= rs[row];
                if (RS == 2) s *= rsqrtf(rs[2 * row + rsw] * (1.0f / 512.0f) + EPS);
                bf16* rowp = O + u.ooff + (size_t)row * ldc + col0;
#pragma unroll
                for (int bj = 0; bj < 2; ++bj) { f32x4 v0 = acc[ai][bj][m][0] * s, v1 = acc[ai][bj][m][1] * s;
                    if (RS == 4) { const f32x4 c0 = *(const f32x4*)(rs + u.roff + col0 + bj * HALF), c1 = *(const f32x4*)(rs + u.roff + col0 + bj * HALF + 4); v0 = v0 * c0; v1 = v1 * c1; }
                    if (RS == 5) { const f32x4 c0 = *(const f32x4*)(rs + u.roff + col0 + bj * HALF), c1 = *(const f32x4*)(rs + u.roff + col0 + bj * HALF + 4); const float sg = (row & 1) ? -s : s; v0 = v0 + c0 * sg; v1 = v1 + c1 * sg; }
                    if (ACT == 1) {
#pragma unroll
                        for (int j = 0; j < 4; ++j) { const float a = fmaxf(v0[j], 0.f), b = fmaxf(v1[j], 0.f); v0[j] = a * a; v1[j] = b * b; } }
                    u32x4 w; w.x = cvt_pk_bf16(v0[0], v0[1]); w.y = cvt_pk_bf16(v0[2], v0[3]); w.z = cvt_pk_bf16(v1[0], v1[1]); w.w = cvt_pk_bf16(v1[2], v1[3]);
                    *(u32x4*)(rowp + bj * HALF) = w; } }
    }
};
template <bool FINAL> struct EpiResid {
    static constexpr bool PERM = true;
    bf16* Xb; float* ssp; float* out;
    __device__ __forceinline__ void operator()(const f32x4 (&acc)[2][2][4][2], const Unit& u, int wr, int wc, int fr, int fq) const {
        const int row0 = u.pm * BM + wr * 64 + fr, col0 = u.pn * BM + wc * 32 + 8 * fq, lane_ = fq * 16 + fr;
        u32x4 o[2][4][2];
#pragma unroll
        for (int ai = 0; ai < 2; ++ai)
#pragma unroll
            for (int m = 0; m < 4; ++m)
#pragma unroll
                for (int bj = 0; bj < 2; ++bj) o[ai][m][bj] = *(const u32x4*)(Xb + (size_t)(row0 + ai * HALF + m * 16) * D + col0 + bj * HALF);
#pragma unroll
        for (int ai = 0; ai < 2; ++ai) {
#pragma unroll
            for (int m = 0; m < 4; ++m) { const int row = row0 + ai * HALF + m * 16; bf16* xp = Xb + (size_t)row * D + col0; float q = 0.f;
#pragma unroll
                for (int bj = 0; bj < 2; ++bj) { const u32x4 ov = o[ai][m][bj];
                    f32x4 v0 = acc[ai][bj][m][0], v1 = acc[ai][bj][m][1];
                    v0[0] += bflo(ov[0]); v0[1] += bfhi(ov[0]); v0[2] += bflo(ov[1]); v0[3] += bfhi(ov[1]); v1[0] += bflo(ov[2]); v1[1] += bfhi(ov[2]); v1[2] += bflo(ov[3]); v1[3] += bfhi(ov[3]);
                    if (FINAL) { float* op = out + (size_t)row * D + col0 + bj * HALF; *(f32x4*)op = v0; *(f32x4*)(op + 4) = v1; }
                    else { u32x4 w; w.x = cvt_pk_bf16(v0[0], v0[1]); w.y = cvt_pk_bf16(v0[2], v0[3]); w.z = cvt_pk_bf16(v1[0], v1[1]); w.w = cvt_pk_bf16(v1[2], v1[3]);
                        *(u32x4*)(xp + bj * HALF) = w;
#pragma unroll
                        for (int j = 0; j < 4; ++j) { const float a = bflo(w[j]), b = bfhi(w[j]); q += a * a + b * b; } } }
                if (!FINAL) { q += shx(q, 16, lane_); q += shx(q, 32, lane_); if (fq == 0) ssp[(size_t)row * 32 + u.pn * 4 + wc] = q; } }
            asm volatile("" ::: "memory"); }
    }
};

struct EpiFnetSym {
    static constexpr bool PERM = true;
    bf16* Y; const bf16* Ab; const float* xcm; int L; float cs;
    __device__ __forceinline__ void operator()(const f32x4 (&acc)[2][2][4][2], const Unit& u, int wr, int wc, int fr, int fq) const {
        const int row0 = u.pm * BM + wr * 64 + fr, col0 = u.pn * BM + wc * 32 + 8 * fq;
        f32x4 b0[2], b1[2];
#pragma unroll
        for (int bj = 0; bj < 2; ++bj) { b0[bj] = *(const f32x4*)(xcm + u.roff + col0 + bj * HALF); b1[bj] = *(const f32x4*)(xcm + u.roff + col0 + bj * HALF + 4); }
#pragma unroll
        for (int ai = 0; ai < 2; ++ai)
#pragma unroll
            for (int m = 0; m < 4; ++m) { const int row = row0 + ai * HALF + m * 16; const float sg = (row & 1) ? -1.f : 1.f;
                const bf16* ap = Ab + u.aoff + (size_t)row * 512 + col0;
                bf16* y1 = Y + u.ooff + (size_t)row * D + col0; bf16* y2 = Y + u.ooff + (size_t)(L - row) * D + col0;
#pragma unroll
                for (int bj = 0; bj < 2; ++bj) { const u32x4 a = *(const u32x4*)(ap + bj * HALF);
                    f32x4 a0 = {bflo(a[0]), bfhi(a[0]), bflo(a[1]), bfhi(a[1])}, a1 = {bflo(a[2]), bfhi(a[2]), bflo(a[3]), bfhi(a[3])};
                    a0 = a0 + b0[bj] * sg; a1 = a1 + b1[bj] * sg;
                    const f32x4 p0 = (a0 + acc[ai][bj][m][0]) * cs, p1 = (a1 + acc[ai][bj][m][1]) * cs, q0 = (a0 - acc[ai][bj][m][0]) * cs, q1 = (a1 - acc[ai][bj][m][1]) * cs;
                    u32x4 w; w.x = cvt_pk_bf16(p0[0], p0[1]); w.y = cvt_pk_bf16(p0[2], p0[3]); w.z = cvt_pk_bf16(p1[0], p1[1]); w.w = cvt_pk_bf16(p1[2], p1[3]);
                    *(u32x4*)(y1 + bj * HALF) = w;
                    if (row > 0) { u32x4 v; v.x = cvt_pk_bf16(q0[0], q0[1]); v.y = cvt_pk_bf16(q0[2], q0[3]); v.z = cvt_pk_bf16(q1[0], q1[1]); v.w = cvt_pk_bf16(q1[2], q1[3]);
                        *(u32x4*)(y2 + bj * HALF) = v; } } }
    }
};

template <class Epi, class Sched>
__device__ __forceinline__ void gemm_phase(LAS unsigned char* lds, const int K, const int lda, const int ldb, const Sched& S, const Epi& E) {
    const int tid = opaque_tid(), wid = __builtin_amdgcn_readfirstlane(tid >> 6), lane = tid & 63, wr = wid >> 2, wc = wid & 3, fr = lane & 15, fq = lane >> 4;
    const int nt = K / BK;
    unsigned voffA[2], voffB[2];
#pragma unroll
    for (int i = 0; i < 2; ++i) { int R, C; stage_rc(tid * 16 + i * 8192, R, C); const int Rb = Epi::PERM ? ((R & ~31) + perm32(R & 31)) : R;
        voffA[i] = (unsigned)(R * lda + C) * 2u; voffB[i] = (unsigned)(Rb * ldb + C) * 2u; }
    const size_t kstep = (size_t)(BK * 2);
    const size_t hstepA = (size_t)HALF * lda * 2, hstepB = (size_t)HALF * ldb * 2;
    const unsigned ldsw = (unsigned)wid * 1024u;
    const int aoff = lds_byte(wr * 64 + fr, fq * 8), boff = lds_byte(wc * 32 + fr, fq * 8);
#define PG8_SA(b, h) (((b) * 2 + (h)) * HTB)
#define PG8_SB(b, h) ((4 + (b) * 2 + (h)) * HTB)
#define PG8_STAGE(bufoff, gbase, voff) do { _Pragma("unroll") for (int _i = 0; _i < 2; ++_i) \
        __builtin_amdgcn_global_load_lds((const unsigned*)((const char*)(gbase) + (voff)[_i]), (LAS unsigned*)(lds + (bufoff) + ldsw + _i * 8192), 16, 0, 0); } while (0)
#define PG8_LDA(dst, b, h) do { _Pragma("unroll") for (int m = 0; m < 4; ++m) _Pragma("unroll") for (int k = 0; k < 2; ++k) dst[m][k] = *(const LAS bf16x8*)(lds + PG8_SA(b, h) + aoff + m * 2048 + k * 1024); } while (0)
#define PG8_LDB(dst, b, h) do { _Pragma("unroll") for (int n = 0; n < 2; ++n) _Pragma("unroll") for (int k = 0; k < 2; ++k) dst[n][k] = *(const LAS bf16x8*)(lds + PG8_SB(b, h) + boff + n * 2048 + k * 1024); } while (0)
#define PG8_MMA(ai, bj, At, Bt) do { __builtin_amdgcn_s_setprio(1); _Pragma("unroll") for (int m = 0; m < 4; ++m) _Pragma("unroll") for (int n = 0; n < 2; ++n) _Pragma("unroll") for (int k = 0; k < 2; ++k) \
        acc[ai][bj][m][n] = __builtin_amdgcn_mfma_f32_16x16x32_bf16(Bt[n][k], At[m][k], acc[ai][bj][m][n], 0, 0, 0); __builtin_amdgcn_s_setprio(0); } while (0)
#define PG8_WAIT_V(n) asm volatile("s_waitcnt vmcnt(" #n ")" ::: "memory")
#define PG8_WAIT_L(n) asm volatile("s_waitcnt lgkmcnt(" #n ")" ::: "memory")
#define PG8_BAR __builtin_amdgcn_s_barrier()
#define PG8_SCHED __builtin_amdgcn_sched_barrier(0)
    Unit cur, nxt; int ui = 0;
    if (!S.next(0, cur)) return;
    f32x4 acc[2][2][4][2];
#pragma unroll
    for (int a = 0; a < 2; ++a)
#pragma unroll
        for (int b = 0; b < 2; ++b)
#pragma unroll
            for (int m = 0; m < 4; ++m)
#pragma unroll
                for (int n = 0; n < 2; ++n) acc[a][b][m][n] = (f32x4){0.f, 0.f, 0.f, 0.f};
    bf16x8 At[4][2], B0[2][2], B1[2][2];
    const char* cA = cur.a; const char* cB = cur.b;
    PG8_STAGE(PG8_SB(0, 0), cB, voffB); PG8_STAGE(PG8_SB(0, 1), cB + hstepB, voffB); PG8_STAGE(PG8_SA(0, 0), cA, voffA); PG8_STAGE(PG8_SA(0, 1), cA + hstepA, voffA);
    if (wr == 1) PG8_BAR;
    PG8_WAIT_V(2); PG8_BAR;
    PG8_STAGE(PG8_SB(1, 0), cB + kstep, voffB); PG8_STAGE(PG8_SA(1, 0), cA + kstep, voffA); PG8_STAGE(PG8_SB(1, 1), cB + hstepB + kstep, voffB);
    PG8_WAIT_V(6); PG8_BAR;
    for (;;) {
        const bool has_next = S.next(ui + 1, nxt);
        const char* nA = has_next ? nxt.a : cA; const char* nB = has_next ? nxt.b : cB;
        for (int t = 0; t < nt; t += 2) {
            const bool last = (t == nt - 2);
            const char* a1 = cA + (size_t)(t + 1) * kstep;
            const char* a2 = last ? nA : cA + (size_t)(t + 2) * kstep; const char* b2 = last ? nB : cB + (size_t)(t + 2) * kstep;
            const char* a3 = a2 + kstep; const char* b3 = b2 + kstep;
            PG8_LDB(B0, 0, 0); PG8_LDB(B1, 0, 1); PG8_SCHED; PG8_LDA(At, 0, 0); PG8_STAGE(PG8_SA(1, 1), a1 + hstepA, voffA);
            PG8_WAIT_V(8); PG8_WAIT_L(0); PG8_BAR; PG8_MMA(0, 0, At, B0); PG8_MMA(0, 1, At, B1); PG8_BAR; PG8_SCHED;
            PG8_LDA(At, 0, 1); PG8_STAGE(PG8_SB(0, 0), b2, voffB); PG8_STAGE(PG8_SB(0, 1), b2 + hstepB, voffB); PG8_STAGE(PG8_SA(0, 0), a2, voffA);
            PG8_WAIT_V(8); PG8_WAIT_L(0); PG8_BAR; PG8_MMA(1, 0, At, B0); PG8_MMA(1, 1, At, B1); PG8_BAR; PG8_SCHED;
            PG8_LDB(B0, 1, 0); PG8_LDB(B1, 1, 1); PG8_SCHED; PG8_LDA(At, 1, 0); PG8_STAGE(PG8_SA(0, 1), a2 + hstepA, voffA);
            PG8_WAIT_V(8); PG8_WAIT_L(0); PG8_BAR; PG8_MMA(0, 0, At, B0); PG8_MMA(0, 1, At, B1); PG8_BAR; PG8_SCHED;
            PG8_LDA(At, 1, 1); PG8_STAGE(PG8_SB(1, 0), b3, voffB); PG8_STAGE(PG8_SB(1, 1), b3 + hstepB, voffB); PG8_STAGE(PG8_SA(1, 0), a3, voffA);
            PG8_WAIT_V(8); PG8_WAIT_L(0); PG8_BAR; PG8_MMA(1, 0, At, B0); PG8_MMA(1, 1, At, B1); PG8_BAR; PG8_SCHED;
        }
        if (wr == 0) PG8_BAR;
        E(acc, cur, wr, wc, fr, fq);
        if (!has_next) break;
#pragma unroll
        for (int a = 0; a < 2; ++a)
#pragma unroll
            for (int b = 0; b < 2; ++b)
#pragma unroll
                for (int m = 0; m < 4; ++m)
#pragma unroll
                    for (int n = 0; n < 2; ++n) acc[a][b][m][n] = (f32x4){0.f, 0.f, 0.f, 0.f};
        cur = nxt; cA = nA; cB = nB; ++ui;
        if (wr == 1) PG8_BAR;
    }
    PG8_WAIT_V(0);
    PG8_BAR;
#undef PG8_SA
#undef PG8_SB
#undef PG8_STAGE
#undef PG8_LDA
#undef PG8_LDB
#undef PG8_MMA
#undef PG8_WAIT_V
#undef PG8_WAIT_L
#undef PG8_BAR
#undef PG8_SCHED
}
}

namespace att {
constexpr int NW = 8, QBLK = 32, KVBLK = 64, DV = 128;
constexpr int SHM_V = KVBLK * DV * 2;
template <int DQK> struct Geo { static constexpr int KROW = DQK * 2, SHM_K = KVBLK * KROW, NQ = DQK / 16, CPR = DQK / 8  , NKI = SHM_K / 8192  ; };
template <int DQK> __device__ __forceinline__ int kswz(int row) { return DQK == 192 ? ((row >> 1) & 7) : (row & 15); }
#define SBAR() __builtin_amdgcn_sched_barrier(0)
__device__ __forceinline__ int crow(int r, int hi) { return (r & 3) + 8 * (r >> 2) + 4 * hi; }
__device__ __forceinline__ void partialSM(f32x16& p0, f32x16& p1, float& m_reg, float& mn, float& alpha, const float C, const float thr) {
    float pmax = p0[0];
#pragma unroll
    for (int r = 1; r < 16; ++r) pmax = fmaxf(pmax, p0[r]);
#pragma unroll
    for (int r = 0; r < 16; ++r) pmax = fmaxf(pmax, p1[r]);
    { auto rr = __builtin_amdgcn_permlane32_swap(__float_as_uint(pmax), __float_as_uint(pmax), false, false);
      pmax = fmaxf(__uint_as_float(rr[0]), __uint_as_float(rr[1])); }
    if (__builtin_expect(__all(pmax - m_reg <= thr), 1)) { mn = m_reg; alpha = 1.f; }
    else { mn = fmaxf(m_reg, pmax); alpha = __builtin_amdgcn_exp2f((m_reg - mn) * C); m_reg = mn; }
    const float mnC = -mn * C;
#pragma unroll
    for (int r = 0; r < 16; ++r) p0[r] = fmaf(p0[r], C, mnC);
#pragma unroll
    for (int r = 0; r < 16; ++r) p1[r] = fmaf(p1[r], C, mnC);
#pragma unroll
    for (int r = 0; r < 16; ++r) p0[r] = __builtin_amdgcn_exp2f(p0[r]);
}
__device__ __forceinline__ void finishSM(f32x16& p0, f32x16& p1, float alpha, float& l_reg, bf16x8& pa0, bf16x8& pa1, bf16x8& pa2, bf16x8& pa3) {
#pragma unroll
    for (int r = 0; r < 16; ++r) p1[r] = __builtin_amdgcn_exp2f(p1[r]);
    float ps = 0;
#pragma unroll
    for (int r = 0; r < 16; ++r) ps += p0[r];
#pragma unroll
    for (int r = 0; r < 16; ++r) ps += p1[r];
    { auto rr = __builtin_amdgcn_permlane32_swap(__float_as_uint(ps), __float_as_uint(ps), false, false);
      ps = __uint_as_float(rr[0]) + __uint_as_float(rr[1]); }
    l_reg = l_reg * alpha + ps;
#define PK4(P, BASE, OUT) do { unsigned a0 = cvt_pk_bf16(P[BASE + 0], P[BASE + 1]), a1 = cvt_pk_bf16(P[BASE + 2], P[BASE + 3]);   \
    unsigned b0 = cvt_pk_bf16(P[BASE + 4], P[BASE + 5]), b1 = cvt_pk_bf16(P[BASE + 6], P[BASE + 7]);                              \
    auto r0 = __builtin_amdgcn_permlane32_swap(a0, b0, false, false); auto r1 = __builtin_amdgcn_permlane32_swap(a1, b1, false, false); \
    u32x4 w = {r0[0], r1[0], r0[1], r1[1]}; OUT = *reinterpret_cast<bf16x8*>(&w); } while (0)
    PK4(p0, 0, pa0); PK4(p0, 8, pa1); PK4(p1, 0, pa2); PK4(p1, 8, pa3);
#undef PK4
}
template <int DQK> struct KAddr { static constexpr int KB = DQK == 192 ? 4 : 8; };
template <int DQK>
__device__ __forceinline__ void qkt(f32x16& p0, f32x16& p1, const char* Ksl  , const bf16x8* qr, const int (&kb)[KAddr<DQK>::KB]) {
    p0 = f32x16{}; p1 = f32x16{};
    constexpr int NQ = Geo<DQK>::NQ, RB = 32 * Geo<DQK>::KROW, KB = KAddr<DQK>::KB;
#define KOFF(d0) (kb[(d0) % KB] + ((d0) / KB) * 32 * KB)
    bf16x8 f0[3], f1[3];
#pragma unroll
    for (int d0 = 0; d0 < 2; ++d0) { f0[d0] = *reinterpret_cast<const bf16x8*>(Ksl + KOFF(d0)); f1[d0] = *reinterpret_cast<const bf16x8*>(Ksl + KOFF(d0) + RB); }
    __builtin_amdgcn_sched_group_barrier(0x100, 4, 0);
#pragma unroll
    for (int d0 = 0; d0 < NQ; ++d0) {
        if (d0 + 2 < NQ) { f0[(d0 + 2) % 3] = *reinterpret_cast<const bf16x8*>(Ksl + KOFF(d0 + 2)); f1[(d0 + 2) % 3] = *reinterpret_cast<const bf16x8*>(Ksl + KOFF(d0 + 2) + RB); }
        p0 = __builtin_amdgcn_mfma_f32_32x32x16_bf16(f0[d0 % 3], qr[d0], p0, 0, 0, 0);
        p1 = __builtin_amdgcn_mfma_f32_32x32x16_bf16(f1[d0 % 3], qr[d0], p1, 0, 0, 0);
        __builtin_amdgcn_sched_group_barrier(0x100, 2, 0); __builtin_amdgcn_sched_group_barrier(0x8, 2, 0); }
#undef KOFF
}
__device__ __forceinline__ int v_st(int k, int c) { const int kk = (k & ~0xC) | ((k & 4) << 1) | ((k & 8) >> 1); return ((kk >> 3) * 4 + (c >> 5)) * 512 + ((kk & 7) * 32 + (c & 31)) * 2; }
__device__ __forceinline__ int v_rd_base(int lane) { return ((lane & 3) << 3) | (((lane >> 2) & 3) << 6) | (((lane >> 4) & 1) << 5) | (((lane >> 5) & 1) << 8); }
constexpr int v_rd_off(int d0, int ks, int half) { return d0 * 512 + ks * 4096 + half * 2048; }
template <int OFF> __device__ __forceinline__ s16x4 tr_read(int vb) {
    s16x4 r; asm volatile("ds_read_b64_tr_b16 %0, %1 offset:%2" : "=&v"(r) : "v"(vb), "i"(OFF) : "memory"); return r;
}
template <int D0> __device__ __forceinline__ void pv_one(f32x16& od, int vb, bf16x8 pa0, bf16x8 pa1, bf16x8 pa2, bf16x8 pa3) {
    const s16x4 l0 = tr_read<v_rd_off(D0, 0, 0)>(vb), h0 = tr_read<v_rd_off(D0, 0, 1)>(vb), l1 = tr_read<v_rd_off(D0, 1, 0)>(vb), h1 = tr_read<v_rd_off(D0, 1, 1)>(vb);
    const s16x4 l2 = tr_read<v_rd_off(D0, 2, 0)>(vb), h2 = tr_read<v_rd_off(D0, 2, 1)>(vb), l3 = tr_read<v_rd_off(D0, 3, 0)>(vb), h3 = tr_read<v_rd_off(D0, 3, 1)>(vb);
    asm volatile("s_waitcnt lgkmcnt(0)" ::: "memory"); SBAR();
#define PK(L, H) (bf16x8){L[0], L[1], L[2], L[3], H[0], H[1], H[2], H[3]}
    od = __builtin_amdgcn_mfma_f32_32x32x16_bf16(pa0, PK(l0, h0), od, 0, 0, 0);
    od = __builtin_amdgcn_mfma_f32_32x32x16_bf16(pa1, PK(l1, h1), od, 0, 0, 0);
    od = __builtin_amdgcn_mfma_f32_32x32x16_bf16(pa2, PK(l2, h2), od, 0, 0, 0);
    od = __builtin_amdgcn_mfma_f32_32x32x16_bf16(pa3, PK(l3, h3), od, 0, 0, 0);
#undef PK
}
__device__ __forceinline__ void pv_d0(f32x16* o, int vb, bf16x8 pa0, bf16x8 pa1, bf16x8 pa2, bf16x8 pa3) {
    pv_one<0>(o[0], vb, pa0, pa1, pa2, pa3); pv_one<1>(o[1], vb, pa0, pa1, pa2, pa3); pv_one<2>(o[2], vb, pa0, pa1, pa2, pa3); pv_one<3>(o[3], vb, pa0, pa1, pa2, pa3);
}

template <int DQK, bool ROPE>
__device__ __forceinline__ void attn_unit(const bf16* __restrict__ Qb, int ldq, const bf16* __restrict__ Kh, int ldk, const bf16* __restrict__ Vh, int ldv,
                                          bf16* __restrict__ Ob, int ldo, int nkeys, const float* __restrict__ qg, const float* __restrict__ ropec, const float* __restrict__ ropes,
                                          int pos0, const float sm_scale, const float* __restrict__ qrs, char* lds) {
    using G = Geo<DQK>; constexpr int NQ = G::NQ;
    const int tid = opaque_tid(), wid = __builtin_amdgcn_readfirstlane(tid >> 6), lane = tid & 63, r32 = lane & 31, hi = lane >> 5;
    char* V_lds = lds; char* K_lds = lds + 3 * SHM_V;
    float* wsp = (float*)(lds + 3 * SHM_V + 2 * G::SHM_K) + wid * 64; float* li_l = wsp; float* al_l = wsp + 32;
    const float C = sm_scale * 1.4426950408889634f, thr = 8.f / sm_scale;
    float m_reg = -1e30f, l_reg = 0; f32x16 o[4] = {}; bf16x8 qr[NQ];
    {
        const bf16* Qw = Qb + (long)(wid * QBLK + r32) * ldq + hi * 8;
        u32x4 raw[NQ]; float ssq = 0.f;
#pragma unroll
        for (int d0 = 0; d0 < NQ; ++d0) { raw[d0] = *reinterpret_cast<const u32x4*>(Qw + d0 * 16);
#pragma unroll
            for (int j = 0; j < 4; ++j) { const float a = bflo(raw[d0][j]), b = bfhi(raw[d0][j]); ssq += a * a + b * b; } }
        ssq += shx(ssq, 32, lane);
        const float qs_ = qrs ? qrs[wid * QBLK + r32] : 1.f;
        const float rstd = qs_ * rsqrtf(qs_ * qs_ * ssq * (1.0f / DQK) + EPS);
        constexpr int NPLAIN = ROPE ? 8 : NQ;
#pragma unroll
        for (int d0 = 0; d0 < NPLAIN; ++d0) { const f32x4 g0 = *reinterpret_cast<const f32x4*>(qg + d0 * 16 + hi * 8), g1 = *reinterpret_cast<const f32x4*>(qg + d0 * 16 + hi * 8 + 4);
            u32x4 w;
#pragma unroll
            for (int j = 0; j < 4; ++j) { const float gl = j < 2 ? g0[2 * j] : g1[2 * j - 4], gh = j < 2 ? g0[2 * j + 1] : g1[2 * j - 3]; w[j] = cvt_pk_bf16(bflo(raw[d0][j]) * rstd * gl, bfhi(raw[d0][j]) * rstd * gh); }
            qr[d0] = *reinterpret_cast<bf16x8*>(&w); }
        if constexpr (ROPE) {
            const long pos = pos0 + wid * QBLK + r32;
#pragma unroll
            for (int dd = 0; dd < 2; ++dd) { const int d0 = 8 + dd, i0 = dd * 16 + hi * 8;
                float cs[8], sn[8], ga[8], gb[8];
                { const f32x4 c0 = *reinterpret_cast<const f32x4*>(ropec + pos * 32 + i0), c1 = *reinterpret_cast<const f32x4*>(ropec + pos * 32 + i0 + 4);
                  const f32x4 s0 = *reinterpret_cast<const f32x4*>(ropes + pos * 32 + i0), s1 = *reinterpret_cast<const f32x4*>(ropes + pos * 32 + i0 + 4);
                  const f32x4 a0 = *reinterpret_cast<const f32x4*>(qg + d0 * 16 + hi * 8), a1 = *reinterpret_cast<const f32x4*>(qg + d0 * 16 + hi * 8 + 4);
                  const f32x4 b0 = *reinterpret_cast<const f32x4*>(qg + (d0 + 2) * 16 + hi * 8), b1 = *reinterpret_cast<const f32x4*>(qg + (d0 + 2) * 16 + hi * 8 + 4);
#pragma unroll
                  for (int j = 0; j < 4; ++j) { cs[j] = c0[j]; cs[4 + j] = c1[j]; sn[j] = s0[j]; sn[4 + j] = s1[j]; ga[j] = a0[j]; ga[4 + j] = a1[j]; gb[j] = b0[j]; gb[4 + j] = b1[j]; } }
                u32x4 w1, w2;
#pragma unroll
                for (int j = 0; j < 4; ++j) {
                    const float x1l = bflo(raw[d0][j]) * rstd * ga[2 * j], x1h = bfhi(raw[d0][j]) * rstd * ga[2 * j + 1];
                    const float x2l = bflo(raw[d0 + 2][j]) * rstd * gb[2 * j], x2h = bfhi(raw[d0 + 2][j]) * rstd * gb[2 * j + 1];
                    w1[j] = cvt_pk_bf16(x1l * cs[2 * j] - x2l * sn[2 * j], x1h * cs[2 * j + 1] - x2h * sn[2 * j + 1]);
                    w2[j] = cvt_pk_bf16(x1l * sn[2 * j] + x2l * cs[2 * j], x1h * sn[2 * j + 1] + x2h * cs[2 * j + 1]); }
                qr[d0] = *reinterpret_cast<bf16x8*>(&w1); qr[d0 + 2] = *reinterpret_cast<bf16x8*>(&w2); }
        }
    }
    const int vb0 = (int)(uintptr_t)V_lds + v_rd_base(lane);
    unsigned kgo[G::NKI], vgo[2];
#pragma unroll
    for (int t = 0; t < G::NKI; ++t) { const int q = (wid * G::NKI + t) * 64 + lane, row = q / G::CPR, pc = q % G::CPR; kgo[t] = (unsigned)(row * ldk * 2 + ((pc ^ kswz<DQK>(row)) * 16)); }
#pragma unroll
    for (int t = 0; t < 2; ++t) { const int q = (wid * 2 + t) * 64 + lane, sub = q >> 5, within = q & 31; const int kk = ((sub >> 2) << 3) | (within >> 2), cc = (sub & 3) * 32 + (within & 3) * 8;
        const int key = (kk & ~0xC) | ((kk & 4) << 1) | ((kk & 8) >> 1); vgo[t] = (unsigned)(key * ldv * 2 + cc * 2); }
    int koffs[KAddr<DQK>::KB];
#pragma unroll
    for (int d0 = 0; d0 < KAddr<DQK>::KB; ++d0) koffs[d0] = (((2 * d0) | hi) ^ kswz<DQK>(r32)) * 16;
    const char* Kg = (const char*)Kh; const char* Vg = (const char*)Vh;
#define SDMA(tile, kslot, vslot) do { const char* kb_ = Kg + (size_t)(tile) * KVBLK * ldk * 2; const char* vb_ = Vg + (size_t)(tile) * KVBLK * ldv * 2; \
    _Pragma("unroll") for (int t_ = 0; t_ < G::NKI; ++t_) __builtin_amdgcn_global_load_lds((const unsigned*)(kb_ + kgo[t_]), (LAS unsigned*)(K_lds + (kslot) * G::SHM_K + (wid * G::NKI + t_) * 1024), 16, 0, 0); \
    _Pragma("unroll") for (int t_ = 0; t_ < 2; ++t_) __builtin_amdgcn_global_load_lds((const unsigned*)(vb_ + vgo[t_]), (LAS unsigned*)(V_lds + (vslot) * SHM_V + (wid * 2 + t_) * 1024), 16, 0, 0); } while (0)
#define RESC(a) do { if (__any((a) < 1.f)) { if (hi == 0) al_l[r32] = (a); asm volatile("s_waitcnt lgkmcnt(0)" ::: "memory"); \
    _Pragma("unroll") for (int d = 0; d < 4; ++d) _Pragma("unroll") for (int r = 0; r < 16; ++r) o[d][r] *= al_l[crow(r, hi)]; } } while (0)
    f32x16 pA0, pA1, pB0, pB1; float mnA, mnB, alA, alB; bf16x8 pa0, pa1, pa2, pa3; const int NT = nkeys / KVBLK;
    const char* Ksl = K_lds + r32 * G::KROW;
    SDMA(0, 0, 0); __syncthreads();
    SDMA(1, 1, 1);
    qkt<DQK>(pA0, pA1, Ksl, qr, koffs); partialSM(pA0, pA1, m_reg, mnA, alA, C, thr);
    __syncthreads();
    int vs = 0;
    for (int j = 1; j + 1 < NT; j += 2) {
        const int v1 = vs == 2 ? 0 : vs + 1, v2 = v1 == 2 ? 0 : v1 + 1;
        SDMA(j + 1, 0, v2);
        SBAR(); qkt<DQK>(pB0, pB1, Ksl + G::SHM_K, qr, koffs);
        finishSM(pA0, pA1, alA, l_reg, pa0, pa1, pa2, pa3); SBAR();
        pv_d0(o, vb0 + vs * SHM_V, pa0, pa1, pa2, pa3); partialSM(pB0, pB1, m_reg, mnB, alB, C, thr);
        RESC(alB); __syncthreads();
        const int v3 = v2 == 2 ? 0 : v2 + 1;
        SDMA(j + 2, 1, v3);
        SBAR(); qkt<DQK>(pA0, pA1, Ksl, qr, koffs);
        finishSM(pB0, pB1, alB, l_reg, pa0, pa1, pa2, pa3); SBAR();
        pv_d0(o, vb0 + v1 * SHM_V, pa0, pa1, pa2, pa3); partialSM(pA0, pA1, m_reg, mnA, alA, C, thr);
        RESC(alA); __syncthreads();
        vs = v2;
    }
    {   const int v1 = vs == 2 ? 0 : vs + 1;
        SBAR(); qkt<DQK>(pB0, pB1, Ksl + G::SHM_K, qr, koffs);
        finishSM(pA0, pA1, alA, l_reg, pa0, pa1, pa2, pa3); SBAR();
        pv_d0(o, vb0 + vs * SHM_V, pa0, pa1, pa2, pa3); partialSM(pB0, pB1, m_reg, mnB, alB, C, thr);
        RESC(alB);
        finishSM(pB0, pB1, alB, l_reg, pa0, pa1, pa2, pa3); SBAR();
        pv_d0(o, vb0 + v1 * SHM_V, pa0, pa1, pa2, pa3); }
    if (hi == 0) li_l[r32] = l_reg; asm volatile("s_waitcnt lgkmcnt(0)" ::: "memory");
    const int lane_e = opaque_tid() & 63, hi_e = lane_e >> 5;
    float rli[16];
#pragma unroll
    for (int r = 0; r < 16; ++r) rli[r] = __builtin_amdgcn_rcpf(li_l[crow(r, hi_e)]);
    bf16* Ow = Ob + (long)(wid * QBLK) * ldo;
#pragma unroll
    for (int r = 0; r < 16; ++r) { const int orow = crow(r, hi_e);
#pragma unroll
        for (int d0 = 0; d0 < 4; ++d0) Ow[(long)orow * ldo + d0 * 32 + (lane_e & 31)] = (bf16)(cvt_pk_bf16(o[d0][r] * rli[r], 0.f) & 0xffffu); }
    __syncthreads();
#undef SDMA
#undef RESC
}
}

#define XB_TMO      128
#define XB_XCNT(j)  (256  + 64 * (j))
#define XB_XSUB(j)  (1280 + 64 * (j))
#define XB_XGEN(j)  (2304 + 64 * (j))
#define XB_TOP      3328
#define XB_TOPGEN   3392
#define XCD_BAR_WORDS 3456
#define XB_SPIN_CAP (1u << 20)
__device__ __forceinline__ unsigned xb_ld(unsigned* p)              { return __hip_atomic_load(p, __ATOMIC_RELAXED, __HIP_MEMORY_SCOPE_AGENT); }
__device__ __forceinline__ unsigned xb_add(unsigned* p, unsigned v) { return __hip_atomic_fetch_add(p, v, __ATOMIC_RELAXED, __HIP_MEMORY_SCOPE_AGENT); }
__device__ __forceinline__ unsigned xb_xcc_id() { return (unsigned)__builtin_amdgcn_s_getreg((3 << 11) | 20) & 0xFu; }
#define XB_SPIN(cond, bar) do { unsigned _sp = 0; while (cond) { __builtin_amdgcn_s_sleep(1); \
    if ((++_sp & 255u) == 0u) { if (xb_ld(&(bar)[XB_TMO])) break; if (_sp > XB_SPIN_CAP) { atomicAdd(&(bar)[XB_TMO], 1u); break; } } } } while (0)
struct XcdBarrier { unsigned* bar; unsigned x; volatile LAS unsigned* st; };
__device__ __forceinline__ XcdBarrier xcd_barrier_post(unsigned* bar, volatile LAS unsigned* st) {
    XcdBarrier b; b.bar = bar; b.x = xb_xcc_id(); b.st = st;
    if (threadIdx.x == 0) (void)xb_add(&bar[XB_XCNT(b.x)], 1u);
    return b;
}
__device__ __forceinline__ void xcd_barrier_complete(unsigned* bar, unsigned x, unsigned& nloc, unsigned& nx) {
    const unsigned G = gridDim.x * gridDim.y * gridDim.z;
    unsigned sum, cnt, mine, sp = 0u;
    for (;;) {
        sum = 0u; cnt = 0u; mine = 0u;
#pragma unroll
        for (unsigned j = 0; j < 16; ++j) { const unsigned c = xb_ld(&bar[XB_XCNT(j)]); sum += c; cnt += (c > 0u) ? 1u : 0u; mine = (j == x) ? c : mine; }
        if (sum == G) break;
        __builtin_amdgcn_s_sleep(1);
        if ((++sp & 255u) == 0u) { if (xb_ld(&bar[XB_TMO])) break; if (sp > XB_SPIN_CAP) { atomicAdd(&bar[XB_TMO], 1u); break; } }
    }
    nloc = mine > 0u ? mine : 1u; nx = cnt > 0u ? cnt : 1u;
}
__device__ __forceinline__ void xcd_barrier(const XcdBarrier& b) {
    asm volatile("s_waitcnt vmcnt(0)" ::: "memory");
    __syncthreads();
    if (threadIdx.x == 0) {
        unsigned* bar = b.bar;
        __builtin_amdgcn_s_waitcnt(0);
        unsigned nloc = b.st[0], nx = b.st[1];
        if (nloc == 0u) { xcd_barrier_complete(bar, b.x, nloc, nx); b.st[0] = nloc; b.st[1] = nx; }
        const unsigned old = xb_add(&bar[XB_XSUB(b.x)], 1u);
        const unsigned gen = old / nloc;
        if (old + 1u == (gen + 1u) * nloc) {
            __builtin_amdgcn_fence(__ATOMIC_RELEASE, "agent");
            asm volatile("s_waitcnt vmcnt(0)" ::: "memory");
            const unsigned og = xb_add(&bar[XB_TOP], 1u);
            const unsigned tg = og / nx;
            if (og + 1u == (tg + 1u) * nx) xb_add(&bar[XB_TOPGEN], 1u);
            else XB_SPIN(xb_ld(&bar[XB_TOPGEN]) == tg, bar);
            __builtin_amdgcn_fence(__ATOMIC_ACQUIRE, "agent");
            xb_add(&bar[XB_XGEN(b.x)], 1u);
            asm volatile("s_waitcnt vmcnt(0)" ::: "memory");
        } else {
            XB_SPIN(xb_ld(&bar[XB_XGEN(b.x)]) == gen, bar);
            __builtin_amdgcn_fence(__ATOMIC_ACQUIRE, "agent");
            asm volatile("s_waitcnt vmcnt(0)" ::: "memory");
        }
    }
    __syncthreads();
}

template <int MODE>
__device__ __forceinline__ void transpose_item(const float* __restrict__ W, int K, int N, bf16* __restrict__ WT, const float* __restrict__ gk, LAS float* scr, int item, int lane) {
    const int nblk = N / 32, kb = item / nblk, nb = item % nblk, k0 = 64 * kb, n0 = 32 * nb;
#pragma unroll 8
    for (int i = 0; i < 32; ++i) { const int kk = 2 * i + (lane >> 5); float w = W[(size_t)(k0 + kk) * N + n0 + (lane & 31)]; if (gk) w *= gk[k0 + kk]; scr[kk * 33 + (lane & 31)] = w; }
    LDS_WAIT(); asm volatile("" ::: "memory");
    const int c = lane & 7;
#pragma unroll
    for (int j = 0; j < 4; ++j) { const int n = (lane >> 3) + 8 * j; const LAS float* s = scr + (8 * c) * 33 + n;
        u32x4 o; o.x = cvt_pk_bf16(s[0 * 33], s[1 * 33]); o.y = cvt_pk_bf16(s[2 * 33], s[3 * 33]); o.z = cvt_pk_bf16(s[4 * 33], s[5 * 33]); o.w = cvt_pk_bf16(s[6 * 33], s[7 * 33]);
        int nn = n0 + n; if (MODE == 1) { const int hh = nn >> 8, jj = nn & 255; nn = hh * 320 + (jj < 128 ? jj : jj + 64); }
        *(u32x4*)(WT + (size_t)nn * K + k0 + 8 * c) = o; }
    LDS_WAIT(); asm volatile("" ::: "memory");
}
__device__ __forceinline__ void rms_row_to_bf16(const float* __restrict__ xrow, const float* __restrict__ g, bf16* __restrict__ orow, int lane) {
    const f32x4* xr = (const f32x4*)xrow + lane; f32x4 v[8]; float s = 0.f;
#pragma unroll
    for (int j = 0; j < 8; ++j) { v[j] = xr[64 * j]; s += (v[j].x * v[j].x + v[j].y * v[j].y) + (v[j].z * v[j].z + v[j].w * v[j].w); }
    const float r = rsqrtf(wave_sum(s, lane) * (1.f / D) + EPS);
    u32x2* o8 = (u32x2*)orow + lane;
#pragma unroll
    for (int j = 0; j < 8; ++j) { const f32x4 gg = ((const f32x4*)g)[lane + 64 * j]; u32x2 w; w.x = cvt_pk_bf16(v[j].x * r * gg.x, v[j].y * r * gg.y); w.y = cvt_pk_bf16(v[j].z * r * gg.z, v[j].w * r * gg.w); o8[64 * j] = w; }
}

template <int NK>
__device__ __forceinline__ void hgrn_scan_item(const bf16* __restrict__ Zv, int row0, int L, int hh, int dir, int kbase, const float* __restrict__ lbl, bf16* __restrict__ Oo,
                                               LAS unsigned char* lds, const unsigned char* lds_gen, int tid, int lane, int wave) {
    constexpr int NPAIR = NK / 2, NPART = 512 / NPAIR, SPT = 64 / NPART, QROW = NK * 2 + 16, ND0 = NK / 16, NKB = NK / 32;
    LAS unsigned char* QT = lds; LAS unsigned char* KT = lds + 64 * QROW; LAS unsigned char* KTT = lds + 128 * QROW; LAS unsigned char* VL = lds + 53248;
    LAS float* TOT = (LAS float*)(lds + 69632); LAS float* FAC = (LAS float*)(lds + 73728);
    const int kp = tid % NPAIR, part = tid / NPAIR, r32 = lane & 31, hi = lane >> 5, sr = tid >> 4, sc = (tid & 15) * 8;
    const int vst0 = att::v_st(sr, sc), vst1 = att::v_st(32 + sr, sc);
    const int nchunk = L >> 6, zc = hh * 128 + kbase + 2 * kp;
    float lb0, lb1; { const float* lg = lbl + dir * 2048 + zc; const f32x2 l0 = *(const f32x2*)lg, l1 = *(const f32x2*)(lg + 4096), l2 = *(const f32x2*)(lg + 8192), l3 = *(const f32x2*)(lg + 12288);
        { const float mx = fmaxf(fmaxf(l0.x, l1.x), fmaxf(l2.x, l3.x)); const float e0 = __expf(l0.x - mx), e1 = __expf(l1.x - mx), e2 = __expf(l2.x - mx), e3 = __expf(l3.x - mx); lb0 = e1 / (e0 + e1 + e2 + e3); }
        { const float mx = fmaxf(fmaxf(l0.y, l1.y), fmaxf(l2.y, l3.y)); const float e0 = __expf(l0.y - mx), e1 = __expf(l1.y - mx), e2 = __expf(l2.y - mx), e3 = __expf(l3.y - mx); lb1 = e1 / (e0 + e1 + e2 + e3); } }
    f32x16 St[NKB];
#pragma unroll
    for (int i = 0; i < NKB; ++i) St[i] = f32x16{};
    unsigned hq_[SPT], hz_[SPT]; bf16x8 rv0, rv1;
#define HG_POS(n) (dir ? (L - 1 - (n)) : (n))
#define HG_LOAD(ch) do { _Pragma("unroll") for (int i = 0; i < SPT; ++i) { const int n = (ch) * 64 + part * SPT + i; const bf16* zr = Zv + (size_t)(row0 + HG_POS(n)) * 10240 + zc; hq_[i] = *(const unsigned*)zr; hz_[i] = *(const unsigned*)(zr + 2048 + dir * 2048); } \
        rv0 = *(const bf16x8*)(Zv + (size_t)(row0 + HG_POS((ch) * 64 + sr)) * 10240 + 6144 + hh * 128 + sc); rv1 = *(const bf16x8*)(Zv + (size_t)(row0 + HG_POS((ch) * 64 + 32 + sr)) * 10240 + 6144 + hh * 128 + sc); } while (0)
    HG_LOAD(0);
    for (int ch = 0; ch < nchunk; ++ch) {
        float run0[SPT], run1[SPT], kk0[SPT], kk1[SPT]; float a0 = 0.f, a1 = 0.f;
#pragma unroll
        for (int i = 0; i < SPT; ++i) { const float z0 = bflo(hz_[i]), z1 = bfhi(hz_[i]);
            const float s0 = __builtin_amdgcn_rcpf(1.f + __expf(-z0)), s1 = __builtin_amdgcn_rcpf(1.f + __expf(-z1));
            const float f0 = lb0 + (1.f - lb0) * s0, f1 = lb1 + (1.f - lb1) * s1;
            kk0[i] = (1.f - lb0) * (1.f - s0); kk1[i] = (1.f - lb1) * (1.f - s1);
            a0 += __logf(f0); a1 += __logf(f1); run0[i] = a0; run1[i] = a1; }
        *(LAS f32x2*)(TOT + part * NK + 2 * kp) = (f32x2){a0, a1};
        *(LAS bf16x8*)(VL + vst0) = rv0; *(LAS bf16x8*)(VL + vst1) = rv1;
        __syncthreads();
        float base0 = 0.f, base1 = 0.f, rr0 = 0.f, rr1 = 0.f, bl0 = 0.f, bl1 = 0.f;
#pragma unroll
        for (int q = 0; q < NPART; ++q) { const f32x2 t = *(const LAS f32x2*)(TOT + q * NK + 2 * kp); if (q < part) { base0 += t.x; base1 += t.y; } if (q < NPART / 2) { rr0 += t.x; rr1 += t.y; } bl0 += t.x; bl1 += t.y; }
        base0 -= rr0; base1 -= rr1;
        float kt0[SPT], kt1[SPT];
#pragma unroll
        for (int i = 0; i < SPT; ++i) { const float d0 = fminf(fmaxf(base0 + run0[i], -60.f), 60.f), d1 = fminf(fmaxf(base1 + run1[i], -60.f), 60.f);
            kt0[i] = kk0[i] * __expf(-d0); kt1[i] = kk1[i] * __expf(-d1);
            const int st = part * SPT + i;
            *(LAS unsigned*)(QT + st * QROW + kp * 4) = cvt_pk_bf16(bflo(hq_[i]) * __expf(d0), bfhi(hq_[i]) * __expf(d1));
            *(LAS unsigned*)(KT + st * QROW + kp * 4) = cvt_pk_bf16(kt0[i], kt1[i]); }
        if constexpr (SPT == 8) {
            *(LAS u32x4*)(KTT + (2 * kp) * 144 + part * 16) = (u32x4){cvt_pk_bf16(kt0[0], kt0[1]), cvt_pk_bf16(kt0[2], kt0[3]), cvt_pk_bf16(kt0[4], kt0[5]), cvt_pk_bf16(kt0[6], kt0[7])};
            *(LAS u32x4*)(KTT + (2 * kp + 1) * 144 + part * 16) = (u32x4){cvt_pk_bf16(kt1[0], kt1[1]), cvt_pk_bf16(kt1[2], kt1[3]), cvt_pk_bf16(kt1[4], kt1[5]), cvt_pk_bf16(kt1[6], kt1[7])};
        } else {
            *(LAS u32x2*)(KTT + (2 * kp) * 144 + part * 8) = (u32x2){cvt_pk_bf16(kt0[0], kt0[1]), cvt_pk_bf16(kt0[2], kt0[3])};
            *(LAS u32x2*)(KTT + (2 * kp + 1) * 144 + part * 8) = (u32x2){cvt_pk_bf16(kt1[0], kt1[1]), cvt_pk_bf16(kt1[2], kt1[3])};
        }
        if (part == 0) { *(LAS f32x2*)(FAC + 2 * kp) = (f32x2){__expf(rr0), __expf(rr1)}; *(LAS f32x2*)(FAC + NK + 2 * kp) = (f32x2){__expf(bl0), __expf(bl1)}; *(LAS f32x2*)(FAC + 2 * NK + 2 * kp) = (f32x2){__expf(bl0 - rr0), __expf(bl1 - rr1)}; }
        __syncthreads();
        if (ch + 1 < nchunk) HG_LOAD(ch + 1);
        if (wave < 4) {
            const int vb = wave; const int vbase = (int)(uintptr_t)(lds_gen + 53248) + att::v_rd_base(lane) + vb * 512;
            bf16x8 vf[4];
            { const s16x4 l0 = att::tr_read<att::v_rd_off(0, 0, 0)>(vbase), h0 = att::tr_read<att::v_rd_off(0, 0, 1)>(vbase), l1 = att::tr_read<att::v_rd_off(0, 1, 0)>(vbase), h1 = att::tr_read<att::v_rd_off(0, 1, 1)>(vbase);
              const s16x4 l2 = att::tr_read<att::v_rd_off(0, 2, 0)>(vbase), h2 = att::tr_read<att::v_rd_off(0, 2, 1)>(vbase), l3 = att::tr_read<att::v_rd_off(0, 3, 0)>(vbase), h3 = att::tr_read<att::v_rd_off(0, 3, 1)>(vbase);
              asm volatile("s_waitcnt lgkmcnt(0)" ::: "memory"); __builtin_amdgcn_sched_barrier(0);
#define HG_PK(L_, H_) (bf16x8){L_[0], L_[1], L_[2], L_[3], H_[0], H_[1], H_[2], H_[3]}
              vf[0] = HG_PK(l0, h0); vf[1] = HG_PK(l1, h1); vf[2] = HG_PK(l2, h2); vf[3] = HG_PK(l3, h3); }
#define HG_PK4(P_, BASE_, OUT_) do { unsigned a0_ = cvt_pk_bf16(P_[BASE_ + 0], P_[BASE_ + 1]), a1_ = cvt_pk_bf16(P_[BASE_ + 2], P_[BASE_ + 3]); \
    unsigned b0_ = cvt_pk_bf16(P_[BASE_ + 4], P_[BASE_ + 5]), b1_ = cvt_pk_bf16(P_[BASE_ + 6], P_[BASE_ + 7]); \
    auto r0_ = __builtin_amdgcn_permlane32_swap(a0_, b0_, false, false); auto r1_ = __builtin_amdgcn_permlane32_swap(a1_, b1_, false, false); \
    u32x4 w_ = {r0_[0], r1_[0], r0_[1], r1_[1]}; OUT_ = *reinterpret_cast<bf16x8*>(&w_); } while (0)
            f32x16 od0 = f32x16{}, od1 = f32x16{};
            {
                f32x16 p0 = f32x16{};
#pragma unroll
                for (int d0 = 0; d0 < ND0; ++d0) { const int cb = (d0 * 16 + hi * 8) * 2;
                    const bf16x8 a = *(const LAS bf16x8*)(KT + r32 * QROW + cb), b = *(const LAS bf16x8*)(QT + r32 * QROW + cb);
                    p0 = __builtin_amdgcn_mfma_f32_32x32x16_bf16(a, b, p0, 0, 0, 0); }
#pragma unroll
                for (int r = 0; r < 16; ++r) if (att::crow(r, hi) > r32) p0[r] = 0.f;
                bf16x8 pa0, pa1; HG_PK4(p0, 0, pa0); HG_PK4(p0, 8, pa1);
                od0 = __builtin_amdgcn_mfma_f32_32x32x16_bf16(pa0, vf[0], od0, 0, 0, 0); od0 = __builtin_amdgcn_mfma_f32_32x32x16_bf16(pa1, vf[1], od0, 0, 0, 0); }
            {
                f32x16 p0 = f32x16{}, p1 = f32x16{};
#pragma unroll
                for (int d0 = 0; d0 < ND0; ++d0) { const int cb = (d0 * 16 + hi * 8) * 2;
                    const bf16x8 a0_ = *(const LAS bf16x8*)(KT + r32 * QROW + cb), a1_ = *(const LAS bf16x8*)(KT + (32 + r32) * QROW + cb), b = *(const LAS bf16x8*)(QT + (32 + r32) * QROW + cb);
                    p0 = __builtin_amdgcn_mfma_f32_32x32x16_bf16(a0_, b, p0, 0, 0, 0); p1 = __builtin_amdgcn_mfma_f32_32x32x16_bf16(a1_, b, p1, 0, 0, 0); }
#pragma unroll
                for (int r = 0; r < 16; ++r) if (att::crow(r, hi) > r32) p1[r] = 0.f;
                bf16x8 pa0, pa1, pa2, pa3; HG_PK4(p0, 0, pa0); HG_PK4(p0, 8, pa1); HG_PK4(p1, 0, pa2); HG_PK4(p1, 8, pa3);
                od1 = __builtin_amdgcn_mfma_f32_32x32x16_bf16(pa0, vf[0], od1, 0, 0, 0); od1 = __builtin_amdgcn_mfma_f32_32x32x16_bf16(pa1, vf[1], od1, 0, 0, 0);
                od1 = __builtin_amdgcn_mfma_f32_32x32x16_bf16(pa2, vf[2], od1, 0, 0, 0); od1 = __builtin_amdgcn_mfma_f32_32x32x16_bf16(pa3, vf[3], od1, 0, 0, 0); }
#pragma unroll
            for (int kb = 0; kb < NKB; ++kb) {
                float er[16];
#pragma unroll
                for (int m = 0; m < 4; ++m) { const f32x4 e4 = *(const LAS f32x4*)(FAC + 32 * kb + 8 * m + 4 * hi); er[4 * m] = e4[0]; er[4 * m + 1] = e4[1]; er[4 * m + 2] = e4[2]; er[4 * m + 3] = e4[3]; }
#pragma unroll
                for (int s2 = 0; s2 < 2; ++s2) {
                    u32x4 bw;
#pragma unroll
                    for (int j = 0; j < 4; ++j) bw[j] = cvt_pk_bf16(St[kb][8 * s2 + 2 * j] * er[8 * s2 + 2 * j], St[kb][8 * s2 + 2 * j + 1] * er[8 * s2 + 2 * j + 1]);
                    const bf16x8 bfr = *reinterpret_cast<bf16x8*>(&bw);
                    const int ko = (32 * kb + 16 * s2 + 4 * hi) * 2;
                    const u32x2 x0 = *(const LAS u32x2*)(QT + r32 * QROW + ko), x1 = *(const LAS u32x2*)(QT + r32 * QROW + ko + 16);
                    const u32x2 y0 = *(const LAS u32x2*)(QT + (32 + r32) * QROW + ko), y1 = *(const LAS u32x2*)(QT + (32 + r32) * QROW + ko + 16);
                    u32x4 aw0 = {x0[0], x0[1], x1[0], x1[1]}, aw1 = {y0[0], y0[1], y1[0], y1[1]};
                    od0 = __builtin_amdgcn_mfma_f32_32x32x16_bf16(*reinterpret_cast<bf16x8*>(&aw0), bfr, od0, 0, 0, 0);
                    od1 = __builtin_amdgcn_mfma_f32_32x32x16_bf16(*reinterpret_cast<bf16x8*>(&aw1), bfr, od1, 0, 0, 0); } }
#pragma unroll
            for (int r = 0; r < 16; ++r) { const int t = att::crow(r, hi); const int n0 = ch * 64 + t, n1 = n0 + 32;
                Oo[(size_t)(row0 + HG_POS(n0)) * D + hh * 128 + 32 * vb + r32] = (bf16)(cvt_pk_bf16(od0[r], 0.f) & 0xffffu);
                Oo[(size_t)(row0 + HG_POS(n1)) * D + hh * 128 + 32 * vb + r32] = (bf16)(cvt_pk_bf16(od1[r], 0.f) & 0xffffu); }
#pragma unroll
            for (int kb = 0; kb < NKB; ++kb) {
                f32x16 U = f32x16{};
#pragma unroll
                for (int ks = 0; ks < 4; ++ks) { const bf16x8 a = *(const LAS bf16x8*)(KTT + (32 * kb + r32) * 144 + (16 * ks + 8 * hi) * 2); U = __builtin_amdgcn_mfma_f32_32x32x16_bf16(a, vf[ks], U, 0, 0, 0); }
#pragma unroll
                for (int m = 0; m < 4; ++m) { const f32x4 el = *(const LAS f32x4*)(FAC + NK + 32 * kb + 8 * m + 4 * hi), elr = *(const LAS f32x4*)(FAC + 2 * NK + 32 * kb + 8 * m + 4 * hi);
#pragma unroll
                    for (int e = 0; e < 4; ++e) St[kb][4 * m + e] = el[e] * St[kb][4 * m + e] + elr[e] * U[4 * m + e]; } }
#undef HG_PK
#undef HG_PK4
        }
        __syncthreads();
    }
#undef HG_LOAD
#undef HG_POS
}

__device__ __forceinline__ void reduce_rstd(const float* __restrict__ ssp, float* __restrict__ rstd, int i0, int stride) {
    for (int row = i0; row < T; row += stride) { const f32x4* p = (const f32x4*)(ssp + (size_t)row * 32); float s = 0.f;
#pragma unroll
        for (int j = 0; j < 8; ++j) { const f32x4 v = p[j]; s += (v.x + v.y) + (v.z + v.w); }
        rstd[row] = rsqrtf(s * (1.f / D) + EPS); }
}
struct Args { const float* in[28]; float* out; unsigned char* ws; int ph_lo, ph_hi, li, pad; };
constexpr int RING_BYTES = 131072, MISC_OFF = RING_BYTES + 64, LDS_BYTES = 147456;

__host__ __device__ constexpr int n_phases() {
    int n = 1;
    for (int layer = 0; layer < 4; ++layer) {
        n += 1;
        if (layer == 0) n += 1;
        const int kind = layer % 3;
        if (kind == 0) n += 2 + 3 * 3 + 1;
        else if (kind == 1) n += 3 * 3 + 1;
        else n += 5;
        n += 4;
        n += 1 + 4;
    }
    return n;
}
constexpr int NPH = n_phases();

#define H      ((bf16*)X)
#define Xb     ((bf16*)(ws + LO(WS_H)))
#define rstd_  ((float*)(ws + LO(WS_RSTD)))
#define ssp_   ((float*)(ws + LO(WS_SSP)))
#define ropec  ((float*)(ws + LO(WS_ROPE)))
#define ropes  ((float*)(ws + LO(WS_ROPE)) + 4096 * 32)
#define mem_rs ((float*)(ws + LO(WS_MEMRS)))
#define mem_b  ((bf16*)(ws + LO(WS_MEMB)))
#define memkv  ((bf16*)(ws + LO(WS_MEMKV)))
#define w1t    ((bf16*)(ws + LO(WS_W1)))
#define w2t    ((bf16*)(ws + LO(WS_W2)))
#define rq     ((float*)(ws + LO(WS_SS0)))
#define rkv_   ((float*)(ws + LO(WS_SS0) + 262144))
#define P      ((bf16*)(ws + LO(S_P)))
#define Qv     ((bf16*)(ws + LO(S_QC)) - (size_t)c * CH * 3072)
#define KVv    ((bf16*)(ws + LO(S_KVC)) - (size_t)c * CH * 5120)
#define Zv     ((bf16*)(ws + LO(S_Z)) - (size_t)c * CH * 10240)
#define OFv    ((bf16*)(ws + LO(S_OF)) - (size_t)c * CH * D)
#define OBv    ((bf16*)(ws + LO(S_OB)) - (size_t)c * CH * D)
#define OP2v   ((bf16*)X + (size_t)T * D - (size_t)c * CH * D)
#define OP3v   ((bf16*)X + (size_t)T * D + (size_t)CH * D - (size_t)c * CH * D)
#define T1     ((bf16*)(ws + LO(S_T1)))
#define Qm     ((bf16*)(ws + LO(S_QM)))
#define Om     ((bf16*)(ws + LO(S_OM)))
#define Hv     ((bf16*)(ws + LO(S_HID) + (size_t)(c & 1) * 256 * MiB) - (size_t)c * CH * DFF)
__global__ void __launch_bounds__(NWAVES * 64, 2) fwd(Args args) {
    extern __shared__ __attribute__((aligned(16))) unsigned char lds_raw[];
    LAS unsigned char* lds = (LAS unsigned char*)lds_raw;
    const int G0_ = gridDim.x, bx0_ = blockIdx.x;
    const int vcu0_ = (G0_ % 8 == 0) ? (bx0_ % 8) * (G0_ / 8) + bx0_ / 8 : bx0_;
    unsigned* ctl = (unsigned*)(args.ws + WS_CTL);
    volatile LAS unsigned* MISC = (volatile LAS unsigned*)(lds + MISC_OFF);
    if (threadIdx.x < 16) MISC[threadIdx.x] = 0u;
    __syncthreads();
    const int lo = args.ph_lo, hi = args.ph_hi;
    XcdBarrier bar; bar.bar = ctl + CW_BAR + args.li * XCD_BAR_WORDS; bar.x = 0; bar.st = MISC + 8;
    if (hi - lo > 1) bar = xcd_barrier_post(ctl + CW_BAR + args.li * XCD_BAR_WORDS, MISC + 8);
    int ph = 0;
#define PH_BEGIN(id) asm volatile("" : "+s"(ph)); if (ph >= lo && ph < hi) { if (PHMASK & (1ull << (id))) for (int rep_ = 0; rep_ < (((REPMASK >> (id)) & 1ull) ? 2 : 1); ++rep_) { if (rep_) __syncthreads(); const int G = launder_i(G0_), bx = launder_i(bx0_), vcu = launder_i(vcu0_), NGW = G * NWAVES; (void)bx; (void)NGW; const int tid = opaque_tid(), lane = tid & 63, wave = __builtin_amdgcn_readfirstlane(tid >> 6), gw = vcu * NWAVES + wave; (void)lane; (void)gw; unsigned char* ws = launder_p(args.ws); float* X = (float*)launder_p((unsigned char*)args.out); (void)X;
#define PH_END   } if (ph + 1 < hi) { XcdBarrier b2_ = bar; b2_.bar = (unsigned*)launder_p((unsigned char*)bar.bar); xcd_barrier(b2_); } } ++ph;


    PH_BEGIN(0)
    {
        for (int m = gw; m < T; m += NGW) { const float* src_ = (m < TPR ? in_ptr(0) + (size_t)m * D : in_ptr(1) + (size_t)(m - TPR) * D);
            const f32x4* xr = (const f32x4*)src_ + lane; f32x4 v[8]; float s = 0.f;
#pragma unroll
            for (int j = 0; j < 8; ++j) { v[j] = xr[64 * j]; s += (v[j].x * v[j].x + v[j].y * v[j].y) + (v[j].z * v[j].z + v[j].w * v[j].w); }
            s = wave_sum(s, lane); if (lane == 0) rstd_[m] = rsqrtf(s * (1.f / D) + EPS);
            u32x2* o8 = (u32x2*)(Xb + (size_t)m * D) + lane;
#pragma unroll
            for (int j = 0; j < 8; ++j) { u32x2 w; w.x = cvt_pk_bf16(v[j].x, v[j].y); w.y = cvt_pk_bf16(v[j].z, v[j].w); o8[64 * j] = w; } }
        for (int i = bx * 512 + tid; i < 4096 * 32; i += G * 512) { const int p = i >> 5, k = i & 31; const float inv = 1.0f / powf(10000.0f, (float)(2 * k) / 64.0f); const float ang = (float)p * inv; float s, c; sincosf(ang, &s, &c); ropec[i] = c; ropes[i] = s; }
        { bf16* Dc = (bf16*)(ws + LO(WS_DC)); const float* g2 = in_ptr(4) + 2 * D;
          for (int i = bx * 512 + tid; i < 4 * 2 * 512 * 512; i += G * 512) { const int k = i & 511, cp = (i >> 9) & 511, part = (i >> 18) & 1, g = i >> 19; const int r = (cp * k) & 511; const float x = (float)r * (2.0f / 512.0f);
              const float v = (part ? sinpif(x) : cospif(x)) * g2[g * 512 + k]; Dc[i] = (bf16)(cvt_pk_bf16(v, 0.f) & 0xffffu); } }
        { bf16* DL = (bf16*)(ws + LO(WS_DL2)); for (int i = bx * 512 + tid; i < 2048 * 2048; i += G * 512) { const int k = i & 2047, lp = i >> 11; const int j = k & 1023; const int r = (lp * j) & 2047; const float x = (float)r * (2.0f / 2048.0f);
              const float v = (k < 1024) ? cospif(x) : -sinpif(x); DL[i] = (bf16)(cvt_pk_bf16(v, 0.f) & 0xffffu); } }
        { bf16* DL = (bf16*)(ws + LO(WS_DL4)); for (int i = bx * 512 + tid; i < 4096 * 4096; i += G * 512) { const int k = i & 4095, lp = i >> 12; const int j = k & 2047; const int r = (lp * j) & 4095; const float x = (float)r * (2.0f / 4096.0f);
              const float v = (k < 2048) ? cospif(x) : -sinpif(x); DL[i] = (bf16)(cvt_pk_bf16(v, 0.f) & 0xffffu); } }
        for (int m = gw; m < 4096; m += NGW) { const float* src = (m < 2048 ? in_ptr(2) + (size_t)m * D : in_ptr(3) + (size_t)(m - 2048) * D);
            const f32x4* xr = (const f32x4*)src + lane; f32x4 v[8]; float s = 0.f;
#pragma unroll
            for (int j = 0; j < 8; ++j) { v[j] = xr[64 * j]; s += (v[j].x * v[j].x + v[j].y * v[j].y) + (v[j].z * v[j].z + v[j].w * v[j].w); }
            s = wave_sum(s, lane); if (lane == 0) mem_rs[m] = rsqrtf(s * (1.f / D) + EPS);
            u32x2* o8 = (u32x2*)(mem_b + (size_t)m * D) + lane;
#pragma unroll
            for (int j = 0; j < 8; ++j) { u32x2 w; w.x = cvt_pk_bf16(v[j].x, v[j].y); w.y = cvt_pk_bf16(v[j].z, v[j].w); o8[64 * j] = w; } }
        { u32x4 z = {0u, 0u, 0u, 0u};
          for (int i = bx * 512 + tid; i < 2 * 192 * 2048 / 8; i += G * 512) { const int j = i / (192 * 2048 / 8), r = i % (192 * 2048 / 8); *(u32x4*)((bf16*)(ws + LO(WS_MLA_WIN)) + (size_t)j * 1280 * 2048 + (size_t)1088 * 2048 + (size_t)r * 8) = z; }
          for (int i = bx * 512 + tid; i < 2 * 16 * 64 * 512 / 8; i += G * 512) { const int j = i / (16 * 64 * 512 / 8), r = i % (16 * 64 * 512 / 8), hh = r / (64 * 512 / 8), q = r % (64 * 512 / 8);
              *(u32x4*)((bf16*)(ws + LO(WS_MLA_WKVB)) + (size_t)j * 5120 * 512 + (size_t)(hh * 320 + 128) * 512 + (size_t)q * 8) = z; } }
        LAS float* scr = (LAS float*)(lds + wave * 16384);
        {
            constexpr int I_WIN = 32 * 34, I_QB = 8 * 96, I_KVB = 8 * 128, I_WO = 32 * 64, I_HIN = 32 * 320, I_MQ = 32 * 16, I_MKV = 32 * 32, I_MO = 8 * 64;
            constexpr int NIT = 2 * I_WIN + 2 * I_QB + 2 * I_KVB + 2 * I_WO + I_HIN + I_WO + I_WO + 4 * I_MQ + 4 * I_MKV + 4 * I_MO;
            for (int it = gw; it < NIT; it += NGW) {
                int r = it;
                if (r < 2 * I_WIN) { const int j = r / I_WIN; transpose_item<0>(in_ptr(5) + (size_t)j * 2048 * 1088, 2048, 1088, (bf16*)(ws + LO(WS_MLA_WIN)) + (size_t)j * 1280 * 2048, in_ptr(4) + (3 * j) * D, scr, r % I_WIN, lane); continue; } r -= 2 * I_WIN;
                if (r < 2 * I_QB) { const int j = r / I_QB; transpose_item<0>(in_ptr(8) + (size_t)j * 512 * 3072, 512, 3072, (bf16*)(ws + LO(WS_MLA_WQB)) + (size_t)j * 3072 * 512, in_ptr(6) + j * 512, scr, r % I_QB, lane); continue; } r -= 2 * I_QB;
                if (r < 2 * I_KVB) { const int j = r / I_KVB; transpose_item<1>(in_ptr(9) + (size_t)j * 512 * 4096, 512, 4096, (bf16*)(ws + LO(WS_MLA_WKVB)) + (size_t)j * 5120 * 512, in_ptr(7) + j * 512, scr, r % I_KVB, lane); continue; } r -= 2 * I_KVB;
                if (r < 2 * I_WO) { const int j = r / I_WO; transpose_item<0>(in_ptr(12) + (size_t)j * 2048 * 2048, 2048, 2048, (bf16*)(ws + LO(WS_MLA_WO)) + (size_t)j * 2048 * 2048, nullptr, scr, r % I_WO, lane); continue; } r -= 2 * I_WO;
                if (r < I_HIN) { transpose_item<0>(in_ptr(13), 2048, 10240, (bf16*)(ws + LO(WS_HG_WIN)), in_ptr(4) + 1 * D, scr, r, lane); continue; } r -= I_HIN;
                if (r < I_WO) { transpose_item<0>(in_ptr(16), 2048, 2048, (bf16*)(ws + LO(WS_HG_WO)), nullptr, scr, r, lane); continue; } r -= I_WO;
                if (r < I_WO) { transpose_item<0>(in_ptr(17), 2048, 2048, (bf16*)(ws + LO(WS_FN_WO)), nullptr, scr, r, lane); continue; } r -= I_WO;
                if (r < 4 * I_MQ) { const int j = r / I_MQ; transpose_item<0>(in_ptr(20) + (size_t)j * 2048 * 512, 2048, 512, (bf16*)(ws + LO(WS_MEM_WQ)) + (size_t)j * 512 * 2048, in_ptr(18) + j * D, scr, r % I_MQ, lane); continue; } r -= 4 * I_MQ;
                if (r < 4 * I_MKV) { const int j = r / I_MKV; transpose_item<0>(in_ptr(21) + (size_t)j * 2048 * 1024, 2048, 1024, (bf16*)(ws + LO(WS_MEM_WKV)) + (size_t)j * 1024 * 2048, in_ptr(19) + j * 2048, scr, r % I_MKV, lane); continue; } r -= 4 * I_MKV;
                { const int j = r / I_MO; transpose_item<0>(in_ptr(24) + (size_t)j * 512 * 2048, 512, 2048, (bf16*)(ws + LO(WS_MEM_WO)) + (size_t)j * 2048 * 512, nullptr, scr, r % I_MO, lane); }
            }
        }
        __syncthreads();
    }
    PH_END

#pragma unroll 1
    for (int layer = 0; layer < 4; ++layer) {
        const int kind = layer % 3, jm = layer / 3;
        PH_BEGIN(1)
        {
            if (layer > 0) reduce_rstd(ssp_, rstd_, bx * 512 + tid, G * 512);
            LAS float* scr = (LAS float*)(lds + wave * 16384);
            constexpr int I_1 = 32 * 256, I_2 = 128 * 64;
            for (int it = gw; it < I_1 + I_2; it += NGW) {
                if (it < I_1) transpose_item<0>(in_ptr(26) + (size_t)layer * D * DFF, D, DFF, w1t, in_ptr(25) + layer * D, scr, it, lane);
                else transpose_item<0>(in_ptr(27) + (size_t)layer * DFF * D, DFF, D, w2t, nullptr, scr, it - I_1, lane);
            }
            __syncthreads();
            if (layer == 0) {
                pg8::TileOrder S; S.init(mem_b, D, ws + WS_MEM_WKV, D, 0, 16, 16, G, bx);
                pg8::EpiBf16<1, 0> E{memkv, 4096, mem_rs, 0, 1.f};
                pg8::gemm_phase(lds, D, D, D, S, E);
            }
        }
        PH_END
        if (layer == 0) {
            PH_BEGIN(2)
            for (int m = gw; m < 4096; m += NGW) { const int ly = lane >> 4, hh = (lane >> 2) & 3, qq = lane & 3;
                bf16* p = memkv + (size_t)m * 4096 + ly * 1024 + hh * 128 + qq * 32; const float* g = in_ptr(23) + ly * 128 + qq * 32;
                u32x4 raw[4]; float x[32]; float s = 0.f;
#pragma unroll
                for (int j = 0; j < 4; ++j) { raw[j] = *(const u32x4*)(p + 8 * j);
#pragma unroll
                    for (int e = 0; e < 4; ++e) { x[8 * j + 2 * e] = bflo(raw[j][e]); x[8 * j + 2 * e + 1] = bfhi(raw[j][e]); } }
#pragma unroll
                for (int e = 0; e < 32; ++e) s += x[e] * x[e];
                s += shx(s, 1, lane); s += shx(s, 2, lane);
                const float r = rsqrtf(s * (1.f / 128.f) + EPS);
#pragma unroll
                for (int j = 0; j < 4; ++j) { u32x4 w;
#pragma unroll
                    for (int e = 0; e < 4; ++e) w[e] = cvt_pk_bf16(x[8 * j + 2 * e] * r * g[8 * j + 2 * e], x[8 * j + 2 * e + 1] * r * g[8 * j + 2 * e + 1]);
                    *(u32x4*)(p + 8 * j) = w; } }
            PH_END
        }

        if (kind == 0) {
            PH_BEGIN(3)
            {   pg8::TileOrder S; S.init(Xb, D, (bf16*)(ws + LO(WS_MLA_WIN)) + (size_t)jm * 1280 * 2048, D, 0, T / 256, 5, G, bx);
                pg8::EpiBf16<1, 0> E{P, 1280, rstd_, 0, 1.f};
                pg8::gemm_phase(lds, D, D, D, S, E); }
            PH_END
            PH_BEGIN(24)
            for (int m = gw; m < T; m += NGW) {
                const u32x4 a = *(const u32x4*)(P + (size_t)m * 1280 + lane * 16), b = *(const u32x4*)(P + (size_t)m * 1280 + lane * 16 + 8); float q2 = 0.f;
#pragma unroll
                for (int e = 0; e < 4; ++e) { const float a0 = bflo(a[e]), a1 = bfhi(a[e]), b0 = bflo(b[e]), b1 = bfhi(b[e]); q2 += (a0 * a0 + a1 * a1) + (b0 * b0 + b1 * b1); }
#pragma unroll
                for (int o = 1; o < 32; o <<= 1) q2 += shx(q2, o, lane);
                const float rs_ = rsqrtf(q2 * (1.f / 512.f) + EPS);
                if (lane == 0) rq[m] = rs_; if (lane == 32) rkv_[m] = rs_; }
            PH_END
#pragma unroll 1
            for (int c = 0; c < 3; ++c) {
                PH_BEGIN(4)
                {   pg8::TileOrder S; S.init(P, 1280, (bf16*)(ws + LO(WS_MLA_WQB)) + (size_t)jm * 3072 * 512, 512, c * 64, 64, 12, G, bx);
                    pg8::EpiBf16<1, 0> E{Qv, 3072, rq, 0, 1.f};
                    pg8::gemm_phase(lds, 512, 1280, 512, S, E); }
                {   pg8::TileOrder S; S.init(P + 512, 1280, (bf16*)(ws + LO(WS_MLA_WKVB)) + (size_t)jm * 5120 * 512, 512, c * 64, 64, 20, G, bx);
                    pg8::EpiBf16<1, 0> E{KVv, 5120, rkv_, 0, 1.f};
                    pg8::gemm_phase(lds, 512, 1280, 512, S, E); }
                PH_END
                PH_BEGIN(5)
                {   const float* gk = in_ptr(11) + jm * 192; const int hh = lane >> 2, qq = lane & 3;
                    for (int m = c * CH + gw; m < (c + 1) * CH; m += NGW) {
                        const int pos = m < TPR ? (m & 2047) : ((m - TPR) & 4095);
                        bf16* kp = KVv + (size_t)m * 5120 + hh * 320; const bf16* pr = P + (size_t)m * 1280 + 1024;
                        u32x4 raw[4]; float x[32], x1[8], x2[8]; float s = 0.f;
#pragma unroll
                        for (int j = 0; j < 4; ++j) { raw[j] = *(const u32x4*)(kp + qq * 32 + 8 * j);
#pragma unroll
                            for (int e = 0; e < 4; ++e) { x[8 * j + 2 * e] = bflo(raw[j][e]); x[8 * j + 2 * e + 1] = bfhi(raw[j][e]); } }
                        { const u32x4 r1 = *(const u32x4*)(pr + qq * 8), r2 = *(const u32x4*)(pr + 32 + qq * 8);
#pragma unroll
                          for (int e = 0; e < 4; ++e) { x1[2 * e] = bflo(r1[e]); x1[2 * e + 1] = bfhi(r1[e]); x2[2 * e] = bflo(r2[e]); x2[2 * e + 1] = bfhi(r2[e]); } }
#pragma unroll
                        for (int e = 0; e < 32; ++e) s += x[e] * x[e];
#pragma unroll
                        for (int e = 0; e < 8; ++e) s += x1[e] * x1[e] + x2[e] * x2[e];
                        s += shx(s, 1, lane); s += shx(s, 2, lane);
                        const float r = rsqrtf(s * (1.f / 192.f) + EPS);
#pragma unroll
                        for (int j = 0; j < 4; ++j) { u32x4 w;
#pragma unroll
                            for (int e = 0; e < 4; ++e) w[e] = cvt_pk_bf16(x[8 * j + 2 * e] * r * gk[qq * 32 + 8 * j + 2 * e], x[8 * j + 2 * e + 1] * r * gk[qq * 32 + 8 * j + 2 * e + 1]);
                            *(u32x4*)(kp + qq * 32 + 8 * j) = w; }
                        float y1[8], y2[8];
#pragma unroll
                        for (int e = 0; e < 8; ++e) { const int i = qq * 8 + e; const float cc = ropec[pos * 32 + i], sn = ropes[pos * 32 + i];
                            const float a = x1[e] * r * gk[128 + i], b = x2[e] * r * gk[160 + i]; y1[e] = a * cc - b * sn; y2[e] = a * sn + b * cc; }
                        u32x4 w1, w2;
#pragma unroll
                        for (int e = 0; e < 4; ++e) { w1[e] = cvt_pk_bf16(y1[2 * e], y1[2 * e + 1]); w2[e] = cvt_pk_bf16(y2[2 * e], y2[2 * e + 1]); }
                        *(u32x4*)(kp + 128 + qq * 8) = w1; *(u32x4*)(kp + 160 + qq * 8) = w2;
                    } }
                PH_END
                PH_BEGIN(6)
                {   const int nqb = (c == 0) ? 8 : 16, nun = 1024;
                    for (int idx = vcu; idx < nun; idx += G) {
                        const int qb = idx % nqb, hh = (idx / nqb) & 15, sl = idx / (nqb * 16); const int s = (c == 0) ? sl : 8 + (c - 1) * 4 + sl;
                        const int row0 = seq_row0(s), L = seq_len(s);
                        att::attn_unit<192, true>(Qv + (size_t)(row0 + qb * 256) * 3072 + hh * 192, 3072, KVv + (size_t)row0 * 5120 + hh * 320, 5120, KVv + (size_t)row0 * 5120 + hh * 320 + 192, 5120,
                                                  H + (size_t)(row0 + qb * 256) * D + hh * 128, D, L, in_ptr(10) + jm * 192, ropec, ropes, qb * 256, 0.07216878364870322f, nullptr, (char*)lds_raw);
                    } }
                PH_END
            }
            PH_BEGIN(7)
            {   pg8::TileOrder S; S.init(H, D, (bf16*)(ws + LO(WS_MLA_WO)) + (size_t)jm * 2048 * 2048, D, 0, T / 256, 8, G, bx);
                pg8::EpiResid<false> E{Xb, ssp_, nullptr};
                pg8::gemm_phase(lds, D, D, D, S, E); }
            PH_END
        } else if (kind == 1) {
#pragma unroll 1
            for (int c = 0; c < 3; ++c) {
                PH_BEGIN(8)
                {   pg8::TileOrder S; S.init(Xb, D, ws + WS_HG_WIN, D, c * 64, 64, 40, G, bx);
                    pg8::EpiBf16<1, 0> E{Zv, 10240, rstd_, 0, 1.f};
                    pg8::gemm_phase(lds, D, D, D, S, E); }
                PH_END
                PH_BEGIN(9)
                {
                    if (c == 0) {
                        for (int it = vcu; it < 256; it += G) { const int dir = it & 1, hh = (it >> 1) & 15, s = it >> 5;
                            hgrn_scan_item<128>(Zv, seq_row0(s), seq_len(s), hh, dir, 0, in_ptr(14), dir ? OBv : OFv, lds, lds_raw, tid, lane, wave); }
                    } else {
                        for (int it = vcu; it < 256; it += G) { const int kh = it & 1, dir = (it >> 1) & 1, hh = (it >> 2) & 15, s = 8 + (c - 1) * 4 + (it >> 6);
                            bf16* Oo = kh ? (dir ? OP3v : OP2v) : (dir ? OBv : OFv);
                            hgrn_scan_item<64>(Zv, seq_row0(s), seq_len(s), hh, dir, kh * 64, in_ptr(14), Oo, lds, lds_raw, tid, lane, wave); }
                    } }
                PH_END
                PH_BEGIN(10)
                {   const float* go = in_ptr(15) + (lane & 3) * 32;
                    for (int m = c * CH + gw; m < (c + 1) * CH; m += NGW) {
                        const bf16* pf = OFv + (size_t)m * D + lane * 32; const bf16* pb = OBv + (size_t)m * D + lane * 32; const bf16* pg = Zv + (size_t)m * 10240 + 8192 + lane * 32;
                        const bf16* p2 = OP2v + (size_t)m * D + lane * 32; const bf16* p3 = OP3v + (size_t)m * D + lane * 32;
                        float x[32]; float s = 0.f;
#pragma unroll
                        for (int j = 0; j < 4; ++j) { const u32x4 a = *(const u32x4*)(pf + 8 * j), b = *(const u32x4*)(pb + 8 * j);
#pragma unroll
                            for (int e = 0; e < 4; ++e) { x[8 * j + 2 * e] = bflo(a[e]) + bflo(b[e]); x[8 * j + 2 * e + 1] = bfhi(a[e]) + bfhi(b[e]); }
                            if (c > 0) { const u32x4 a2 = *(const u32x4*)(p2 + 8 * j), b2 = *(const u32x4*)(p3 + 8 * j);
#pragma unroll
                                for (int e = 0; e < 4; ++e) { x[8 * j + 2 * e] += bflo(a2[e]) + bflo(b2[e]); x[8 * j + 2 * e + 1] += bfhi(a2[e]) + bfhi(b2[e]); } } }
#pragma unroll
                        for (int e = 0; e < 32; ++e) s += x[e] * x[e];
                        s += shx(s, 1, lane); s += shx(s, 2, lane);
                        const float r = rsqrtf(s * (1.f / 128.f) + EPS);
#pragma unroll
                        for (int j = 0; j < 4; ++j) { const u32x4 gr = *(const u32x4*)(pg + 8 * j); u32x4 w;
#pragma unroll
                            for (int e = 0; e < 4; ++e) { const float g0 = bflo(gr[e]), g1 = bfhi(gr[e]); const float s0 = g0 / (1.f + __expf(-g0)), s1 = g1 / (1.f + __expf(-g1));
                                w[e] = cvt_pk_bf16(x[8 * j + 2 * e] * r * go[8 * j + 2 * e] * s0, x[8 * j + 2 * e + 1] * r * go[8 * j + 2 * e + 1] * s1); }
                            *(u32x4*)(H + (size_t)m * D + lane * 32 + 8 * j) = w; } } }
                PH_END
            }
            PH_BEGIN(11)
            {   pg8::TileOrder S; S.init(H, D, ws + WS_HG_WO, D, 0, T / 256, 8, G, bx);
                pg8::EpiResid<false> E{Xb, ssp_, nullptr};
                pg8::gemm_phase(lds, D, D, D, S, E); }
            PH_END
        } else {
            struct F1Order { const char* Dc; const char* HEb; const char* HOb; int G, c, smp;
                __device__ __forceinline__ bool next(int i, pg8::Unit& u) const {
                    const int idx = i * G + c; const int npn = smp ? 8 : 4, per = 16 * npn; if (idx >= 8 * per) return false;
                    const int s = (smp ? 8 : 0) + idx / per, rem = idx % per; const int g = rem / (4 * npn), part = (rem / (2 * npn)) & 1, pn = (rem % (2 * npn)) / 2, pm = rem & 1;
                    const int row0 = seq_row0(s), L = seq_len(s);
                    u.pm = pm; u.pn = pn; u.a = Dc + ((size_t)((g * 2 + part) * 512 + pm * 256) * 512) * 2; u.b = (part ? HOb : HEb) + ((size_t)(row0 / 2 + pn * 256) * D + g * 512) * 2;
                    u.ooff = (long)row0 * D + (long)g * 512 * L + (long)part * (L / 2); u.aoff = 0; u.roff = 0; return true; } };
            struct F2Order { const char* DL; const char* T1b; int G, c, smp, half;
                __device__ __forceinline__ bool next(int i, pg8::Unit& u) const {
                    const int idx = i * G + c; const int L = smp ? 4096 : 2048, npm = L / 512; if (idx >= npm * 64) return false;
                    const int pm = idx / 64, sgp = idx % 64; const int s = (smp ? 8 : 0) + sgp / 8, g = (sgp % 8) / 2, pn = sgp % 2; const int row0 = seq_row0(s);
                    u.pm = pm; u.pn = pn; u.a = DL + ((size_t)pm * 256 * L + half * (L / 2)) * 2; u.b = T1b + ((size_t)row0 * D + (size_t)g * 512 * L + (size_t)pn * 256 * L + half * (L / 2)) * 2;
                    u.aoff = (long)(row0 / 2) * D + (long)g * (L / 2) * 512; u.ooff = half ? (long)row0 * D + g * 512 : u.aoff; u.roff = s * D + g * 512; return true; } };
            PH_BEGIN(22)
            {
                bf16* HE = (bf16*)(ws + LO(S_HE)); bf16* HO = (bf16*)(ws + LO(S_HO)); float* xcm = (float*)(ws + LO(WS_XCMID));
                for (int m = gw; m < T / 2; m += NGW) {
                    const int s = m < 8192 ? m / 1024 : 8 + (m - 8192) / 2048; const int row0 = seq_row0(s), L = seq_len(s), j = m - row0 / 2;
                    const bf16* pa = Xb + (size_t)(row0 + j) * D + lane * 32; const bf16* pb = Xb + (size_t)(row0 + (j ? L - j : 0)) * D + lane * 32;
                    const float ra = rstd_[row0 + j], rb = j ? rstd_[row0 + L - j] : 0.f;
#pragma unroll
                    for (int q = 0; q < 4; ++q) { const u32x4 a = *(const u32x4*)(pa + 8 * q), b = *(const u32x4*)(pb + 8 * q); u32x4 we, wo;
#pragma unroll
                        for (int e = 0; e < 4; ++e) { const float a0 = bflo(a[e]) * ra, a1 = bfhi(a[e]) * ra, b0 = bflo(b[e]) * rb, b1 = bfhi(b[e]) * rb; we[e] = cvt_pk_bf16(a0 + b0, a1 + b1); wo[e] = j ? cvt_pk_bf16(a0 - b0, a1 - b1) : 0u; }
                        *(u32x4*)(HE + (size_t)m * D + lane * 32 + 8 * q) = we; *(u32x4*)(HO + (size_t)m * D + lane * 32 + 8 * q) = wo; } }
                const bf16* Dcc = (const bf16*)(ws + LO(WS_DC));
                for (int t = gw; t < 16 * D; t += NGW) { const int s = t >> 11, col = t & 2047, g = col >> 9, cp = col & 511; const int mid = seq_row0(s) + seq_len(s) / 2;
                    const u32x4 dv = *(const u32x4*)(Dcc + ((size_t)(g * 2) * 512 + cp) * 512 + lane * 8), xv = *(const u32x4*)(Xb + (size_t)mid * D + g * 512 + lane * 8); float a = 0.f;
#pragma unroll
                    for (int e = 0; e < 4; ++e) a += bflo(dv[e]) * bflo(xv[e]) + bfhi(dv[e]) * bfhi(xv[e]);
                    a = wave_sum(a, lane); if (lane == 0) xcm[t] = a * rstd_[mid]; } }
            PH_END
            PH_BEGIN(12)
            {   F1Order S{(const char*)(ws + LO(WS_DC)), (const char*)(ws + LO(S_HE)), (const char*)(ws + LO(S_HO)), G, bx, 1}; pg8::EpiBf16<0, 0> E{T1, 4096, nullptr, 0, 1.f};
                pg8::gemm_phase(lds, 512, 512, D, S, E); }
            {   F1Order S{(const char*)(ws + LO(WS_DC)), (const char*)(ws + LO(S_HE)), (const char*)(ws + LO(S_HO)), G, bx, 0}; pg8::EpiBf16<0, 0> E{T1, 2048, nullptr, 0, 1.f};
                pg8::gemm_phase(lds, 512, 512, D, S, E); }
            PH_END
            PH_BEGIN(13)
            {   F2Order S{(const char*)(ws + LO(WS_DL4)), (const char*)T1, G, bx, 1, 0}; pg8::EpiBf16<0, 0> E{(bf16*)(ws + LO(S_HE)), 512, nullptr, 0, 1.f};
                pg8::gemm_phase(lds, 2048, 4096, 4096, S, E); }
            {   F2Order S{(const char*)(ws + LO(WS_DL2)), (const char*)T1, G, bx, 0, 0}; pg8::EpiBf16<0, 0> E{(bf16*)(ws + LO(S_HE)), 512, nullptr, 0, 1.f};
                pg8::gemm_phase(lds, 1024, 2048, 2048, S, E); }
            PH_END
            PH_BEGIN(23)
            {   F2Order S{(const char*)(ws + LO(WS_DL4)), (const char*)T1, G, bx, 1, 1}; pg8::EpiFnetSym E{H, (const bf16*)(ws + LO(S_HE)), (const float*)(ws + LO(WS_XCMID)), 4096, 6.905339660024878e-4f};
                pg8::gemm_phase(lds, 2048, 4096, 4096, S, E); }
            {   F2Order S{(const char*)(ws + LO(WS_DL2)), (const char*)T1, G, bx, 0, 1}; pg8::EpiFnetSym E{H, (const bf16*)(ws + LO(S_HE)), (const float*)(ws + LO(WS_XCMID)), 2048, 9.765625e-4f};
                pg8::gemm_phase(lds, 1024, 2048, 2048, S, E); }
            {
                const float* xcm = (const float*)(ws + LO(WS_XCMID));
                for (int t = gw; t < 16 * D; t += NGW) { const int s = t >> 11, col = t & 2047, g = col >> 9, cp = col & 511; const int row0 = seq_row0(s), L = seq_len(s);
                    const bf16* tp = T1 + (size_t)row0 * D + (size_t)g * 512 * L + (size_t)cp * L; float a = 0.f;
                    for (int j0 = lane * 8; j0 < L / 2; j0 += 512) { const u32x4 v = *(const u32x4*)(tp + j0);
#pragma unroll
                        for (int e = 0; e < 4; ++e) a += bflo(v[e]) - bfhi(v[e]); }
                    a = wave_sum(a, lane);
                    if (lane == 0) H[(size_t)(row0 + L / 2) * D + col] = (bf16)(cvt_pk_bf16((a + xcm[t]) * (L == 4096 ? 6.905339660024878e-4f : 9.765625e-4f), 0.f) & 0xffffu); } }
            PH_END
            PH_BEGIN(14)
            {   pg8::TileOrder S; S.init(H, D, ws + WS_FN_WO, D, 0, T / 256, 8, G, bx);
                pg8::EpiResid<false> E{Xb, ssp_, nullptr};
                pg8::gemm_phase(lds, D, D, D, S, E); }
            PH_END
        }

        {
            PH_BEGIN(15)
            reduce_rstd(ssp_, rstd_, bx * 512 + tid, G * 512);
            PH_END
            PH_BEGIN(16)
            {   pg8::TileOrder S; S.init(Xb, D, (bf16*)(ws + LO(WS_MEM_WQ)) + (size_t)layer * 512 * 2048, D, 0, T / 256, 2, G, bx);
                pg8::EpiBf16<1, 0> E{Qm, 512, rstd_, 0, 1.f};
                pg8::gemm_phase(lds, D, D, D, S, E); }
            PH_END
            PH_BEGIN(17)
            for (int idx = vcu; idx < 768; idx += G) {
                const int hh = idx & 3, rb = idx >> 2; const int s = rb < 64 ? rb / 8 : 8 + (rb - 64) / 16;
                const bf16* kp = memkv + (size_t)(s * 256) * 4096 + layer * 1024 + hh * 128;
                att::attn_unit<128, false>(Qm + (size_t)rb * 256 * 512 + hh * 128, 512, kp, 4096, kp + 512, 4096, Om + (size_t)rb * 256 * 512 + hh * 128, 512, 256,
                                           in_ptr(22) + layer * 128, nullptr, nullptr, 0, 0.08838834764831845f, nullptr, (char*)lds_raw);
            }
            PH_END
            PH_BEGIN(18)
            {   pg8::TileOrder S; S.init(Om, 512, (bf16*)(ws + LO(WS_MEM_WO)) + (size_t)layer * 2048 * 512, 512, 0, T / 256, 8, G, bx);
                pg8::EpiResid<false> E{Xb, ssp_, nullptr};
                pg8::gemm_phase(lds, 512, 512, 512, S, E); }
            PH_END
        }
        {
            PH_BEGIN(19)
            reduce_rstd(ssp_, rstd_, bx * 512 + tid, G * 512);
            PH_END
#pragma unroll 1
            for (int cc = 0; cc < 4; ++cc) {
                PH_BEGIN(20)
                if (cc > 0) { const int c = cc - 1;
                    pg8::TileOrder S; S.init(Hv, DFF, w2t, DFF, c * 64, 64, 8, G, bx);
                    if (layer == 3) { pg8::EpiResid<true> E{Xb, nullptr, X}; pg8::gemm_phase(lds, DFF, DFF, DFF, S, E); }
                    else { pg8::EpiResid<false> E{Xb, ssp_, nullptr}; pg8::gemm_phase(lds, DFF, DFF, DFF, S, E); } }
                if (cc < 3) { const int c = cc;
                    pg8::TileOrder S; S.init(Xb, D, w1t, D, c * 64, 64, 32, G, bx);
                    pg8::EpiBf16<1, 1> E{Hv, DFF, rstd_, 0, 1.f};
                    pg8::gemm_phase(lds, D, D, D, S, E); }
                PH_END
            }
        }
    }
#undef PH_BEGIN
#undef PH_END
}

extern "C" void kernel_launch(void* const* d_in, const int* in_sizes, int n_in, void* d_out, int out_size, void* d_ws, size_t ws_size, hipStream_t stream) {
    static int grid = 0;
    if (grid == 0) {
        if (n_in != 28 || out_size != T * D || ws_size < WS_END) { fprintf(stderr, "kernel_launch: unexpected shapes (n_in %d out %d ws %zu)\n", n_in, out_size, ws_size); grid = -1; return; }
        int dev = 0, cus = 0, per_cu = 0;
        if (hipGetDevice(&dev) != hipSuccess || hipDeviceGetAttribute(&cus, hipDeviceAttributeMultiprocessorCount, dev) != hipSuccess) { grid = -1; return; }
        if (hipFuncSetAttribute((const void*)fwd, hipFuncAttributeMaxDynamicSharedMemorySize, LDS_BYTES) != hipSuccess) { fprintf(stderr, "kernel_launch: hipFuncSetAttribute failed\n"); grid = -1; return; }
        if (hipOccupancyMaxActiveBlocksPerMultiprocessor(&per_cu, (const void*)fwd, NWAVES * 64, LDS_BYTES) != hipSuccess || per_cu < 1) fprintf(stderr, "kernel_launch: occupancy query says %d\n", per_cu);
        (void)hipGetLastError();
        grid = cus;
    }
    if (grid < 0) return;
    (void)hipMemsetAsync((char*)d_ws + WS_CTL, 0, CTL_BYTES, stream);
    Args a{};
    for (int i = 0; i < 28; ++i) a.in[i] = (const float*)d_in[i];
    a.out = (float*)d_out; a.ws = (unsigned char*)d_ws; a.pad = 0;
#if N_LAUNCH_MODE == 0
    a.ph_lo = 0; a.ph_hi = NPH; a.li = 0;
    hipLaunchKernelGGL(fwd, dim3(grid), dim3(NWAVES * 64), LDS_BYTES, stream, a);
#else
    for (int p = 0; p < NPH; ++p) { a.ph_lo = p; a.ph_hi = p + 1; a.li = 0; hipLaunchKernelGGL(fwd, dim3(grid), dim3(NWAVES * 64), LDS_BYTES, stream, a); }
#endif
    const hipError_t le = hipPeekAtLastError();
    if (le != hipSuccess) fprintf(stderr, "kernel_launch: launch failed: %s\n", hipGetErrorName(le));
}
```

```cpp
#include <hip/hip_runtime.h>
#include <cstdio>
#include <cstdint>

#ifndef PHMASK
#define PHMASK 0xFFFFFFFFFFFFFFFFull
#endif
#ifndef REPMASK
#define REPMASK 0x0ull
#endif
#ifndef N_LAUNCH_MODE
#define N_LAUNCH_MODE 0
#endif

#define LAS __attribute__((address_space(3)))
#define GAS __attribute__((address_space(1)))
typedef unsigned short bf16;
typedef short bf16x8 __attribute__((ext_vector_type(8)));
typedef short s16x4 __attribute__((ext_vector_type(4)));
typedef float f32x4 __attribute__((ext_vector_type(4)));
typedef float f32x2 __attribute__((ext_vector_type(2)));
typedef float f32x16 __attribute__((ext_vector_type(16)));
typedef unsigned u32x4 __attribute__((ext_vector_type(4)));
typedef unsigned u32x2 __attribute__((ext_vector_type(2)));

constexpr int D = 2048, T = 49152, TPR = 16384, CH = 16384, DFF = 8192, NWAVES = 8;
constexpr float EPS = 1e-6f;
__host__ __device__ __forceinline__ int seq_row0(int s) { return s < 8 ? s * 2048 : 16384 + (s - 8) * 4096; }
__host__ __device__ __forceinline__ int seq_len(int s) { return s < 8 ? 2048 : 4096; }

constexpr size_t MiB = 1u << 20;
constexpr size_t WS_CTL = 0, CTL_BYTES = 4 * MiB;
constexpr size_t WS_SS0 = 1 * MiB, WS_RSTD = 2 * MiB;
constexpr size_t WS_ROPE = 4 * MiB;
constexpr size_t WS_MEMRS = 5 * MiB;
constexpr size_t WS_MLA_WIN = 6 * MiB, WS_MLA_WQB = 16 * MiB, WS_MLA_WKVB = 22 * MiB, WS_MLA_WO = 32 * MiB;
constexpr size_t WS_HG_WIN = 48 * MiB, WS_HG_WO = 88 * MiB, WS_FN_WO = 96 * MiB;
constexpr size_t WS_MEM_WQ = 104 * MiB, WS_MEM_WKV = 112 * MiB, WS_MEM_WO = 128 * MiB;
constexpr size_t WS_W1 = 136 * MiB, WS_W2 = 168 * MiB;
constexpr size_t WS_DC = 200 * MiB, WS_DL2 = 204 * MiB, WS_DL4 = 220 * MiB;
constexpr size_t WS_MEMB = 284 * MiB, WS_MEMKV = 300 * MiB;
constexpr size_t WS_H = 332 * MiB;
constexpr size_t WS_S = 524 * MiB;
constexpr size_t WS_SSP = 1036 * MiB;
constexpr size_t WS_END = 1044 * MiB;
constexpr size_t S_P = WS_S, S_QC = WS_S + 120 * MiB, S_KVC = WS_S + 216 * MiB;
constexpr size_t S_Z = WS_S, S_OF = WS_S + 320 * MiB, S_OB = WS_S + 384 * MiB;
constexpr size_t S_HE = WS_S, S_HO = WS_S + 96 * MiB, S_T1 = WS_S + 192 * MiB;
constexpr size_t WS_XCMID = WS_MEMRS + 65536;
constexpr size_t S_QM = WS_S, S_OM = WS_S + 48 * MiB;
constexpr size_t S_HID = WS_S;
constexpr int CW_TMO = 0, CW_BAR = 4096;

typedef __bf16 bf16x2_t __attribute__((ext_vector_type(2)));
__device__ __forceinline__ unsigned cvt_pk_bf16(float lo, float hi) { const f32x2 f = {lo, hi}; const bf16x2_t v = __builtin_convertvector(f, bf16x2_t); return __builtin_bit_cast(unsigned, v); }
__device__ __forceinline__ float bf2f(unsigned short b) { return __uint_as_float(((unsigned)b) << 16); }
__device__ __forceinline__ float bflo(unsigned w) { return __uint_as_float(w << 16); }
__device__ __forceinline__ float bfhi(unsigned w) { return __uint_as_float(w & 0xffff0000u); }
__device__ __forceinline__ float shx(float v, int m, int lane) { return __int_as_float(__builtin_amdgcn_ds_bpermute((lane ^ m) << 2, __float_as_int(v))); }
__device__ __forceinline__ float shl_(float v, int src) { return __int_as_float(__builtin_amdgcn_ds_bpermute(src << 2, __float_as_int(v))); }
__device__ __forceinline__ float wave_sum(float v, int lane) {
#pragma unroll
    for (int o = 1; o < 64; o <<= 1) v += shx(v, o, lane);
    return v;
}
__device__ __forceinline__ int opaque_tid() { int t = threadIdx.x; asm volatile("" : "+v"(t)); return t; }
__device__ __forceinline__ const float* in_ptr(int i) {
    const __attribute__((address_space(4))) char* ka = (const __attribute__((address_space(4))) char*)__builtin_amdgcn_kernarg_segment_ptr();
    int off = i * 8; asm volatile("" : "+s"(off));
    const float* p = *(const float* const __attribute__((address_space(4)))*)(ka + off);
    return (const float*)(const __attribute__((address_space(1))) float*)p;
}
__device__ __forceinline__ size_t LO(size_t v) { asm volatile("" : "+s"(v)); return v; }
__device__ __forceinline__ int launder_i(int v) { asm volatile("" : "+s"(v)); return v; }
__device__ __forceinline__ unsigned char* launder_p(unsigned char* p) { unsigned z = 0u; asm volatile("" : "+s"(z)); return p + z; }
#define LDS_WAIT() asm volatile("s_waitcnt lgkmcnt(0)" ::: "memory")
#define VM_WAIT() asm volatile("s_waitcnt vmcnt(0)" ::: "memory")

namespace pg8 {
constexpr int BM = 256, BK = 64, HALF = 128, HTB = HALF * BK * 2, STAGE_BYTES = 8 * HTB, NXCD = 8;
__host__ __device__ __forceinline__ int lds_byte(int r, int c) { const int st = (r >> 4) * 2 + (c >> 5), rr = r & 15, cc = c & 31, ob = rr * 64 + cc * 2; return st * 1024 + (ob ^ (((ob >> 9) & 1) << 5)); }
__host__ __device__ __forceinline__ void stage_rc(int b, int& R, int& C) { const int st = b / 1024, sb = b % 1024, swz = sb ^ (((sb >> 9) & 1) << 5); R = (st >> 1) * 16 + swz / 64; C = (st & 1) * 32 + (swz % 64) / 2; }
__host__ __device__ __forceinline__ int perm32(int rho) { const int n = rho >> 4, i = rho & 15; return 8 * (i >> 2) + 4 * n + (i & 3); }

struct Unit { int pm, pn; const char* a; const char* b; long ooff; long aoff; int roff; };

struct TileOrder {
    const char* A; const char* B; int lda, ldb, nM, nN, nwg, G, c, pm0, WGM;
    __device__ __forceinline__ void init(const void* A_, int lda_, const void* B_, int ldb_, int pm0_, int nM_, int nN_, int G_, int c_, int wgm_ = 4) {
        A = (const char*)A_; B = (const char*)B_; lda = lda_; ldb = ldb_; pm0 = pm0_; nM = nM_; nN = nN_; nwg = nM_ * nN_; G = G_; c = c_; WGM = wgm_; }
    __device__ __forceinline__ bool next(int i, Unit& u) const {
        const long L = (long)i * G + c; if (L >= nwg) return false;
        int wgid = (int)L; { const int q = nwg / NXCD, r = nwg % NXCD, xcd = wgid % NXCD, off = wgid / NXCD; wgid = (xcd < r ? xcd * (q + 1) : r * (q + 1) + (xcd - r) * q) + off; }
        const int nig = WGM * nN, gid = wgid / nig, fm = gid * WGM, gsz = (nM - fm) < WGM ? (nM - fm) : WGM;
        u.pm = pm0 + fm + ((wgid % nig) % gsz); u.pn = (wgid % nig) / gsz;
        u.a = A + (size_t)u.pm * 256 * lda * 2; u.b = B + (size_t)u.pn * 256 * ldb * 2; u.ooff = 0; u.aoff = 0; u.roff = 0; return true;
    }
};

template <int RS  , int ACT  > struct EpiBf16 {
    static constexpr bool PERM = true;
    bf16* O; int ldc; const float* rs; int rsw; float cs;
    __device__ __forceinline__ void operator()(const f32x4 (&acc)[2][2][4][2], const Unit& u, int wr, int wc, int fr, int fq) const {
        const int row0 = u.pm * BM + wr * 64 + fr, col0 = u.pn * BM + wc * 32 + 8 * fq;
#pragma unroll
        for (int ai = 0; ai < 2; ++ai)
#pragma unroll
            for (int m = 0; m < 4; ++m) { const int row = row0 + ai * HALF + m * 16; float s = cs;
                if (RS == 1) s *= rs[row];
                if (RS == 2) s *= rsqrtf(rs[2 * row + rsw] * (1.0f / 512.0f) + EPS);
                if (RS == 3) { const f32x4* pp = (const f32x4*)(rs + (size_t)row * 32); float t = 0.f;
#pragma unroll
                    for (int j = 0; j < 8; ++j) { const f32x4 v = pp[j]; t += (v.x + v.y) + (v.z + v.w); }
                    s *= rsqrtf(t * (1.f / D) + EPS); }
                bf16* rowp = O + u.ooff + (size_t)row * ldc + col0;
#pragma unroll
                for (int bj = 0; bj < 2; ++bj) { f32x4 v0 = acc[ai][bj][m][0] * s, v1 = acc[ai][bj][m][1] * s;
                    if (RS == 4) { const f32x4 c0 = *(const f32x4*)(rs + u.roff + col0 + bj * HALF), c1 = *(const f32x4*)(rs + u.roff + col0 + bj * HALF + 4); v0 = v0 * c0; v1 = v1 * c1; }
                    if (RS == 5) { const f32x4 c0 = *(const f32x4*)(rs + u.roff + col0 + bj * HALF), c1 = *(const f32x4*)(rs + u.roff + col0 + bj * HALF + 4); const float sg = (row & 1) ? -s : s; v0 = v0 + c0 * sg; v1 = v1 + c1 * sg; }
                    if (ACT == 1) {
#pragma unroll
                        for (int j = 0; j < 4; ++j) { const float a = fmaxf(v0[j], 0.f), b = fmaxf(v1[j], 0.f); v0[j] = a * a; v1[j] = b * b; } }
                    u32x4 w; w.x = cvt_pk_bf16(v0[0], v0[1]); w.y = cvt_pk_bf16(v0[2], v0[3]); w.z = cvt_pk_bf16(v1[0], v1[1]); w.w = cvt_pk_bf16(v1[2], v1[3]);
                    *(u32x4*)(rowp + bj * HALF) = w; } }
    }
};
template <bool FINAL> struct EpiResid {
    static constexpr bool PERM = true;
    bf16* Xb; float* ssp; float* out;
    __device__ __forceinline__ void operator()(const f32x4 (&acc)[2][2][4][2], const Unit& u, int wr, int wc, int fr, int fq) const {
        const int row0 = u.pm * BM + wr * 64 + fr, col0 = u.pn * BM + wc * 32 + 8 * fq, lane_ = fq * 16 + fr;
        u32x4 o[2][4][2];
#pragma unroll
        for (int ai = 0; ai < 2; ++ai)
#pragma unroll
            for (int m = 0; m < 4; ++m)
#pragma unroll
                for (int bj = 0; bj < 2; ++bj) o[ai][m][bj] = *(const u32x4*)(Xb + (size_t)(row0 + ai * HALF + m * 16) * D + col0 + bj * HALF);
#pragma unroll
        for (int ai = 0; ai < 2; ++ai) {
#pragma unroll
            for (int m = 0; m < 4; ++m) { const int row = row0 + ai * HALF + m * 16; bf16* xp = Xb + (size_t)row * D + col0; float q = 0.f;
#pragma unroll
                for (int bj = 0; bj < 2; ++bj) { const u32x4 ov = o[ai][m][bj];
                    f32x4 v0 = acc[ai][bj][m][0], v1 = acc[ai][bj][m][1];
                    v0[0] += bflo(ov[0]); v0[1] += bfhi(ov[0]); v0[2] += bflo(ov[1]); v0[3] += bfhi(ov[1]); v1[0] += bflo(ov[2]); v1[1] += bfhi(ov[2]); v1[2] += bflo(ov[3]); v1[3] += bfhi(ov[3]);
                    if (FINAL) { float* op = out + (size_t)row * D + col0 + bj * HALF; *(f32x4*)op = v0; *(f32x4*)(op + 4) = v1; }
                    else { u32x4 w; w.x = cvt_pk_bf16(v0[0], v0[1]); w.y = cvt_pk_bf16(v0[2], v0[3]); w.z = cvt_pk_bf16(v1[0], v1[1]); w.w = cvt_pk_bf16(v1[2], v1[3]);
                        *(u32x4*)(xp + bj * HALF) = w;
#pragma unroll
                        for (int j = 0; j < 4; ++j) { const float a = bflo(w[j]), b = bfhi(w[j]); q += a * a + b * b; } } }
                if (!FINAL) { q += shx(q, 16, lane_); q += shx(q, 32, lane_); if (fq == 0) ssp[(size_t)row * 32 + u.pn * 4 + wc] = q; } }
            asm volatile("" ::: "memory"); }
    }
};

struct EpiFnetSym {
    static constexpr bool PERM = true;
    bf16* Y; const bf16* Ab; const float* xcm; int L; float cs;
    __device__ __forceinline__ void operator()(const f32x4 (&acc)[2][2][4][2], const Unit& u, int wr, int wc, int fr, int fq) const {
        const int row0 = u.pm * BM + wr * 64 + fr, col0 = u.pn * BM + wc * 32 + 8 * fq;
        f32x4 b0[2], b1[2];
#pragma unroll
        for (int bj = 0; bj < 2; ++bj) { b0[bj] = *(const f32x4*)(xcm + u.roff + col0 + bj * HALF); b1[bj] = *(const f32x4*)(xcm + u.roff + col0 + bj * HALF + 4); }
#pragma unroll
        for (int ai = 0; ai < 2; ++ai)
#pragma unroll
            for (int m = 0; m < 4; ++m) { const int row = row0 + ai * HALF + m * 16; const float sg = (row & 1) ? -1.f : 1.f;
                const bf16* ap = Ab + u.aoff + (size_t)row * 512 + col0;
                bf16* y1 = Y + u.ooff + (size_t)row * D + col0; bf16* y2 = Y + u.ooff + (size_t)(L - row) * D + col0;
#pragma unroll
                for (int bj = 0; bj < 2; ++bj) { const u32x4 a = *(const u32x4*)(ap + bj * HALF);
                    f32x4 a0 = {bflo(a[0]), bfhi(a[0]), bflo(a[1]), bfhi(a[1])}, a1 = {bflo(a[2]), bfhi(a[2]), bflo(a[3]), bfhi(a[3])};
                    a0 = a0 + b0[bj] * sg; a1 = a1 + b1[bj] * sg;
                    const f32x4 p0 = (a0 + acc[ai][bj][m][0]) * cs, p1 = (a1 + acc[ai][bj][m][1]) * cs, q0 = (a0 - acc[ai][bj][m][0]) * cs, q1 = (a1 - acc[ai][bj][m][1]) * cs;
                    u32x4 w; w.x = cvt_pk_bf16(p0[0], p0[1]); w.y = cvt_pk_bf16(p0[2], p0[3]); w.z = cvt_pk_bf16(p1[0], p1[1]); w.w = cvt_pk_bf16(p1[2], p1[3]);
                    *(u32x4*)(y1 + bj * HALF) = w;
                    if (row > 0) { u32x4 v; v.x = cvt_pk_bf16(q0[0], q0[1]); v.y = cvt_pk_bf16(q0[2], q0[3]); v.z = cvt_pk_bf16(q1[0], q1[1]); v.w = cvt_pk_bf16(q1[2], q1[3]);
                        *(u32x4*)(y2 + bj * HALF) = v; } } }
    }
};

template <class Epi, class Sched>
__device__ __forceinline__ void gemm_phase(LAS unsigned char* lds, const int K, const int lda, const int ldb, const Sched& S, const Epi& E) {
    const int tid = opaque_tid(), wid = __builtin_amdgcn_readfirstlane(tid >> 6), lane = tid & 63, wr = wid >> 2, wc = wid & 3, fr = lane & 15, fq = lane >> 4;
    const int nt = K / BK;
    unsigned voffA[2], voffB[2];
#pragma unroll
    for (int i = 0; i < 2; ++i) { int R, C; stage_rc(tid * 16 + i * 8192, R, C); const int Rb = Epi::PERM ? ((R & ~31) + perm32(R & 31)) : R;
        voffA[i] = (unsigned)(R * lda + C) * 2u; voffB[i] = (unsigned)(Rb * ldb + C) * 2u; }
    const size_t kstep = (size_t)(BK * 2);
    const size_t hstepA = (size_t)HALF * lda * 2, hstepB = (size_t)HALF * ldb * 2;
    const unsigned ldsw = (unsigned)wid * 1024u;
    const int aoff = lds_byte(wr * 64 + fr, fq * 8), boff = lds_byte(wc * 32 + fr, fq * 8);
#define PG8_SA(b, h) (((b) * 2 + (h)) * HTB)
#define PG8_SB(b, h) ((4 + (b) * 2 + (h)) * HTB)
#define PG8_STAGE(bufoff, gbase, voff) do { _Pragma("unroll") for (int _i = 0; _i < 2; ++_i) \
        __builtin_amdgcn_global_load_lds((const unsigned*)((const char*)(gbase) + (voff)[_i]), (LAS unsigned*)(lds + (bufoff) + ldsw + _i * 8192), 16, 0, 0); } while (0)
#define PG8_LDA(dst, b, h) do { _Pragma("unroll") for (int m = 0; m < 4; ++m) _Pragma("unroll") for (int k = 0; k < 2; ++k) dst[m][k] = *(const LAS bf16x8*)(lds + PG8_SA(b, h) + aoff + m * 2048 + k * 1024); } while (0)
#define PG8_LDB(dst, b, h) do { _Pragma("unroll") for (int n = 0; n < 2; ++n) _Pragma("unroll") for (int k = 0; k < 2; ++k) dst[n][k] = *(const LAS bf16x8*)(lds + PG8_SB(b, h) + boff + n * 2048 + k * 1024); } while (0)
#define PG8_MMA(ai, bj, At, Bt) do { __builtin_amdgcn_s_setprio(1); _Pragma("unroll") for (int m = 0; m < 4; ++m) _Pragma("unroll") for (int n = 0; n < 2; ++n) _Pragma("unroll") for (int k = 0; k < 2; ++k) \
        acc[ai][bj][m][n] = __builtin_amdgcn_mfma_f32_16x16x32_bf16(Bt[n][k], At[m][k], acc[ai][bj][m][n], 0, 0, 0); __builtin_amdgcn_s_setprio(0); } while (0)
#define PG8_WAIT_V(n) asm volatile("s_waitcnt vmcnt(" #n ")" ::: "memory")
#define PG8_WAIT_L(n) asm volatile("s_waitcnt lgkmcnt(" #n ")" ::: "memory")
#define PG8_BAR __builtin_amdgcn_s_barrier()
#define PG8_SCHED __builtin_amdgcn_sched_barrier(0)
    Unit cur, nxt; int ui = 0;
    if (!S.next(0, cur)) return;
    f32x4 acc[2][2][4][2];
#pragma unroll
    for (int a = 0; a < 2; ++a)
#pragma unroll
        for (int b = 0; b < 2; ++b)
#pragma unroll
            for (int m = 0; m < 4; ++m)
#pragma unroll
                for (int n = 0; n < 2; ++n) acc[a][b][m][n] = (f32x4){0.f, 0.f, 0.f, 0.f};
    bf16x8 At[4][2], B0[2][2], B1[2][2];
    const char* cA = cur.a; const char* cB = cur.b;
    PG8_STAGE(PG8_SB(0, 0), cB, voffB); PG8_STAGE(PG8_SB(0, 1), cB + hstepB, voffB); PG8_STAGE(PG8_SA(0, 0), cA, voffA); PG8_STAGE(PG8_SA(0, 1), cA + hstepA, voffA);
    if (wr == 1) PG8_BAR;
    PG8_WAIT_V(2); PG8_BAR;
    PG8_STAGE(PG8_SB(1, 0), cB + kstep, voffB); PG8_STAGE(PG8_SA(1, 0), cA + kstep, voffA); PG8_STAGE(PG8_SB(1, 1), cB + hstepB + kstep, voffB);
    PG8_WAIT_V(6); PG8_BAR;
    for (;;) {
        const bool has_next = S.next(ui + 1, nxt);
        const char* nA = has_next ? nxt.a : cA; const char* nB = has_next ? nxt.b : cB;
        for (int t = 0; t < nt; t += 2) {
            const bool last = (t == nt - 2);
            const char* a1 = cA + (size_t)(t + 1) * kstep;
            const char* a2 = last ? nA : cA + (size_t)(t + 2) * kstep; const char* b2 = last ? nB : cB + (size_t)(t + 2) * kstep;
            const char* a3 = a2 + kstep; const char* b3 = b2 + kstep;
            PG8_LDB(B0, 0, 0); PG8_LDB(B1, 0, 1); PG8_SCHED; PG8_LDA(At, 0, 0); PG8_STAGE(PG8_SA(1, 1), a1 + hstepA, voffA);
            PG8_WAIT_V(8); PG8_WAIT_L(0); PG8_BAR; PG8_MMA(0, 0, At, B0); PG8_MMA(0, 1, At, B1); PG8_BAR; PG8_SCHED;
            PG8_LDA(At, 0, 1); PG8_STAGE(PG8_SB(0, 0), b2, voffB); PG8_STAGE(PG8_SB(0, 1), b2 + hstepB, voffB); PG8_STAGE(PG8_SA(0, 0), a2, voffA);
            PG8_WAIT_V(8); PG8_WAIT_L(0); PG8_BAR; PG8_MMA(1, 0, At, B0); PG8_MMA(1, 1, At, B1); PG8_BAR; PG8_SCHED;
            PG8_LDB(B0, 1, 0); PG8_LDB(B1, 1, 1); PG8_SCHED; PG8_LDA(At, 1, 0); PG8_STAGE(PG8_SA(0, 1), a2 + hstepA, voffA);
            PG8_WAIT_V(8); PG8_WAIT_L(0); PG8_BAR; PG8_MMA(0, 0, At, B0); PG8_MMA(0, 1, At, B1); PG8_BAR; PG8_SCHED;
            PG8_LDA(At, 1, 1); PG8_STAGE(PG8_SB(1, 0), b3, voffB); PG8_STAGE(PG8_SB(1, 1), b3 + hstepB, voffB); PG8_STAGE(PG8_SA(1, 0), a3, voffA);
            PG8_WAIT_V(8); PG8_WAIT_L(0); PG8_BAR; PG8_MMA(1, 0, At, B0); PG8_MMA(1, 1, At, B1); PG8_BAR; PG8_SCHED;
        }
        if (wr == 0) PG8_BAR;
        E(acc, cur, wr, wc, fr, fq);
        if (!has_next) break;
#pragma unroll
        for (int a = 0; a < 2; ++a)
#pragma unroll
            for (int b = 0; b < 2; ++b)
#pragma unroll
                for (int m = 0; m < 4; ++m)
#pragma unroll
                    for (int n = 0; n < 2; ++n) acc[a][b][m][n] = (f32x4){0.f, 0.f, 0.f, 0.f};
        cur = nxt; cA = nA; cB = nB; ++ui;
        if (wr == 1) PG8_BAR;
    }
    PG8_WAIT_V(0);
    PG8_BAR;
#undef PG8_SA
#undef PG8_SB
#undef PG8_STAGE
#undef PG8_LDA
#undef PG8_LDB
#undef PG8_MMA
#undef PG8_WAIT_V
#undef PG8_WAIT_L
#undef PG8_BAR
#undef PG8_SCHED
}
}

namespace att {
constexpr int NW = 8, QBLK = 32, KVBLK = 64, DV = 128;
constexpr int SHM_V = KVBLK * DV * 2;
template <int DQK> struct Geo { static constexpr int KROW = DQK * 2, SHM_K = KVBLK * KROW, NQ = DQK / 16, CPR = DQK / 8  , NKI = SHM_K / 8192  ; };
template <int DQK> __device__ __forceinline__ int kswz(int row) { return DQK == 192 ? ((row >> 1) & 7) : (row & 15); }
#define SBAR() __builtin_amdgcn_sched_barrier(0)
__device__ __forceinline__ int crow(int r, int hi) { return (r & 3) + 8 * (r >> 2) + 4 * hi; }
__device__ __forceinline__ void partialSM(f32x16& p0, f32x16& p1, float& m_reg, float& mn, float& alpha, const float C, const float thr) {
    float pmax = p0[0];
#pragma unroll
    for (int r = 1; r < 16; ++r) pmax = fmaxf(pmax, p0[r]);
#pragma unroll
    for (int r = 0; r < 16; ++r) pmax = fmaxf(pmax, p1[r]);
    { auto rr = __builtin_amdgcn_permlane32_swap(__float_as_uint(pmax), __float_as_uint(pmax), false, false);
      pmax = fmaxf(__uint_as_float(rr[0]), __uint_as_float(rr[1])); }
    if (__builtin_expect(__all(pmax - m_reg <= thr), 1)) { mn = m_reg; alpha = 1.f; }
    else { mn = fmaxf(m_reg, pmax); alpha = __builtin_amdgcn_exp2f((m_reg - mn) * C); m_reg = mn; }
    const float mnC = -mn * C;
#pragma unroll
    for (int r = 0; r < 16; ++r) p0[r] = fmaf(p0[r], C, mnC);
#pragma unroll
    for (int r = 0; r < 16; ++r) p1[r] = fmaf(p1[r], C, mnC);
#pragma unroll
    for (int r = 0; r < 16; ++r) p0[r] = __builtin_amdgcn_exp2f(p0[r]);
}
__device__ __forceinline__ void finishSM(f32x16& p0, f32x16& p1, float alpha, float& l_reg, bf16x8& pa0, bf16x8& pa1, bf16x8& pa2, bf16x8& pa3) {
#pragma unroll
    for (int r = 0; r < 16; ++r) p1[r] = __builtin_amdgcn_exp2f(p1[r]);
    float ps = 0;
#pragma unroll
    for (int r = 0; r < 16; ++r) ps += p0[r];
#pragma unroll
    for (int r = 0; r < 16; ++r) ps += p1[r];
    { auto rr = __builtin_amdgcn_permlane32_swap(__float_as_uint(ps), __float_as_uint(ps), false, false);
      ps = __uint_as_float(rr[0]) + __uint_as_float(rr[1]); }
    l_reg = l_reg * alpha + ps;
#define PK4(P, BASE, OUT) do { unsigned a0 = cvt_pk_bf16(P[BASE + 0], P[BASE + 1]), a1 = cvt_pk_bf16(P[BASE + 2], P[BASE + 3]);   \
    unsigned b0 = cvt_pk_bf16(P[BASE + 4], P[BASE + 5]), b1 = cvt_pk_bf16(P[BASE + 6], P[BASE + 7]);                              \
    auto r0 = __builtin_amdgcn_permlane32_swap(a0, b0, false, false); auto r1 = __builtin_amdgcn_permlane32_swap(a1, b1, false, false); \
    u32x4 w = {r0[0], r1[0], r0[1], r1[1]}; OUT = *reinterpret_cast<bf16x8*>(&w); } while (0)
    PK4(p0, 0, pa0); PK4(p0, 8, pa1); PK4(p1, 0, pa2); PK4(p1, 8, pa3);
#undef PK4
}
template <int DQK> struct KAddr { static constexpr int KB = DQK == 192 ? 4 : 8; };
template <int DQK>
__device__ __forceinline__ void qkt(f32x16& p0, f32x16& p1, const char* Ksl  , const bf16x8* qr, const int (&kb)[KAddr<DQK>::KB]) {
    p0 = f32x16{}; p1 = f32x16{};
    constexpr int NQ = Geo<DQK>::NQ, RB = 32 * Geo<DQK>::KROW, KB = KAddr<DQK>::KB;
#define KOFF(d0) (kb[(d0) % KB] + ((d0) / KB) * 32 * KB)
    bf16x8 f0[3], f1[3];
#pragma unroll
    for (int d0 = 0; d0 < 2; ++d0) { f0[d0] = *reinterpret_cast<const bf16x8*>(Ksl + KOFF(d0)); f1[d0] = *reinterpret_cast<const bf16x8*>(Ksl + KOFF(d0) + RB); }
    __builtin_amdgcn_sched_group_barrier(0x100, 4, 0);
#pragma unroll
    for (int d0 = 0; d0 < NQ; ++d0) {
        if (d0 + 2 < NQ) { f0[(d0 + 2) % 3] = *reinterpret_cast<const bf16x8*>(Ksl + KOFF(d0 + 2)); f1[(d0 + 2) % 3] = *reinterpret_cast<const bf16x8*>(Ksl + KOFF(d0 + 2) + RB); }
        p0 = __builtin_amdgcn_mfma_f32_32x32x16_bf16(f0[d0 % 3], qr[d0], p0, 0, 0, 0);
        p1 = __builtin_amdgcn_mfma_f32_32x32x16_bf16(f1[d0 % 3], qr[d0], p1, 0, 0, 0);
        __builtin_amdgcn_sched_group_barrier(0x100, 2, 0); __builtin_amdgcn_sched_group_barrier(0x8, 2, 0); }
#undef KOFF
}
__device__ __forceinline__ int v_st(int k, int c) { const int kk = (k & ~0xC) | ((k & 4) << 1) | ((k & 8) >> 1); return ((kk >> 3) * 4 + (c >> 5)) * 512 + ((kk & 7) * 32 + (c & 31)) * 2; }
__device__ __forceinline__ int v_rd_base(int lane) { return ((lane & 3) << 3) | (((lane >> 2) & 3) << 6) | (((lane >> 4) & 1) << 5) | (((lane >> 5) & 1) << 8); }
constexpr int v_rd_off(int d0, int ks, int half) { return d0 * 512 + ks * 4096 + half * 2048; }
template <int OFF> __device__ __forceinline__ s16x4 tr_read(int vb) {
    s16x4 r; asm volatile("ds_read_b64_tr_b16 %0, %1 offset:%2" : "=&v"(r) : "v"(vb), "i"(OFF) : "memory"); return r;
}
template <int D0> __device__ __forceinline__ void pv_one(f32x16& od, int vb, bf16x8 pa0, bf16x8 pa1, bf16x8 pa2, bf16x8 pa3) {
    const s16x4 l0 = tr_read<v_rd_off(D0, 0, 0)>(vb), h0 = tr_read<v_rd_off(D0, 0, 1)>(vb), l1 = tr_read<v_rd_off(D0, 1, 0)>(vb), h1 = tr_read<v_rd_off(D0, 1, 1)>(vb);
    const s16x4 l2 = tr_read<v_rd_off(D0, 2, 0)>(vb), h2 = tr_read<v_rd_off(D0, 2, 1)>(vb), l3 = tr_read<v_rd_off(D0, 3, 0)>(vb), h3 = tr_read<v_rd_off(D0, 3, 1)>(vb);
    asm volatile("s_waitcnt lgkmcnt(0)" ::: "memory"); SBAR();
#define PK(L, H) (bf16x8){L[0], L[1], L[2], L[3], H[0], H[1], H[2], H[3]}
    od = __builtin_amdgcn_mfma_f32_32x32x16_bf16(pa0, PK(l0, h0), od, 0, 0, 0);
    od = __builtin_amdgcn_mfma_f32_32x32x16_bf16(pa1, PK(l1, h1), od, 0, 0, 0);
    od = __builtin_amdgcn_mfma_f32_32x32x16_bf16(pa2, PK(l2, h2), od, 0, 0, 0);
    od = __builtin_amdgcn_mfma_f32_32x32x16_bf16(pa3, PK(l3, h3), od, 0, 0, 0);
#undef PK
}
__device__ __forceinline__ void pv_d0(f32x16* o, int vb, bf16x8 pa0, bf16x8 pa1, bf16x8 pa2, bf16x8 pa3) {
    pv_one<0>(o[0], vb, pa0, pa1, pa2, pa3); pv_one<1>(o[1], vb, pa0, pa1, pa2, pa3); pv_one<2>(o[2], vb, pa0, pa1, pa2, pa3); pv_one<3>(o[3], vb, pa0, pa1, pa2, pa3);
}

template <int DQK, bool ROPE>
__device__ __forceinline__ void attn_unit(const bf16* __restrict__ Qb, int ldq, const bf16* __restrict__ Kh, int ldk, const bf16* __restrict__ Vh, int ldv,
                                          bf16* __restrict__ Ob, int ldo, int nkeys, const float* __restrict__ qg, const float* __restrict__ ropec, const float* __restrict__ ropes,
                                          int pos0, const float sm_scale, const float* __restrict__ qrs, char* lds) {
    using G = Geo<DQK>; constexpr int NQ = G::NQ;
    const int tid = opaque_tid(), wid = __builtin_amdgcn_readfirstlane(tid >> 6), lane = tid & 63, r32 = lane & 31, hi = lane >> 5;
    char* V_lds = lds; char* K_lds = lds + 3 * SHM_V;
    float* wsp = (float*)(lds + 3 * SHM_V + 2 * G::SHM_K) + wid * 64; float* li_l = wsp; float* al_l = wsp + 32;
    const float C = sm_scale * 1.4426950408889634f, thr = 8.f / sm_scale;
    float m_reg = -1e30f, l_reg = 0; f32x16 o[4] = {}; bf16x8 qr[NQ];
    {
        const bf16* Qw = Qb + (long)(wid * QBLK + r32) * ldq + hi * 8;
        u32x4 raw[NQ]; float ssq = 0.f;
#pragma unroll
        for (int d0 = 0; d0 < NQ; ++d0) { raw[d0] = *reinterpret_cast<const u32x4*>(Qw + d0 * 16);
#pragma unroll
            for (int j = 0; j < 4; ++j) { const float a = bflo(raw[d0][j]), b = bfhi(raw[d0][j]); ssq += a * a + b * b; } }
        ssq += shx(ssq, 32, lane);
        const float qs_ = qrs ? qrs[wid * QBLK + r32] : 1.f;
        const float rstd = qs_ * rsqrtf(qs_ * qs_ * ssq * (1.0f / DQK) + EPS);
        constexpr int NPLAIN = ROPE ? 8 : NQ;
#pragma unroll
        for (int d0 = 0; d0 < NPLAIN; ++d0) { const f32x4 g0 = *reinterpret_cast<const f32x4*>(qg + d0 * 16 + hi * 8), g1 = *reinterpret_cast<const f32x4*>(qg + d0 * 16 + hi * 8 + 4);
            u32x4 w;
#pragma unroll
            for (int j = 0; j < 4; ++j) { const float gl = j < 2 ? g0[2 * j] : g1[2 * j - 4], gh = j < 2 ? g0[2 * j + 1] : g1[2 * j - 3]; w[j] = cvt_pk_bf16(bflo(raw[d0][j]) * rstd * gl, bfhi(raw[d0][j]) * rstd * gh); }
            qr[d0] = *reinterpret_cast<bf16x8*>(&w); }
        if constexpr (ROPE) {
            const long pos = pos0 + wid * QBLK + r32;
#pragma unroll
            for (int dd = 0; dd < 2; ++dd) { const int d0 = 8 + dd, i0 = dd * 16 + hi * 8;
                float cs[8], sn[8], ga[8], gb[8];
                { const f32x4 c0 = *reinterpret_cast<const f32x4*>(ropec + pos * 32 + i0), c1 = *reinterpret_cast<const f32x4*>(ropec + pos * 32 + i0 + 4);
                  const f32x4 s0 = *reinterpret_cast<const f32x4*>(ropes + pos * 32 + i0), s1 = *reinterpret_cast<const f32x4*>(ropes + pos * 32 + i0 + 4);
                  const f32x4 a0 = *reinterpret_cast<const f32x4*>(qg + d0 * 16 + hi * 8), a1 = *reinterpret_cast<const f32x4*>(qg + d0 * 16 + hi * 8 + 4);
                  const f32x4 b0 = *reinterpret_cast<const f32x4*>(qg + (d0 + 2) * 16 + hi * 8), b1 = *reinterpret_cast<const f32x4*>(qg + (d0 + 2) * 16 + hi * 8 + 4);
#pragma unroll
                  for (int j = 0; j < 4; ++j) { cs[j] = c0[j]; cs[4 + j] = c1[j]; sn[j] = s0[j]; sn[4 + j] = s1[j]; ga[j] = a0[j]; ga[4 + j] = a1[j]; gb[j] = b0[j]; gb[4 + j] = b1[j]; } }
                u32x4 w1, w2;
#pragma unroll
                for (int j = 0; j < 4; ++j) {
                    const float x1l = bflo(raw[d0][j]) * rstd * ga[2 * j], x1h = bfhi(raw[d0][j]) * rstd * ga[2 * j + 1];
                    const float x2l = bflo(raw[d0 + 2][j]) * rstd * gb[2 * j], x2h = bfhi(raw[d0 + 2][j]) * rstd * gb[2 * j + 1];
                    w1[j] = cvt_pk_bf16(x1l * cs[2 * j] - x2l * sn[2 * j], x1h * cs[2 * j + 1] - x2h * sn[2 * j + 1]);
                    w2[j] = cvt_pk_bf16(x1l * sn[2 * j] + x2l * cs[2 * j], x1h * sn[2 * j + 1] + x2h * cs[2 * j + 1]); }
                qr[d0] = *reinterpret_cast<bf16x8*>(&w1); qr[d0 + 2] = *reinterpret_cast<bf16x8*>(&w2); }
        }
    }
    const int vb0 = (int)(uintptr_t)V_lds + v_rd_base(lane);
    unsigned kgo[G::NKI], vgo[2];
#pragma unroll
    for (int t = 0; t < G::NKI; ++t) { const int q = (wid * G::NKI + t) * 64 + lane, row = q / G::CPR, pc = q % G::CPR; kgo[t] = (unsigned)(row * ldk * 2 + ((pc ^ kswz<DQK>(row)) * 16)); }
#pragma unroll
    for (int t = 0; t < 2; ++t) { const int q = (wid * 2 + t) * 64 + lane, sub = q >> 5, within = q & 31; const int kk = ((sub >> 2) << 3) | (within >> 2), cc = (sub & 3) * 32 + (within & 3) * 8;
        const int key = (kk & ~0xC) | ((kk & 4) << 1) | ((kk & 8) >> 1); vgo[t] = (unsigned)(key * ldv * 2 + cc * 2); }
    int koffs[KAddr<DQK>::KB];
#pragma unroll
    for (int d0 = 0; d0 < KAddr<DQK>::KB; ++d0) koffs[d0] = (((2 * d0) | hi) ^ kswz<DQK>(r32)) * 16;
    const char* Kg = (const char*)Kh; const char* Vg = (const char*)Vh;
#define SDMA(tile, kslot, vslot) do { const char* kb_ = Kg + (size_t)(tile) * KVBLK * ldk * 2; const char* vb_ = Vg + (size_t)(tile) * KVBLK * ldv * 2; \
    _Pragma("unroll") for (int t_ = 0; t_ < G::NKI; ++t_) __builtin_amdgcn_global_load_lds((const unsigned*)(kb_ + kgo[t_]), (LAS unsigned*)(K_lds + (kslot) * G::SHM_K + (wid * G::NKI + t_) * 1024), 16, 0, 0); \
    _Pragma("unroll") for (int t_ = 0; t_ < 2; ++t_) __builtin_amdgcn_global_load_lds((const unsigned*)(vb_ + vgo[t_]), (LAS unsigned*)(V_lds + (vslot) * SHM_V + (wid * 2 + t_) * 1024), 16, 0, 0); } while (0)
#define RESC(a) do { if (__any((a) < 1.f)) { if (hi == 0) al_l[r32] = (a); asm volatile("s_waitcnt lgkmcnt(0)" ::: "memory"); \
    _Pragma("unroll") for (int d = 0; d < 4; ++d) _Pragma("unroll") for (int r = 0; r < 16; ++r) o[d][r] *= al_l[crow(r, hi)]; } } while (0)
    f32x16 pA0, pA1, pB0, pB1; float mnA, mnB, alA, alB; bf16x8 pa0, pa1, pa2, pa3; const int NT = nkeys / KVBLK;
    const char* Ksl = K_lds + r32 * G::KROW;
    SDMA(0, 0, 0); __syncthreads();
    SDMA(1, 1, 1);
    qkt<DQK>(pA0, pA1, Ksl, qr, koffs); partialSM(pA0, pA1, m_reg, mnA, alA, C, thr);
    __syncthreads();
    int vs = 0;
    for (int j = 1; j + 1 < NT; j += 2) {
        const int v1 = vs == 2 ? 0 : vs + 1, v2 = v1 == 2 ? 0 : v1 + 1;
        SDMA(j + 1, 0, v2);
        SBAR(); qkt<DQK>(pB0, pB1, Ksl + G::SHM_K, qr, koffs);
        finishSM(pA0, pA1, alA, l_reg, pa0, pa1, pa2, pa3); SBAR();
        pv_d0(o, vb0 + vs * SHM_V, pa0, pa1, pa2, pa3); partialSM(pB0, pB1, m_reg, mnB, alB, C, thr);
        RESC(alB); __syncthreads();
        const int v3 = v2 == 2 ? 0 : v2 + 1;
        SDMA(j + 2, 1, v3);
        SBAR(); qkt<DQK>(pA0, pA1, Ksl, qr, koffs);
        finishSM(pB0, pB1, alB, l_reg, pa0, pa1, pa2, pa3); SBAR();
        pv_d0(o, vb0 + v1 * SHM_V, pa0, pa1, pa2, pa3); partialSM(pA0, pA1, m_reg, mnA, alA, C, thr);
        RESC(alA); __syncthreads();
        vs = v2;
    }
    {   const int v1 = vs == 2 ? 0 : vs + 1;
        SBAR(); qkt<DQK>(pB0, pB1, Ksl + G::SHM_K, qr, koffs);
        finishSM(pA0, pA1, alA, l_reg, pa0, pa1, pa2, pa3); SBAR();
        pv_d0(o, vb0 + vs * SHM_V, pa0, pa1, pa2, pa3); partialSM(pB0, pB1, m_reg, mnB, alB, C, thr);
        RESC(alB);
        finishSM(pB0, pB1, alB, l_reg, pa0, pa1, pa2, pa3); SBAR();
        pv_d0(o, vb0 + v1 * SHM_V, pa0, pa1, pa2, pa3); }
    if (hi == 0) li_l[r32] = l_reg; asm volatile("s_waitcnt lgkmcnt(0)" ::: "memory");
    const int lane_e = opaque_tid() & 63, hi_e = lane_e >> 5;
    float rli[16];
#pragma unroll
    for (int r = 0; r < 16; ++r) rli[r] = __builtin_amdgcn_rcpf(li_l[crow(r, hi_e)]);
    bf16* Ow = Ob + (long)(wid * QBLK) * ldo;
#pragma unroll
    for (int r = 0; r < 16; ++r) { const int orow = crow(r, hi_e);
#pragma unroll
        for (int d0 = 0; d0 < 4; ++d0) Ow[(long)orow * ldo + d0 * 32 + (lane_e & 31)] = (bf16)(cvt_pk_bf16(o[d0][r] * rli[r], 0.f) & 0xffffu); }
    __syncthreads();
#undef SDMA
#undef RESC
}
}

#define XB_TMO      128
#define XB_XCNT(j)  (256  + 64 * (j))
#define XB_XSUB(j)  (1280 + 64 * (j))
#define XB_XGEN(j)  (2304 + 64 * (j))
#define XB_TOP      3328
#define XB_TOPGEN   3392
#define XCD_BAR_WORDS 3456
#define XB_SPIN_CAP (1u << 20)
__device__ __forceinline__ unsigned xb_ld(unsigned* p)              { return __hip_atomic_load(p, __ATOMIC_RELAXED, __HIP_MEMORY_SCOPE_AGENT); }
__device__ __forceinline__ unsigned xb_add(unsigned* p, unsigned v) { return __hip_atomic_fetch_add(p, v, __ATOMIC_RELAXED, __HIP_MEMORY_SCOPE_AGENT); }
__device__ __forceinline__ unsigned xb_xcc_id() { return (unsigned)__builtin_amdgcn_s_getreg((3 << 11) | 20) & 0xFu; }
#define XB_SPIN(cond, bar) do { unsigned _sp = 0; while (cond) { __builtin_amdgcn_s_sleep(1); \
    if ((++_sp & 255u) == 0u) { if (xb_ld(&(bar)[XB_TMO])) break; if (_sp > XB_SPIN_CAP) { atomicAdd(&(bar)[XB_TMO], 1u); break; } } } } while (0)
struct XcdBarrier { unsigned* bar; unsigned x; volatile LAS unsigned* st; };
__device__ __forceinline__ XcdBarrier xcd_barrier_post(unsigned* bar, volatile LAS unsigned* st) {
    XcdBarrier b; b.bar = bar; b.x = xb_xcc_id(); b.st = st;
    if (threadIdx.x == 0) (void)xb_add(&bar[XB_XCNT(b.x)], 1u);
    return b;
}
__device__ __forceinline__ void xcd_barrier_complete(unsigned* bar, unsigned x, unsigned& nloc, unsigned& nx) {
    const unsigned G = gridDim.x * gridDim.y * gridDim.z;
    unsigned sum, cnt, mine, sp = 0u;
    for (;;) {
        sum = 0u; cnt = 0u; mine = 0u;
#pragma unroll
        for (unsigned j = 0; j < 16; ++j) { const unsigned c = xb_ld(&bar[XB_XCNT(j)]); sum += c; cnt += (c > 0u) ? 1u : 0u; mine = (j == x) ? c : mine; }
        if (sum == G) break;
        __builtin_amdgcn_s_sleep(1);
        if ((++sp & 255u) == 0u) { if (xb_ld(&bar[XB_TMO])) break; if (sp > XB_SPIN_CAP) { atomicAdd(&bar[XB_TMO], 1u); break; } }
    }
    nloc = mine > 0u ? mine : 1u; nx = cnt > 0u ? cnt : 1u;
}
__device__ __forceinline__ void xcd_barrier(const XcdBarrier& b) {
    asm volatile("s_waitcnt vmcnt(0)" ::: "memory");
    __syncthreads();
    if (threadIdx.x == 0) {
        unsigned* bar = b.bar;
        __builtin_amdgcn_s_waitcnt(0);
        unsigned nloc = b.st[0], nx = b.st[1];
        if (nloc == 0u) { xcd_barrier_complete(bar, b.x, nloc, nx); b.st[0] = nloc; b.st[1] = nx; }
        const unsigned old = xb_add(&bar[XB_XSUB(b.x)], 1u);
        const unsigned gen = old / nloc;
        if (old + 1u == (gen + 1u) * nloc) {
            __builtin_amdgcn_fence(__ATOMIC_RELEASE, "agent");
            asm volatile("s_waitcnt vmcnt(0)" ::: "memory");
            const unsigned og = xb_add(&bar[XB_TOP], 1u);
            const unsigned tg = og / nx;
            if (og + 1u == (tg + 1u) * nx) xb_add(&bar[XB_TOPGEN], 1u);
            else XB_SPIN(xb_ld(&bar[XB_TOPGEN]) == tg, bar);
            __builtin_amdgcn_fence(__ATOMIC_ACQUIRE, "agent");
            xb_add(&bar[XB_XGEN(b.x)], 1u);
            asm volatile("s_waitcnt vmcnt(0)" ::: "memory");
        } else {
            XB_SPIN(xb_ld(&bar[XB_XGEN(b.x)]) == gen, bar);
            __builtin_amdgcn_fence(__ATOMIC_ACQUIRE, "agent");
            asm volatile("s_waitcnt vmcnt(0)" ::: "memory");
        }
    }
    __syncthreads();
}

template <int MODE>
__device__ __forceinline__ void transpose_item(const float* __restrict__ W, int K, int N, bf16* __restrict__ WT, const float* __restrict__ gk, LAS float* scr, int item, int lane) {
    const int nblk = N / 32, kb = item / nblk, nb = item % nblk, k0 = 64 * kb, n0 = 32 * nb;
#pragma unroll 8
    for (int i = 0; i < 32; ++i) { const int kk = 2 * i + (lane >> 5); float w = W[(size_t)(k0 + kk) * N + n0 + (lane & 31)]; if (gk) w *= gk[k0 + kk]; scr[kk * 33 + (lane & 31)] = w; }
    LDS_WAIT(); asm volatile("" ::: "memory");
    const int c = lane & 7;
#pragma unroll
    for (int j = 0; j < 4; ++j) { const int n = (lane >> 3) + 8 * j; const LAS float* s = scr + (8 * c) * 33 + n;
        u32x4 o; o.x = cvt_pk_bf16(s[0 * 33], s[1 * 33]); o.y = cvt_pk_bf16(s[2 * 33], s[3 * 33]); o.z = cvt_pk_bf16(s[4 * 33], s[5 * 33]); o.w = cvt_pk_bf16(s[6 * 33], s[7 * 33]);
        int nn = n0 + n; if (MODE == 1) { const int hh = nn >> 8, jj = nn & 255; nn = hh * 320 + (jj < 128 ? jj : jj + 64); }
        *(u32x4*)(WT + (size_t)nn * K + k0 + 8 * c) = o; }
    LDS_WAIT(); asm volatile("" ::: "memory");
}
__device__ __forceinline__ void rms_row_to_bf16(const float* __restrict__ xrow, const float* __restrict__ g, bf16* __restrict__ orow, int lane) {
    const f32x4* xr = (const f32x4*)xrow + lane; f32x4 v[8]; float s = 0.f;
#pragma unroll
    for (int j = 0; j < 8; ++j) { v[j] = xr[64 * j]; s += (v[j].x * v[j].x + v[j].y * v[j].y) + (v[j].z * v[j].z + v[j].w * v[j].w); }
    const float r = rsqrtf(wave_sum(s, lane) * (1.f / D) + EPS);
    u32x2* o8 = (u32x2*)orow + lane;
#pragma unroll
    for (int j = 0; j < 8; ++j) { const f32x4 gg = ((const f32x4*)g)[lane + 64 * j]; u32x2 w; w.x = cvt_pk_bf16(v[j].x * r * gg.x, v[j].y * r * gg.y); w.y = cvt_pk_bf16(v[j].z * r * gg.z, v[j].w * r * gg.w); o8[64 * j] = w; }
}

template <int NK>
__device__ __forceinline__ void hgrn_scan_item(const bf16* __restrict__ Zv, int row0, int L, int hh, int dir, int kbase, const float* __restrict__ lbl, bf16* __restrict__ Oo,
                                               LAS unsigned char* lds, const unsigned char* lds_gen, int tid, int lane, int wave) {
    constexpr int NPAIR = NK / 2, NPART = 256 / NPAIR, SPT = 64 / NPART, QROW = NK * 2 + 16, ND0 = NK / 16, NKB = NK / 32;
    constexpr int O_KT = 64 * QROW, O_KTT = 128 * QROW, O_VL = 128 * QROW + NK * 144, O_FAC = O_VL + 16384, BUF = O_FAC + 3 * NK * 4;
    static_assert(2 * BUF + NPART * NK * 4 <= 147328, "HGRN LDS");
    LAS float* TOT = (LAS float*)(lds + 2 * BUF);
    const int nchunk = L >> 6;
#define HG_POS(n) (dir ? (L - 1 - (n)) : (n))
    if (wave >= 4) {
        const int ptid = tid - 256, kp = ptid % NPAIR, part = ptid / NPAIR, vr = ptid >> 4, sc = (ptid & 15) * 8;
        const int zc = hh * 128 + kbase + 2 * kp;
        float lb0, lb1; { const float* lg = lbl + dir * 2048 + zc; const f32x2 l0 = *(const f32x2*)lg, l1 = *(const f32x2*)(lg + 4096), l2 = *(const f32x2*)(lg + 8192), l3 = *(const f32x2*)(lg + 12288);
            { const float mx = fmaxf(fmaxf(l0.x, l1.x), fmaxf(l2.x, l3.x)); const float e0 = __expf(l0.x - mx), e1 = __expf(l1.x - mx), e2 = __expf(l2.x - mx), e3 = __expf(l3.x - mx); lb0 = e1 / (e0 + e1 + e2 + e3); }
            { const float mx = fmaxf(fmaxf(l0.y, l1.y), fmaxf(l2.y, l3.y)); const float e0 = __expf(l0.y - mx), e1 = __expf(l1.y - mx), e2 = __expf(l2.y - mx), e3 = __expf(l3.y - mx); lb1 = e1 / (e0 + e1 + e2 + e3); } }
        int vst[4];
#pragma unroll
        for (int i = 0; i < 4; ++i) vst[i] = att::v_st(vr + 16 * i, sc);
        unsigned hq_[SPT], hz_[SPT]; bf16x8 rv[4];
#define HG_LOAD(ch) do { _Pragma("unroll") for (int i = 0; i < SPT; ++i) { const int n = (ch) * 64 + part * SPT + i; const bf16* zr = Zv + (size_t)(row0 + HG_POS(n)) * 10240 + zc; hq_[i] = *(const unsigned*)zr; hz_[i] = *(const unsigned*)(zr + 2048 + dir * 2048); } \
        _Pragma("unroll") for (int i = 0; i < 4; ++i) rv[i] = *(const bf16x8*)(Zv + (size_t)(row0 + HG_POS((ch) * 64 + vr + 16 * i)) * 10240 + 6144 + hh * 128 + sc); } while (0)
        HG_LOAD(0);
        for (int s = -1; s < nchunk; ++s) {
            const bool work = s + 1 < nchunk; LAS unsigned char* B = lds + ((s + 1) & 1) * BUF;
            float run0[SPT], run1[SPT], kk0[SPT], kk1[SPT]; unsigned qraw[SPT];
            if (work) {
                float a0 = 0.f, a1 = 0.f;
#pragma unroll
                for (int i = 0; i < SPT; ++i) { const float z0 = bflo(hz_[i]), z1 = bfhi(hz_[i]);
                    const float s0 = __builtin_amdgcn_rcpf(1.f + __expf(-z0)), s1 = __builtin_amdgcn_rcpf(1.f + __expf(-z1));
                    const float f0 = lb0 + (1.f - lb0) * s0, f1 = lb1 + (1.f - lb1) * s1;
                    kk0[i] = (1.f - lb0) * (1.f - s0); kk1[i] = (1.f - lb1) * (1.f - s1);
                    a0 += __logf(f0); a1 += __logf(f1); run0[i] = a0; run1[i] = a1; qraw[i] = hq_[i]; }
                *(LAS f32x2*)(TOT + part * NK + 2 * kp) = (f32x2){a0, a1};
#pragma unroll
                for (int i = 0; i < 4; ++i) *(LAS bf16x8*)(B + O_VL + vst[i]) = rv[i];
            }
            __syncthreads();
            if (work) {
                float base0 = 0.f, base1 = 0.f, rr0 = 0.f, rr1 = 0.f, bl0 = 0.f, bl1 = 0.f;
#pragma unroll
                for (int q = 0; q < NPART; ++q) { const f32x2 t = *(const LAS f32x2*)(TOT + q * NK + 2 * kp); if (q < part) { base0 += t.x; base1 += t.y; } if (q < NPART / 2) { rr0 += t.x; rr1 += t.y; } bl0 += t.x; bl1 += t.y; }
                base0 -= rr0; base1 -= rr1;
                unsigned kw0[SPT / 2], kw1[SPT / 2];
#pragma unroll
                for (int i = 0; i < SPT; i += 2) {
                    const float d00 = fminf(fmaxf(base0 + run0[i], -60.f), 60.f), d01 = fminf(fmaxf(base1 + run1[i], -60.f), 60.f);
                    const float d10 = fminf(fmaxf(base0 + run0[i + 1], -60.f), 60.f), d11 = fminf(fmaxf(base1 + run1[i + 1], -60.f), 60.f);
                    const float ka0 = kk0[i] * __expf(-d00), ka1 = kk1[i] * __expf(-d01), kb0 = kk0[i + 1] * __expf(-d10), kb1 = kk1[i + 1] * __expf(-d11);
                    const int st = part * SPT + i;
                    *(LAS unsigned*)(B + st * QROW + kp * 4) = cvt_pk_bf16(bflo(qraw[i]) * __expf(d00), bfhi(qraw[i]) * __expf(d01));
                    *(LAS unsigned*)(B + (st + 1) * QROW + kp * 4) = cvt_pk_bf16(bflo(qraw[i + 1]) * __expf(d10), bfhi(qraw[i + 1]) * __expf(d11));
                    *(LAS unsigned*)(B + O_KT + st * QROW + kp * 4) = cvt_pk_bf16(ka0, ka1);
                    *(LAS unsigned*)(B + O_KT + (st + 1) * QROW + kp * 4) = cvt_pk_bf16(kb0, kb1);
                    kw0[i >> 1] = cvt_pk_bf16(ka0, kb0); kw1[i >> 1] = cvt_pk_bf16(ka1, kb1); }
#pragma unroll
                for (int i = 0; i < SPT / 8; ++i) {
                    *(LAS u32x4*)(B + O_KTT + (2 * kp) * 144 + part * SPT * 2 + 16 * i) = (u32x4){kw0[4 * i], kw0[4 * i + 1], kw0[4 * i + 2], kw0[4 * i + 3]};
                    *(LAS u32x4*)(B + O_KTT + (2 * kp + 1) * 144 + part * SPT * 2 + 16 * i) = (u32x4){kw1[4 * i], kw1[4 * i + 1], kw1[4 * i + 2], kw1[4 * i + 3]}; }
                if (part == 0) { LAS float* FAC = (LAS float*)(B + O_FAC);
                    *(LAS f32x2*)(FAC + 2 * kp) = (f32x2){__expf(rr0), __expf(rr1)}; *(LAS f32x2*)(FAC + NK + 2 * kp) = (f32x2){__expf(bl0), __expf(bl1)}; *(LAS f32x2*)(FAC + 2 * NK + 2 * kp) = (f32x2){__expf(bl0 - rr0), __expf(bl1 - rr1)}; }
                if (s + 2 < nchunk) HG_LOAD(s + 2);
            }
            __syncthreads();
        }
#undef HG_LOAD
    } else {
        const int vb = wave, r32 = lane & 31, hi = lane >> 5;
        f32x16 St[NKB];
#pragma unroll
        for (int i = 0; i < NKB; ++i) St[i] = f32x16{};
#define HG_PK(L_, H_) (bf16x8){L_[0], L_[1], L_[2], L_[3], H_[0], H_[1], H_[2], H_[3]}
#define HG_PK4(P_, BASE_, OUT_) do { unsigned a0_ = cvt_pk_bf16(P_[BASE_ + 0], P_[BASE_ + 1]), a1_ = cvt_pk_bf16(P_[BASE_ + 2], P_[BASE_ + 3]); \
    unsigned b0_ = cvt_pk_bf16(P_[BASE_ + 4], P_[BASE_ + 5]), b1_ = cvt_pk_bf16(P_[BASE_ + 6], P_[BASE_ + 7]); \
    auto r0_ = __builtin_amdgcn_permlane32_swap(a0_, b0_, false, false); auto r1_ = __builtin_amdgcn_permlane32_swap(a1_, b1_, false, false); \
    u32x4 w_ = {r0_[0], r1_[0], r0_[1], r1_[1]}; OUT_ = *reinterpret_cast<bf16x8*>(&w_); } while (0)
        for (int s = -1; s < nchunk; ++s) {
            LAS unsigned char* QT = lds + (s & 1) * BUF; LAS unsigned char* KT = QT + O_KT; LAS unsigned char* KTT = QT + O_KTT; LAS float* FAC = (LAS float*)(QT + O_FAC);
            bf16x8 vf[4]; f32x16 od0 = f32x16{}, od1 = f32x16{};
            if (s >= 0) {
                const int vbase = (int)(uintptr_t)(lds_gen + (s & 1) * BUF + O_VL) + att::v_rd_base(lane) + vb * 512;
                { const s16x4 l0 = att::tr_read<att::v_rd_off(0, 0, 0)>(vbase), h0 = att::tr_read<att::v_rd_off(0, 0, 1)>(vbase), l1 = att::tr_read<att::v_rd_off(0, 1, 0)>(vbase), h1 = att::tr_read<att::v_rd_off(0, 1, 1)>(vbase);
                  const s16x4 l2 = att::tr_read<att::v_rd_off(0, 2, 0)>(vbase), h2 = att::tr_read<att::v_rd_off(0, 2, 1)>(vbase), l3 = att::tr_read<att::v_rd_off(0, 3, 0)>(vbase), h3 = att::tr_read<att::v_rd_off(0, 3, 1)>(vbase);
                  asm volatile("s_waitcnt lgkmcnt(0)" ::: "memory"); __builtin_amdgcn_sched_barrier(0);
                  vf[0] = HG_PK(l0, h0); vf[1] = HG_PK(l1, h1); vf[2] = HG_PK(l2, h2); vf[3] = HG_PK(l3, h3); }
                {
                    f32x16 p0 = f32x16{};
#pragma unroll
                    for (int d0 = 0; d0 < ND0; ++d0) { const int cb = (d0 * 16 + hi * 8) * 2;
                        const bf16x8 a = *(const LAS bf16x8*)(KT + r32 * QROW + cb), b = *(const LAS bf16x8*)(QT + r32 * QROW + cb);
                        p0 = __builtin_amdgcn_mfma_f32_32x32x16_bf16(a, b, p0, 0, 0, 0); }
#pragma unroll
                    for (int r = 0; r < 16; ++r) if (att::crow(r, hi) > r32) p0[r] = 0.f;
                    bf16x8 pa0, pa1; HG_PK4(p0, 0, pa0); HG_PK4(p0, 8, pa1);
                    od0 = __builtin_amdgcn_mfma_f32_32x32x16_bf16(pa0, vf[0], od0, 0, 0, 0); od0 = __builtin_amdgcn_mfma_f32_32x32x16_bf16(pa1, vf[1], od0, 0, 0, 0); }
                {
                    f32x16 p0 = f32x16{}, p1 = f32x16{};
#pragma unroll
                    for (int d0 = 0; d0 < ND0; ++d0) { const int cb = (d0 * 16 + hi * 8) * 2;
                        const bf16x8 a0_ = *(const LAS bf16x8*)(KT + r32 * QROW + cb), a1_ = *(const LAS bf16x8*)(KT + (32 + r32) * QROW + cb), b = *(const LAS bf16x8*)(QT + (32 + r32) * QROW + cb);
                        p0 = __builtin_amdgcn_mfma_f32_32x32x16_bf16(a0_, b, p0, 0, 0, 0); p1 = __builtin_amdgcn_mfma_f32_32x32x16_bf16(a1_, b, p1, 0, 0, 0); }
#pragma unroll
                    for (int r = 0; r < 16; ++r) if (att::crow(r, hi) > r32) p1[r] = 0.f;
                    bf16x8 pa0, pa1, pa2, pa3; HG_PK4(p0, 0, pa0); HG_PK4(p0, 8, pa1); HG_PK4(p1, 0, pa2); HG_PK4(p1, 8, pa3);
                    od1 = __builtin_amdgcn_mfma_f32_32x32x16_bf16(pa0, vf[0], od1, 0, 0, 0); od1 = __builtin_amdgcn_mfma_f32_32x32x16_bf16(pa1, vf[1], od1, 0, 0, 0);
                    od1 = __builtin_amdgcn_mfma_f32_32x32x16_bf16(pa2, vf[2], od1, 0, 0, 0); od1 = __builtin_amdgcn_mfma_f32_32x32x16_bf16(pa3, vf[3], od1, 0, 0, 0); }
            }
            __syncthreads();
            if (s >= 0) {
#pragma unroll
                for (int kb = 0; kb < NKB; ++kb) {
                    float er[16];
#pragma unroll
                    for (int m = 0; m < 4; ++m) { const f32x4 e4 = *(const LAS f32x4*)(FAC + 32 * kb + 8 * m + 4 * hi); er[4 * m] = e4[0]; er[4 * m + 1] = e4[1]; er[4 * m + 2] = e4[2]; er[4 * m + 3] = e4[3]; }
#pragma unroll
                    for (int s2 = 0; s2 < 2; ++s2) {
                        u32x4 bw;
#pragma unroll
                        for (int j = 0; j < 4; ++j) bw[j] = cvt_pk_bf16(St[kb][8 * s2 + 2 * j] * er[8 * s2 + 2 * j], St[kb][8 * s2 + 2 * j + 1] * er[8 * s2 + 2 * j + 1]);
                        const bf16x8 bfr = *reinterpret_cast<bf16x8*>(&bw);
                        const int ko = (32 * kb + 16 * s2 + 4 * hi) * 2;
                        const u32x2 x0 = *(const LAS u32x2*)(QT + r32 * QROW + ko), x1 = *(const LAS u32x2*)(QT + r32 * QROW + ko + 16);
                        const u32x2 y0 = *(const LAS u32x2*)(QT + (32 + r32) * QROW + ko), y1 = *(const LAS u32x2*)(QT + (32 + r32) * QROW + ko + 16);
                        u32x4 aw0 = {x0[0], x0[1], x1[0], x1[1]}, aw1 = {y0[0], y0[1], y1[0], y1[1]};
                        od0 = __builtin_amdgcn_mfma_f32_32x32x16_bf16(*reinterpret_cast<bf16x8*>(&aw0), bfr, od0, 0, 0, 0);
                        od1 = __builtin_amdgcn_mfma_f32_32x32x16_bf16(*reinterpret_cast<bf16x8*>(&aw1), bfr, od1, 0, 0, 0); } }
#pragma unroll
                for (int r = 0; r < 16; ++r) { const int t = att::crow(r, hi); const int n0 = s * 64 + t, n1 = n0 + 32;
                    Oo[(size_t)(row0 + HG_POS(n0)) * D + hh * 128 + 32 * vb + r32] = (bf16)(cvt_pk_bf16(od0[r], 0.f) & 0xffffu);
                    Oo[(size_t)(row0 + HG_POS(n1)) * D + hh * 128 + 32 * vb + r32] = (bf16)(cvt_pk_bf16(od1[r], 0.f) & 0xffffu); }
#pragma unroll
                for (int kb = 0; kb < NKB; ++kb) {
                    f32x16 U = f32x16{};
#pragma unroll
                    for (int ks = 0; ks < 4; ++ks) { const bf16x8 a = *(const LAS bf16x8*)(KTT + (32 * kb + r32) * 144 + (16 * ks + 8 * hi) * 2); U = __builtin_amdgcn_mfma_f32_32x32x16_bf16(a, vf[ks], U, 0, 0, 0); }
#pragma unroll
                    for (int m = 0; m < 4; ++m) { const f32x4 el = *(const LAS f32x4*)(FAC + NK + 32 * kb + 8 * m + 4 * hi), elr = *(const LAS f32x4*)(FAC + 2 * NK + 32 * kb + 8 * m + 4 * hi);
#pragma unroll
                        for (int e = 0; e < 4; ++e) St[kb][4 * m + e] = el[e] * St[kb][4 * m + e] + elr[e] * U[4 * m + e]; } }
            }
            __syncthreads();
        }
#undef HG_PK
#undef HG_PK4
    }
#undef HG_POS
    __syncthreads();
}

__device__ __forceinline__ void reduce_rstd(const float* __restrict__ ssp, float* __restrict__ rstd, int i0, int stride) {
    for (int row = i0; row < T; row += stride) { const f32x4* p = (const f32x4*)(ssp + (size_t)row * 32); float s = 0.f;
#pragma unroll
        for (int j = 0; j < 8; ++j) { const f32x4 v = p[j]; s += (v.x + v.y) + (v.z + v.w); }
        rstd[row] = rsqrtf(s * (1.f / D) + EPS); }
}
struct Args { const float* in[28]; float* out; unsigned char* ws; int ph_lo, ph_hi, li, pad; };
constexpr int RING_BYTES = 131072, LDS_BYTES = 147456, MISC_OFF = LDS_BYTES - 128;

__host__ __device__ constexpr int n_phases() {
    int n = 1;
    for (int layer = 0; layer < 4; ++layer) {
        n += 1;
        if (layer == 0) n += 1;
        const int kind = layer % 3;
        if (kind == 0) n += 2 + 3 * 3 + 1;
        else if (kind == 1) n += 3 * 3 + 1;
        else n += 5;
        n += 3;
        n += 1 + 4;
    }
    return n;
}
constexpr int NPH = n_phases();

#define H      ((bf16*)X)
#define Xb     ((bf16*)(ws + LO(WS_H)))
#define rstd_  ((float*)(ws + LO(WS_RSTD)))
#define ssp_   ((float*)(ws + LO(WS_SSP)))
#define ropec  ((float*)(ws + LO(WS_ROPE)))
#define ropes  ((float*)(ws + LO(WS_ROPE)) + 4096 * 32)
#define mem_rs ((float*)(ws + LO(WS_MEMRS)))
#define mem_b  ((bf16*)(ws + LO(WS_MEMB)))
#define memkv  ((bf16*)(ws + LO(WS_MEMKV)))
#define w1t    ((bf16*)(ws + LO(WS_W1)))
#define w2t    ((bf16*)(ws + LO(WS_W2)))
#define rq     ((float*)(ws + LO(WS_SS0)))
#define rkv_   ((float*)(ws + LO(WS_SS0) + 262144))
#define P      ((bf16*)(ws + LO(S_P)))
#define Qv     ((bf16*)(ws + LO(S_QC)) - (size_t)c * CH * 3072)
#define KVv    ((bf16*)(ws + LO(S_KVC)) - (size_t)c * CH * 5120)
#define Zv     ((bf16*)(ws + LO(S_Z)) - (size_t)c * CH * 10240)
#define OFv    ((bf16*)(ws + LO(S_OF)) - (size_t)c * CH * D)
#define OBv    ((bf16*)(ws + LO(S_OB)) - (size_t)c * CH * D)
#define OP2v   ((bf16*)X + (size_t)T * D - (size_t)c * CH * D)
#define OP3v   ((bf16*)X + (size_t)T * D + (size_t)CH * D - (size_t)c * CH * D)
#define T1     ((bf16*)(ws + LO(S_T1)))
#define Qm     ((bf16*)(ws + LO(S_QM)))
#define Om     ((bf16*)(ws + LO(S_OM)))
#define Hv     ((bf16*)(ws + LO(S_HID) + (size_t)(c & 1) * 256 * MiB) - (size_t)c * CH * DFF)
__global__ void __launch_bounds__(NWAVES * 64, 2) fwd(Args args) {
    extern __shared__ __attribute__((aligned(16))) unsigned char lds_raw[];
    LAS unsigned char* lds = (LAS unsigned char*)lds_raw;
    const int G0_ = gridDim.x, bx0_ = blockIdx.x;
    const int vcu0_ = (G0_ % 8 == 0) ? (bx0_ % 8) * (G0_ / 8) + bx0_ / 8 : bx0_;
    unsigned* ctl = (unsigned*)(args.ws + WS_CTL);
    volatile LAS unsigned* MISC = (volatile LAS unsigned*)(lds + MISC_OFF);
    if (threadIdx.x < 16) MISC[threadIdx.x] = 0u;
    __syncthreads();
    const int lo = args.ph_lo, hi = args.ph_hi;
    XcdBarrier bar; bar.bar = ctl + CW_BAR + args.li * XCD_BAR_WORDS; bar.x = 0; bar.st = MISC + 8;
    if (hi - lo > 1) bar = xcd_barrier_post(ctl + CW_BAR + args.li * XCD_BAR_WORDS, MISC + 8);
    int ph = 0;
#define PH_BEGIN(id) asm volatile("" : "+s"(ph)); if (ph >= lo && ph < hi) { if (PHMASK & (1ull << (id))) for (int rep_ = 0; rep_ < (((REPMASK >> (id)) & 1ull) ? 2 : 1); ++rep_) { if (rep_) __syncthreads(); const int G = launder_i(G0_), bx = launder_i(bx0_), vcu = launder_i(vcu0_), NGW = G * NWAVES; (void)bx; (void)NGW; const int tid = opaque_tid(), lane = tid & 63, wave = __builtin_amdgcn_readfirstlane(tid >> 6), gw = vcu * NWAVES + wave; (void)lane; (void)gw; unsigned char* ws = launder_p(args.ws); float* X = (float*)launder_p((unsigned char*)args.out); (void)X;
#define PH_END   } if (ph + 1 < hi) { XcdBarrier b2_ = bar; b2_.bar = (unsigned*)launder_p((unsigned char*)bar.bar); xcd_barrier(b2_); } } ++ph;


    PH_BEGIN(0)
    {
        for (int m = gw; m < T; m += NGW) { const float* src_ = (m < TPR ? in_ptr(0) + (size_t)m * D : in_ptr(1) + (size_t)(m - TPR) * D);
            const f32x4* xr = (const f32x4*)src_ + lane; f32x4 v[8]; float s = 0.f;
#pragma unroll
            for (int j = 0; j < 8; ++j) { v[j] = xr[64 * j]; s += (v[j].x * v[j].x + v[j].y * v[j].y) + (v[j].z * v[j].z + v[j].w * v[j].w); }
            s = wave_sum(s, lane); if (lane == 0) rstd_[m] = rsqrtf(s * (1.f / D) + EPS);
            u32x2* o8 = (u32x2*)(Xb + (size_t)m * D) + lane;
#pragma unroll
            for (int j = 0; j < 8; ++j) { u32x2 w; w.x = cvt_pk_bf16(v[j].x, v[j].y); w.y = cvt_pk_bf16(v[j].z, v[j].w); o8[64 * j] = w; } }
        for (int i = bx * 512 + tid; i < 4096 * 32; i += G * 512) { const int p = i >> 5, k = i & 31; const float inv = 1.0f / powf(10000.0f, (float)(2 * k) / 64.0f); const float ang = (float)p * inv; float s, c; sincosf(ang, &s, &c); ropec[i] = c; ropes[i] = s; }
        { bf16* Dc = (bf16*)(ws + LO(WS_DC)); const float* g2 = in_ptr(4) + 2 * D;
          for (int i = bx * 512 + tid; i < 4 * 2 * 512 * 512; i += G * 512) { const int k = i & 511, cp = (i >> 9) & 511, part = (i >> 18) & 1, g = i >> 19; const int r = (cp * k) & 511; const float x = (float)r * (2.0f / 512.0f);
              const float v = (part ? sinpif(x) : cospif(x)) * g2[g * 512 + k]; Dc[i] = (bf16)(cvt_pk_bf16(v, 0.f) & 0xffffu); } }
        { bf16* DL = (bf16*)(ws + LO(WS_DL2)); for (int i = bx * 512 + tid; i < 2048 * 2048; i += G * 512) { const int k = i & 2047, lp = i >> 11; const int j = k & 1023; const int r = (lp * j) & 2047; const float x = (float)r * (2.0f / 2048.0f);
              const float v = (k < 1024) ? cospif(x) : -sinpif(x); DL[i] = (bf16)(cvt_pk_bf16(v, 0.f) & 0xffffu); } }
        { bf16* DL = (bf16*)(ws + LO(WS_DL4)); for (int i = bx * 512 + tid; i < 4096 * 4096; i += G * 512) { const int k = i & 4095, lp = i >> 12; const int j = k & 2047; const int r = (lp * j) & 4095; const float x = (float)r * (2.0f / 4096.0f);
              const float v = (k < 2048) ? cospif(x) : -sinpif(x); DL[i] = (bf16)(cvt_pk_bf16(v, 0.f) & 0xffffu); } }
        for (int m = gw; m < 4096; m += NGW) { const float* src = (m < 2048 ? in_ptr(2) + (size_t)m * D : in_ptr(3) + (size_t)(m - 2048) * D);
            const f32x4* xr = (const f32x4*)src + lane; f32x4 v[8]; float s = 0.f;
#pragma unroll
            for (int j = 0; j < 8; ++j) { v[j] = xr[64 * j]; s += (v[j].x * v[j].x + v[j].y * v[j].y) + (v[j].z * v[j].z + v[j].w * v[j].w); }
            s = wave_sum(s, lane); if (lane == 0) mem_rs[m] = rsqrtf(s * (1.f / D) + EPS);
            u32x2* o8 = (u32x2*)(mem_b + (size_t)m * D) + lane;
#pragma unroll
            for (int j = 0; j < 8; ++j) { u32x2 w; w.x = cvt_pk_bf16(v[j].x, v[j].y); w.y = cvt_pk_bf16(v[j].z, v[j].w); o8[64 * j] = w; } }
        { u32x4 z = {0u, 0u, 0u, 0u};
          for (int i = bx * 512 + tid; i < 2 * 192 * 2048 / 8; i += G * 512) { const int j = i / (192 * 2048 / 8), r = i % (192 * 2048 / 8); *(u32x4*)((bf16*)(ws + LO(WS_MLA_WIN)) + (size_t)j * 1280 * 2048 + (size_t)1088 * 2048 + (size_t)r * 8) = z; }
          for (int i = bx * 512 + tid; i < 2 * 16 * 64 * 512 / 8; i += G * 512) { const int j = i / (16 * 64 * 512 / 8), r = i % (16 * 64 * 512 / 8), hh = r / (64 * 512 / 8), q = r % (64 * 512 / 8);
              *(u32x4*)((bf16*)(ws + LO(WS_MLA_WKVB)) + (size_t)j * 5120 * 512 + (size_t)(hh * 320 + 128) * 512 + (size_t)q * 8) = z; } }
        LAS float* scr = (LAS float*)(lds + wave * 16384);
        {
            constexpr int I_WIN = 32 * 34, I_QB = 8 * 96, I_KVB = 8 * 128, I_WO = 32 * 64, I_HIN = 32 * 320, I_MQ = 32 * 16, I_MKV = 32 * 32, I_MO = 8 * 64;
            constexpr int NIT = 2 * I_WIN + 2 * I_QB + 2 * I_KVB + 2 * I_WO + I_HIN + I_WO + I_WO + 4 * I_MQ + 4 * I_MKV + 4 * I_MO;
            for (int it = gw; it < NIT; it += NGW) {
                int r = it;
                if (r < 2 * I_WIN) { const int j = r / I_WIN; transpose_item<0>(in_ptr(5) + (size_t)j * 2048 * 1088, 2048, 1088, (bf16*)(ws + LO(WS_MLA_WIN)) + (size_t)j * 1280 * 2048, in_ptr(4) + (3 * j) * D, scr, r % I_WIN, lane); continue; } r -= 2 * I_WIN;
                if (r < 2 * I_QB) { const int j = r / I_QB; transpose_item<0>(in_ptr(8) + (size_t)j * 512 * 3072, 512, 3072, (bf16*)(ws + LO(WS_MLA_WQB)) + (size_t)j * 3072 * 512, in_ptr(6) + j * 512, scr, r % I_QB, lane); continue; } r -= 2 * I_QB;
                if (r < 2 * I_KVB) { const int j = r / I_KVB; transpose_item<1>(in_ptr(9) + (size_t)j * 512 * 4096, 512, 4096, (bf16*)(ws + LO(WS_MLA_WKVB)) + (size_t)j * 5120 * 512, in_ptr(7) + j * 512, scr, r % I_KVB, lane); continue; } r -= 2 * I_KVB;
                if (r < 2 * I_WO) { const int j = r / I_WO; transpose_item<0>(in_ptr(12) + (size_t)j * 2048 * 2048, 2048, 2048, (bf16*)(ws + LO(WS_MLA_WO)) + (size_t)j * 2048 * 2048, nullptr, scr, r % I_WO, lane); continue; } r -= 2 * I_WO;
                if (r < I_HIN) { transpose_item<0>(in_ptr(13), 2048, 10240, (bf16*)(ws + LO(WS_HG_WIN)), in_ptr(4) + 1 * D, scr, r, lane); continue; } r -= I_HIN;
                if (r < I_WO) { transpose_item<0>(in_ptr(16), 2048, 2048, (bf16*)(ws + LO(WS_HG_WO)), nullptr, scr, r, lane); continue; } r -= I_WO;
                if (r < I_WO) { transpose_item<0>(in_ptr(17), 2048, 2048, (bf16*)(ws + LO(WS_FN_WO)), nullptr, scr, r, lane); continue; } r -= I_WO;
                if (r < 4 * I_MQ) { const int j = r / I_MQ; transpose_item<0>(in_ptr(20) + (size_t)j * 2048 * 512, 2048, 512, (bf16*)(ws + LO(WS_MEM_WQ)) + (size_t)j * 512 * 2048, in_ptr(18) + j * D, scr, r % I_MQ, lane); continue; } r -= 4 * I_MQ;
                if (r < 4 * I_MKV) { const int j = r / I_MKV; transpose_item<0>(in_ptr(21) + (size_t)j * 2048 * 1024, 2048, 1024, (bf16*)(ws + LO(WS_MEM_WKV)) + (size_t)j * 1024 * 2048, in_ptr(19) + j * 2048, scr, r % I_MKV, lane); continue; } r -= 4 * I_MKV;
                { const int j = r / I_MO; transpose_item<0>(in_ptr(24) + (size_t)j * 512 * 2048, 512, 2048, (bf16*)(ws + LO(WS_MEM_WO)) + (size_t)j * 2048 * 512, nullptr, scr, r % I_MO, lane); }
            }
        }
        __syncthreads();
    }
    PH_END

#pragma unroll 1
    for (int layer = 0; layer < 4; ++layer) {
        const int kind = layer % 3, jm = layer / 3;
        PH_BEGIN(1)
        {
            if (layer > 0) reduce_rstd(ssp_, rstd_, bx * 512 + tid, G * 512);
            LAS float* scr = (LAS float*)(lds + wave * 16384);
            constexpr int I_1 = 32 * 256, I_2 = 128 * 64;
            for (int it = gw; it < I_1 + I_2; it += NGW) {
                if (it < I_1) transpose_item<0>(in_ptr(26) + (size_t)layer * D * DFF, D, DFF, w1t, in_ptr(25) + layer * D, scr, it, lane);
                else transpose_item<0>(in_ptr(27) + (size_t)layer * DFF * D, DFF, D, w2t, nullptr, scr, it - I_1, lane);
            }
            __syncthreads();
            if (layer == 0) {
                pg8::TileOrder S; S.init(mem_b, D, ws + WS_MEM_WKV, D, 0, 16, 16, G, bx);
                pg8::EpiBf16<1, 0> E{memkv, 4096, mem_rs, 0, 1.f};
                pg8::gemm_phase(lds, D, D, D, S, E);
            }
        }
        PH_END
        if (layer == 0) {
            PH_BEGIN(2)
            for (int m = gw; m < 4096; m += NGW) { const int ly = lane >> 4, hh = (lane >> 2) & 3, qq = lane & 3;
                bf16* p = memkv + (size_t)m * 4096 + ly * 1024 + hh * 128 + qq * 32; const float* g = in_ptr(23) + ly * 128 + qq * 32;
                u32x4 raw[4]; float x[32]; float s = 0.f;
#pragma unroll
                for (int j = 0; j < 4; ++j) { raw[j] = *(const u32x4*)(p + 8 * j);
#pragma unroll
                    for (int e = 0; e < 4; ++e) { x[8 * j + 2 * e] = bflo(raw[j][e]); x[8 * j + 2 * e + 1] = bfhi(raw[j][e]); } }
#pragma unroll
                for (int e = 0; e < 32; ++e) s += x[e] * x[e];
                s += shx(s, 1, lane); s += shx(s, 2, lane);
                const float r = rsqrtf(s * (1.f / 128.f) + EPS);
#pragma unroll
                for (int j = 0; j < 4; ++j) { u32x4 w;
#pragma unroll
                    for (int e = 0; e < 4; ++e) w[e] = cvt_pk_bf16(x[8 * j + 2 * e] * r * g[8 * j + 2 * e], x[8 * j + 2 * e + 1] * r * g[8 * j + 2 * e + 1]);
                    *(u32x4*)(p + 8 * j) = w; } }
            PH_END
        }

        if (kind == 0) {
            PH_BEGIN(3)
            {   pg8::TileOrder S; S.init(Xb, D, (bf16*)(ws + LO(WS_MLA_WIN)) + (size_t)jm * 1280 * 2048, D, 0, T / 256, 5, G, bx);
                pg8::EpiBf16<1, 0> E{P, 1280, rstd_, 0, 1.f};
                pg8::gemm_phase(lds, D, D, D, S, E); }
            PH_END
            PH_BEGIN(24)
            for (int m = gw; m < T; m += NGW) {
                const u32x4 a = *(const u32x4*)(P + (size_t)m * 1280 + lane * 16), b = *(const u32x4*)(P + (size_t)m * 1280 + lane * 16 + 8); float q2 = 0.f;
#pragma unroll
                for (int e = 0; e < 4; ++e) { const float a0 = bflo(a[e]), a1 = bfhi(a[e]), b0 = bflo(b[e]), b1 = bfhi(b[e]); q2 += (a0 * a0 + a1 * a1) + (b0 * b0 + b1 * b1); }
#pragma unroll
                for (int o = 1; o < 32; o <<= 1) q2 += shx(q2, o, lane);
                const float rs_ = rsqrtf(q2 * (1.f / 512.f) + EPS);
                if (lane == 0) rq[m] = rs_; if (lane == 32) rkv_[m] = rs_; }
            PH_END
#pragma unroll 1
            for (int c = 0; c < 3; ++c) {
                PH_BEGIN(4)
                {   pg8::TileOrder S; S.init(P, 1280, (bf16*)(ws + LO(WS_MLA_WQB)) + (size_t)jm * 3072 * 512, 512, c * 64, 64, 12, G, bx);
                    pg8::EpiBf16<1, 0> E{Qv, 3072, rq, 0, 1.f};
                    pg8::gemm_phase(lds, 512, 1280, 512, S, E); }
                {   pg8::TileOrder S; S.init(P + 512, 1280, (bf16*)(ws + LO(WS_MLA_WKVB)) + (size_t)jm * 5120 * 512, 512, c * 64, 64, 20, G, bx);
                    pg8::EpiBf16<1, 0> E{KVv, 5120, rkv_, 0, 1.f};
                    pg8::gemm_phase(lds, 512, 1280, 512, S, E); }
                PH_END
                PH_BEGIN(5)
                {   const float* gk = in_ptr(11) + jm * 192; const int hh = lane >> 2, qq = lane & 3;
                    for (int m = c * CH + gw; m < (c + 1) * CH; m += NGW) {
                        const int pos = m < TPR ? (m & 2047) : ((m - TPR) & 4095);
                        bf16* kp = KVv + (size_t)m * 5120 + hh * 320; const bf16* pr = P + (size_t)m * 1280 + 1024;
                        u32x4 raw[4]; float x[32], x1[8], x2[8]; float s = 0.f;
#pragma unroll
                        for (int j = 0; j < 4; ++j) { raw[j] = *(const u32x4*)(kp + qq * 32 + 8 * j);
#pragma unroll
                            for (int e = 0; e < 4; ++e) { x[8 * j + 2 * e] = bflo(raw[j][e]); x[8 * j + 2 * e + 1] = bfhi(raw[j][e]); } }
                        { const u32x4 r1 = *(const u32x4*)(pr + qq * 8), r2 = *(const u32x4*)(pr + 32 + qq * 8);
#pragma unroll
                          for (int e = 0; e < 4; ++e) { x1[2 * e] = bflo(r1[e]); x1[2 * e + 1] = bfhi(r1[e]); x2[2 * e] = bflo(r2[e]); x2[2 * e + 1] = bfhi(r2[e]); } }
#pragma unroll
                        for (int e = 0; e < 32; ++e) s += x[e] * x[e];
#pragma unroll
                        for (int e = 0; e < 8; ++e) s += x1[e] * x1[e] + x2[e] * x2[e];
                        s += shx(s, 1, lane); s += shx(s, 2, lane);
                        const float r = rsqrtf(s * (1.f / 192.f) + EPS);
#pragma unroll
                        for (int j = 0; j < 4; ++j) { u32x4 w;
#pragma unroll
                            for (int e = 0; e < 4; ++e) w[e] = cvt_pk_bf16(x[8 * j + 2 * e] * r * gk[qq * 32 + 8 * j + 2 * e], x[8 * j + 2 * e + 1] * r * gk[qq * 32 + 8 * j + 2 * e + 1]);
                            *(u32x4*)(kp + qq * 32 + 8 * j) = w; }
                        float y1[8], y2[8];
#pragma unroll
                        for (int e = 0; e < 8; ++e) { const int i = qq * 8 + e; const float cc = ropec[pos * 32 + i], sn = ropes[pos * 32 + i];
                            const float a = x1[e] * r * gk[128 + i], b = x2[e] * r * gk[160 + i]; y1[e] = a * cc - b * sn; y2[e] = a * sn + b * cc; }
                        u32x4 w1, w2;
#pragma unroll
                        for (int e = 0; e < 4; ++e) { w1[e] = cvt_pk_bf16(y1[2 * e], y1[2 * e + 1]); w2[e] = cvt_pk_bf16(y2[2 * e], y2[2 * e + 1]); }
                        *(u32x4*)(kp + 128 + qq * 8) = w1; *(u32x4*)(kp + 160 + qq * 8) = w2;
                    } }
                PH_END
                PH_BEGIN(6)
                {   const int nqb = (c == 0) ? 8 : 16, nun = 1024;
                    for (int idx = vcu; idx < nun; idx += G) {
                        const int qb = idx % nqb, hh = (idx / nqb) & 15, sl = idx / (nqb * 16); const int s = (c == 0) ? sl : 8 + (c - 1) * 4 + sl;
                        const int row0 = seq_row0(s), L = seq_len(s);
                        att::attn_unit<192, true>(Qv + (size_t)(row0 + qb * 256) * 3072 + hh * 192, 3072, KVv + (size_t)row0 * 5120 + hh * 320, 5120, KVv + (size_t)row0 * 5120 + hh * 320 + 192, 5120,
                                                  H + (size_t)(row0 + qb * 256) * D + hh * 128, D, L, in_ptr(10) + jm * 192, ropec, ropes, qb * 256, 0.07216878364870322f, nullptr, (char*)lds_raw);
                    } }
                PH_END
            }
            PH_BEGIN(7)
            {   pg8::TileOrder S; S.init(H, D, (bf16*)(ws + LO(WS_MLA_WO)) + (size_t)jm * 2048 * 2048, D, 0, T / 256, 8, G, bx);
                pg8::EpiResid<false> E{Xb, ssp_, nullptr};
                pg8::gemm_phase(lds, D, D, D, S, E); }
            PH_END
        } else if (kind == 1) {
#pragma unroll 1
            for (int c = 0; c < 3; ++c) {
                PH_BEGIN(8)
                {   pg8::TileOrder S; S.init(Xb, D, ws + WS_HG_WIN, D, c * 64, 64, 40, G, bx);
                    pg8::EpiBf16<1, 0> E{Zv, 10240, rstd_, 0, 1.f};
                    pg8::gemm_phase(lds, D, D, D, S, E); }
                PH_END
                PH_BEGIN(9)
                {
                    if (c == 0) {
                        for (int it = vcu; it < 256; it += G) { const int dir = it & 1, hh = (it >> 1) & 15, s = it >> 5;
                            hgrn_scan_item<128>(Zv, seq_row0(s), seq_len(s), hh, dir, 0, in_ptr(14), dir ? OBv : OFv, lds, lds_raw, tid, lane, wave); }
                    } else {
                        for (int it = vcu; it < 256; it += G) { const int kh = it & 1, dir = (it >> 1) & 1, hh = (it >> 2) & 15, s = 8 + (c - 1) * 4 + (it >> 6);
                            bf16* Oo = kh ? (dir ? OP3v : OP2v) : (dir ? OBv : OFv);
                            hgrn_scan_item<64>(Zv, seq_row0(s), seq_len(s), hh, dir, kh * 64, in_ptr(14), Oo, lds, lds_raw, tid, lane, wave); }
                    } }
                PH_END
                PH_BEGIN(10)
                {   const float* go = in_ptr(15) + (lane & 3) * 32;
                    for (int m = c * CH + gw; m < (c + 1) * CH; m += NGW) {
                        const bf16* pf = OFv + (size_t)m * D + lane * 32; const bf16* pb = OBv + (size_t)m * D + lane * 32; const bf16* pg = Zv + (size_t)m * 10240 + 8192 + lane * 32;
                        const bf16* p2 = OP2v + (size_t)m * D + lane * 32; const bf16* p3 = OP3v + (size_t)m * D + lane * 32;
                        float x[32]; float s = 0.f;
#pragma unroll
                        for (int j = 0; j < 4; ++j) { const u32x4 a = *(const u32x4*)(pf + 8 * j), b = *(const u32x4*)(pb + 8 * j);
#pragma unroll
                            for (int e = 0; e < 4; ++e) { x[8 * j + 2 * e] = bflo(a[e]) + bflo(b[e]); x[8 * j + 2 * e + 1] = bfhi(a[e]) + bfhi(b[e]); }
                            if (c > 0) { const u32x4 a2 = *(const u32x4*)(p2 + 8 * j), b2 = *(const u32x4*)(p3 + 8 * j);
#pragma unroll
                                for (int e = 0; e < 4; ++e) { x[8 * j + 2 * e] += bflo(a2[e]) + bflo(b2[e]); x[8 * j + 2 * e + 1] += bfhi(a2[e]) + bfhi(b2[e]); } } }
#pragma unroll
                        for (int e = 0; e < 32; ++e) s += x[e] * x[e];
                        s += shx(s, 1, lane); s += shx(s, 2, lane);
                        const float r = rsqrtf(s * (1.f / 128.f) + EPS);
#pragma unroll
                        for (int j = 0; j < 4; ++j) { const u32x4 gr = *(const u32x4*)(pg + 8 * j); u32x4 w;
#pragma unroll
                            for (int e = 0; e < 4; ++e) { const float g0 = bflo(gr[e]), g1 = bfhi(gr[e]); const float s0 = g0 / (1.f + __expf(-g0)), s1 = g1 / (1.f + __expf(-g1));
                                w[e] = cvt_pk_bf16(x[8 * j + 2 * e] * r * go[8 * j + 2 * e] * s0, x[8 * j + 2 * e + 1] * r * go[8 * j + 2 * e + 1] * s1); }
                            *(u32x4*)(H + (size_t)m * D + lane * 32 + 8 * j) = w; } } }
                PH_END
            }
            PH_BEGIN(11)
            {   pg8::TileOrder S; S.init(H, D, ws + WS_HG_WO, D, 0, T / 256, 8, G, bx);
                pg8::EpiResid<false> E{Xb, ssp_, nullptr};
                pg8::gemm_phase(lds, D, D, D, S, E); }
            PH_END
        } else {
            struct F1Order { const char* Dc; const char* HEb; const char* HOb; int G, c, smp;
                __device__ __forceinline__ bool next(int i, pg8::Unit& u) const {
                    const int idx = i * G + c; const int npn = smp ? 8 : 4, per = 16 * npn; if (idx >= 8 * per) return false;
                    const int s = (smp ? 8 : 0) + idx / per, rem = idx % per; const int g = rem / (4 * npn), part = (rem / (2 * npn)) & 1, pn = (rem % (2 * npn)) / 2, pm = rem & 1;
                    const int row0 = seq_row0(s), L = seq_len(s);
                    u.pm = pm; u.pn = pn; u.a = Dc + ((size_t)((g * 2 + part) * 512 + pm * 256) * 512) * 2; u.b = (part ? HOb : HEb) + ((size_t)(row0 / 2 + pn * 256) * D + g * 512) * 2;
                    u.ooff = (long)row0 * D + (long)g * 512 * L + (long)part * (L / 2); u.aoff = 0; u.roff = 0; return true; } };
            struct F2Order { const char* DL; const char* T1b; int G, c, smp, half;
                __device__ __forceinline__ bool next(int i, pg8::Unit& u) const {
                    const int idx = i * G + c; const int L = smp ? 4096 : 2048, npm = L / 512; if (idx >= npm * 64) return false;
                    const int pm = idx / 64, sgp = idx % 64; const int s = (smp ? 8 : 0) + sgp / 8, g = (sgp % 8) / 2, pn = sgp % 2; const int row0 = seq_row0(s);
                    u.pm = pm; u.pn = pn; u.a = DL + ((size_t)pm * 256 * L + half * (L / 2)) * 2; u.b = T1b + ((size_t)row0 * D + (size_t)g * 512 * L + (size_t)pn * 256 * L + half * (L / 2)) * 2;
                    u.aoff = (long)(row0 / 2) * D + (long)g * (L / 2) * 512; u.ooff = half ? (long)row0 * D + g * 512 : u.aoff; u.roff = s * D + g * 512; return true; } };
            PH_BEGIN(22)
            {
                bf16* HE = (bf16*)(ws + LO(S_HE)); bf16* HO = (bf16*)(ws + LO(S_HO)); float* xcm = (float*)(ws + LO(WS_XCMID));
                for (int m = gw; m < T / 2; m += NGW) {
                    const int s = m < 8192 ? m / 1024 : 8 + (m - 8192) / 2048; const int row0 = seq_row0(s), L = seq_len(s), j = m - row0 / 2;
                    const bf16* pa = Xb + (size_t)(row0 + j) * D + lane * 32; const bf16* pb = Xb + (size_t)(row0 + (j ? L - j : 0)) * D + lane * 32;
                    const float ra = rstd_[row0 + j], rb = j ? rstd_[row0 + L - j] : 0.f;
#pragma unroll
                    for (int q = 0; q < 4; ++q) { const u32x4 a = *(const u32x4*)(pa + 8 * q), b = *(const u32x4*)(pb + 8 * q); u32x4 we, wo;
#pragma unroll
                        for (int e = 0; e < 4; ++e) { const float a0 = bflo(a[e]) * ra, a1 = bfhi(a[e]) * ra, b0 = bflo(b[e]) * rb, b1 = bfhi(b[e]) * rb; we[e] = cvt_pk_bf16(a0 + b0, a1 + b1); wo[e] = j ? cvt_pk_bf16(a0 - b0, a1 - b1) : 0u; }
                        *(u32x4*)(HE + (size_t)m * D + lane * 32 + 8 * q) = we; *(u32x4*)(HO + (size_t)m * D + lane * 32 + 8 * q) = wo; } }
                const bf16* Dcc = (const bf16*)(ws + LO(WS_DC));
                for (int t = gw; t < 16 * D; t += NGW) { const int s = t >> 11, col = t & 2047, g = col >> 9, cp = col & 511; const int mid = seq_row0(s) + seq_len(s) / 2;
                    const u32x4 dv = *(const u32x4*)(Dcc + ((size_t)(g * 2) * 512 + cp) * 512 + lane * 8), xv = *(const u32x4*)(Xb + (size_t)mid * D + g * 512 + lane * 8); float a = 0.f;
#pragma unroll
                    for (int e = 0; e < 4; ++e) a += bflo(dv[e]) * bflo(xv[e]) + bfhi(dv[e]) * bfhi(xv[e]);
                    a = wave_sum(a, lane); if (lane == 0) xcm[t] = a * rstd_[mid]; } }
            PH_END
            PH_BEGIN(12)
            {   F1Order S{(const char*)(ws + LO(WS_DC)), (const char*)(ws + LO(S_HE)), (const char*)(ws + LO(S_HO)), G, bx, 1}; pg8::EpiBf16<0, 0> E{T1, 4096, nullptr, 0, 1.f};
                pg8::gemm_phase(lds, 512, 512, D, S, E); }
            {   F1Order S{(const char*)(ws + LO(WS_DC)), (const char*)(ws + LO(S_HE)), (const char*)(ws + LO(S_HO)), G, bx, 0}; pg8::EpiBf16<0, 0> E{T1, 2048, nullptr, 0, 1.f};
                pg8::gemm_phase(lds, 512, 512, D, S, E); }
            PH_END
            PH_BEGIN(13)
            {   F2Order S{(const char*)(ws + LO(WS_DL4)), (const char*)T1, G, bx, 1, 0}; pg8::EpiBf16<0, 0> E{(bf16*)(ws + LO(S_HE)), 512, nullptr, 0, 1.f};
                pg8::gemm_phase(lds, 2048, 4096, 4096, S, E); }
            {   F2Order S{(const char*)(ws + LO(WS_DL2)), (const char*)T1, G, bx, 0, 0}; pg8::EpiBf16<0, 0> E{(bf16*)(ws + LO(S_HE)), 512, nullptr, 0, 1.f};
                pg8::gemm_phase(lds, 1024, 2048, 2048, S, E); }
            PH_END
            PH_BEGIN(23)
            {   F2Order S{(const char*)(ws + LO(WS_DL4)), (const char*)T1, G, bx, 1, 1}; pg8::EpiFnetSym E{H, (const bf16*)(ws + LO(S_HE)), (const float*)(ws + LO(WS_XCMID)), 4096, 6.905339660024878e-4f};
                pg8::gemm_phase(lds, 2048, 4096, 4096, S, E); }
            {   F2Order S{(const char*)(ws + LO(WS_DL2)), (const char*)T1, G, bx, 0, 1}; pg8::EpiFnetSym E{H, (const bf16*)(ws + LO(S_HE)), (const float*)(ws + LO(WS_XCMID)), 2048, 9.765625e-4f};
                pg8::gemm_phase(lds, 1024, 2048, 2048, S, E); }
            {
                const float* xcm = (const float*)(ws + LO(WS_XCMID));
                for (int t = gw; t < 16 * D; t += NGW) { const int s = t >> 11, col = t & 2047, g = col >> 9, cp = col & 511; const int row0 = seq_row0(s), L = seq_len(s);
                    const bf16* tp = T1 + (size_t)row0 * D + (size_t)g * 512 * L + (size_t)cp * L; float a = 0.f;
                    for (int j0 = lane * 8; j0 < L / 2; j0 += 512) { const u32x4 v = *(const u32x4*)(tp + j0);
#pragma unroll
                        for (int e = 0; e < 4; ++e) a += bflo(v[e]) - bfhi(v[e]); }
                    a = wave_sum(a, lane);
                    if (lane == 0) H[(size_t)(row0 + L / 2) * D + col] = (bf16)(cvt_pk_bf16((a + xcm[t]) * (L == 4096 ? 6.905339660024878e-4f : 9.765625e-4f), 0.f) & 0xffffu); } }
            PH_END
            PH_BEGIN(14)
            {   pg8::TileOrder S; S.init(H, D, ws + WS_FN_WO, D, 0, T / 256, 8, G, bx);
                pg8::EpiResid<false> E{Xb, ssp_, nullptr};
                pg8::gemm_phase(lds, D, D, D, S, E); }
            PH_END
        }

        {
            PH_BEGIN(16)
            {   pg8::TileOrder S; S.init(Xb, D, (bf16*)(ws + LO(WS_MEM_WQ)) + (size_t)layer * 512 * 2048, D, 0, T / 256, 2, G, bx);
                pg8::EpiBf16<3, 0> E{Qm, 512, ssp_, 0, 1.f};
                pg8::gemm_phase(lds, D, D, D, S, E); }
            PH_END
            PH_BEGIN(17)
            for (int idx = vcu; idx < 768; idx += G) {
                const int hh = idx & 3, rb = idx >> 2; const int s = rb < 64 ? rb / 8 : 8 + (rb - 64) / 16;
                const bf16* kp = memkv + (size_t)(s * 256) * 4096 + layer * 1024 + hh * 128;
                att::attn_unit<128, false>(Qm + (size_t)rb * 256 * 512 + hh * 128, 512, kp, 4096, kp + 512, 4096, Om + (size_t)rb * 256 * 512 + hh * 128, 512, 256,
                                           in_ptr(22) + layer * 128, nullptr, nullptr, 0, 0.08838834764831845f, nullptr, (char*)lds_raw);
            }
            PH_END
            PH_BEGIN(18)
            {   pg8::TileOrder S; S.init(Om, 512, (bf16*)(ws + LO(WS_MEM_WO)) + (size_t)layer * 2048 * 512, 512, 0, T / 256, 8, G, bx);
                pg8::EpiResid<false> E{Xb, ssp_, nullptr};
                pg8::gemm_phase(lds, 512, 512, 512, S, E); }
            PH_END
        }
        {
            PH_BEGIN(19)
            reduce_rstd(ssp_, rstd_, bx * 512 + tid, G * 512);
            PH_END
#pragma unroll 1
            for (int cc = 0; cc < 4; ++cc) {
                PH_BEGIN(20)
                if (cc > 0) { const int c = cc - 1;
                    pg8::TileOrder S; S.init(Hv, DFF, w2t, DFF, c * 64, 64, 8, G, bx);
                    if (layer == 3) { pg8::EpiResid<true> E{Xb, nullptr, X}; pg8::gemm_phase(lds, DFF, DFF, DFF, S, E); }
                    else { pg8::EpiResid<false> E{Xb, ssp_, nullptr}; pg8::gemm_phase(lds, DFF, DFF, DFF, S, E); } }
                if (cc < 3) { const int c = cc;
                    pg8::TileOrder S; S.init(Xb, D, w1t, D, c * 64, 64, 32, G, bx);
                    pg8::EpiBf16<1, 1> E{Hv, DFF, rstd_, 0, 1.f};
                    pg8::gemm_phase(lds, D, D, D, S, E); }
                PH_END
            }
        }
    }
#undef PH_BEGIN
#undef PH_END
}

extern "C" void kernel_launch(void* const* d_in, const int* in_sizes, int n_in, void* d_out, int out_size, void* d_ws, size_t ws_size, hipStream_t stream) {
    static int grid = 0;
    if (grid == 0) {
        if (n_in != 28 || out_size != T * D || ws_size < WS_END) { fprintf(stderr, "kernel_launch: unexpected shapes (n_in %d out %d ws %zu)\n", n_in, out_size, ws_size); grid = -1; return; }
        int dev = 0, cus = 0, per_cu = 0;
        if (hipGetDevice(&dev) != hipSuccess || hipDeviceGetAttribute(&cus, hipDeviceAttributeMultiprocessorCount, dev) != hipSuccess) { grid = -1; return; }
        if (hipFuncSetAttribute((const void*)fwd, hipFuncAttributeMaxDynamicSharedMemorySize, LDS_BYTES) != hipSuccess) { fprintf(stderr, "kernel_launch: hipFuncSetAttribute failed\n"); grid = -1; return; }
        if (hipOccupancyMaxActiveBlocksPerMultiprocessor(&per_cu, (const void*)fwd, NWAVES * 64, LDS_BYTES) != hipSuccess || per_cu < 1) fprintf(stderr, "kernel_launch: occupancy query says %d\n", per_cu);
        (void)hipGetLastError();
        grid = cus;
    }
    if (grid < 0) return;
    (void)hipMemsetAsync((char*)d_ws + WS_CTL, 0, CTL_BYTES, stream);
    Args a{};
    for (int i = 0; i < 28; ++i) a.in[i] = (const float*)d_in[i];
    a.out = (float*)d_out; a.ws = (unsigned char*)d_ws; a.pad = 0;
#if N_LAUNCH_MODE == 0
    a.ph_lo = 0; a.ph_hi = NPH; a.li = 0;
    hipLaunchKernelGGL(fwd, dim3(grid), dim3(NWAVES * 64), LDS_BYTES, stream, a);
#else
    for (int p = 0; p < NPH; ++p) { a.ph_lo = p; a.ph_hi = p + 1; a.li = 0; hipLaunchKernelGGL(fwd, dim3(grid), dim3(NWAVES * 64), LDS_BYTES, stream, a); }
#endif
    const hipError_t le = hipPeekAtLastError();
    if (le != hipSuccess) fprintf(stderr, "kernel_launch: launch failed: %s\n", hipGetErrorName(le));
}
```

```cpp
#include <hip/hip_runtime.h>
#include <cstdio>
#include <cstdint>

#ifndef PHMASK
#define PHMASK 0xFFFFFFFFFFFFFFFFull
#endif
#ifndef REPMASK
#define REPMASK 0x0ull
#endif
#ifndef N_LAUNCH_MODE
#define N_LAUNCH_MODE 0
#endif

#define LAS __attribute__((address_space(3)))
#define GAS __attribute__((address_space(1)))
typedef unsigned short bf16;
typedef short bf16x8 __attribute__((ext_vector_type(8)));
typedef short s16x4 __attribute__((ext_vector_type(4)));
typedef float f32x4 __attribute__((ext_vector_type(4)));
typedef float f32x2 __attribute__((ext_vector_type(2)));
typedef float f32x16 __attribute__((ext_vector_type(16)));
typedef unsigned u32x4 __attribute__((ext_vector_type(4)));
typedef unsigned u32x2 __attribute__((ext_vector_type(2)));

constexpr int D = 2048, T = 49152, TPR = 16384, CH = 16384, DFF = 8192, NWAVES = 8;
constexpr float EPS = 1e-6f;
__host__ __device__ __forceinline__ int seq_row0(int s) { return s < 8 ? s * 2048 : 16384 + (s - 8) * 4096; }
__host__ __device__ __forceinline__ int seq_len(int s) { return s < 8 ? 2048 : 4096; }

constexpr size_t MiB = 1u << 20;
constexpr size_t WS_CTL = 0, CTL_BYTES = 4 * MiB;
constexpr size_t WS_SS0 = 1 * MiB, WS_RSTD = 2 * MiB;
constexpr size_t WS_ROPE = 4 * MiB;
constexpr size_t WS_MEMRS = 5 * MiB;
constexpr size_t WS_MLA_WIN = 6 * MiB, WS_MLA_WQB = 16 * MiB, WS_MLA_WKVB = 22 * MiB, WS_MLA_WO = 32 * MiB;
constexpr size_t WS_HG_WIN = 48 * MiB, WS_HG_WO = 88 * MiB, WS_FN_WO = 96 * MiB;
constexpr size_t WS_MEM_WQ = 104 * MiB, WS_MEM_WKV = 112 * MiB, WS_MEM_WO = 128 * MiB;
constexpr size_t WS_W1 = 136 * MiB, WS_W2 = 168 * MiB;
constexpr size_t WS_DC = 200 * MiB, WS_DL2 = 204 * MiB, WS_DL4 = 220 * MiB;
constexpr size_t WS_MEMB = 284 * MiB, WS_MEMKV = 300 * MiB;
constexpr size_t WS_H = 332 * MiB;
constexpr size_t WS_S = 524 * MiB;
constexpr size_t WS_SSP = 1036 * MiB;
constexpr size_t WS_END = 1044 * MiB;
constexpr size_t S_P = WS_S, S_QC = WS_S + 120 * MiB, S_KVC = WS_S + 216 * MiB;
constexpr size_t S_Z = WS_S, S_OF = WS_S + 320 * MiB, S_OB = WS_S + 384 * MiB;
constexpr size_t S_HE = WS_S, S_HO = WS_S + 96 * MiB, S_T1 = WS_S + 192 * MiB;
constexpr size_t WS_XCMID = WS_MEMRS + 65536;
constexpr size_t S_QM = WS_S, S_OM = WS_S + 48 * MiB;
constexpr size_t S_HID = WS_S;
constexpr int CW_TMO = 0, CW_BAR = 4096;

typedef __bf16 bf16x2_t __attribute__((ext_vector_type(2)));
__device__ __forceinline__ unsigned cvt_pk_bf16(float lo, float hi) { const f32x2 f = {lo, hi}; const bf16x2_t v = __builtin_convertvector(f, bf16x2_t); return __builtin_bit_cast(unsigned, v); }
__device__ __forceinline__ float bf2f(unsigned short b) { return __uint_as_float(((unsigned)b) << 16); }
__device__ __forceinline__ float bflo(unsigned w) { return __uint_as_float(w << 16); }
__device__ __forceinline__ float bfhi(unsigned w) { return __uint_as_float(w & 0xffff0000u); }
__device__ __forceinline__ float shx(float v, int m, int lane) { return __int_as_float(__builtin_amdgcn_ds_bpermute((lane ^ m) << 2, __float_as_int(v))); }
__device__ __forceinline__ float shl_(float v, int src) { return __int_as_float(__builtin_amdgcn_ds_bpermute(src << 2, __float_as_int(v))); }
__device__ __forceinline__ float wave_sum(float v, int lane) {
#pragma unroll
    for (int o = 1; o < 64; o <<= 1) v += shx(v, o, lane);
    return v;
}
__device__ __forceinline__ int opaque_lane() { unsigned z = 0u; asm volatile("" : "+v"(z)); return (int)__builtin_amdgcn_mbcnt_hi(~0u, __builtin_amdgcn_mbcnt_lo(~0u, z)); }
__device__ __forceinline__ int opaque_tid(int w) { return (w << 6) | opaque_lane(); }
__device__ __forceinline__ const float* in_ptr(int i) {
    const __attribute__((address_space(4))) char* ka = (const __attribute__((address_space(4))) char*)__builtin_amdgcn_kernarg_segment_ptr();
    int off = i * 8; asm volatile("" : "+s"(off));
    const float* p = *(const float* const __attribute__((address_space(4)))*)(ka + off);
    return (const float*)(const __attribute__((address_space(1))) float*)p;
}
__device__ __forceinline__ size_t LO(size_t v) { asm volatile("" : "+s"(v)); return v; }
__device__ __forceinline__ int launder_i(int v) { asm volatile("" : "+s"(v)); return v; }
__device__ __forceinline__ unsigned char* launder_p(unsigned char* p) { unsigned z = 0u; asm volatile("" : "+s"(z)); return p + z; }
#define LDS_WAIT() asm volatile("s_waitcnt lgkmcnt(0)" ::: "memory")
#define VM_WAIT() asm volatile("s_waitcnt vmcnt(0)" ::: "memory")

namespace pg8 {
constexpr int BM = 256, BK = 64, HALF = 128, HTB = HALF * BK * 2, STAGE_BYTES = 8 * HTB, NXCD = 8;
__host__ __device__ __forceinline__ int lds_byte(int r, int c) { const int st = (r >> 4) * 2 + (c >> 5), rr = r & 15, cc = c & 31, ob = rr * 64 + cc * 2; return st * 1024 + (ob ^ (((ob >> 9) & 1) << 5)); }
__host__ __device__ __forceinline__ void stage_rc(int b, int& R, int& C) { const int st = b / 1024, sb = b % 1024, swz = sb ^ (((sb >> 9) & 1) << 5); R = (st >> 1) * 16 + swz / 64; C = (st & 1) * 32 + (swz % 64) / 2; }
__host__ __device__ __forceinline__ int perm32(int rho) { const int n = rho >> 4, i = rho & 15; return 8 * (i >> 2) + 4 * n + (i & 3); }

struct Unit { int pm, pn; const char* a; const char* b; long ooff; long aoff; int roff; };

struct TileOrder {
    const char* A; const char* B; int lda, ldb, nM, nN, nwg, G, c, pm0, WGM;
    __device__ __forceinline__ void init(const void* A_, int lda_, const void* B_, int ldb_, int pm0_, int nM_, int nN_, int G_, int c_, int wgm_ = 4) {
        A = (const char*)A_; B = (const char*)B_; lda = lda_; ldb = ldb_; pm0 = pm0_; nM = nM_; nN = nN_; nwg = nM_ * nN_; G = G_; c = c_; WGM = wgm_; }
    __device__ __forceinline__ bool next(int i, Unit& u) const {
        const long L = (long)i * G + c; if (L >= nwg) return false;
        int wgid = (int)L; { const int q = nwg / NXCD, r = nwg % NXCD, xcd = wgid % NXCD, off = wgid / NXCD; wgid = (xcd < r ? xcd * (q + 1) : r * (q + 1) + (xcd - r) * q) + off; }
        const int nig = WGM * nN, gid = wgid / nig, fm = gid * WGM, gsz = (nM - fm) < WGM ? (nM - fm) : WGM;
        u.pm = pm0 + fm + ((wgid % nig) % gsz); u.pn = (wgid % nig) / gsz;
        u.a = A + (size_t)u.pm * 256 * lda * 2; u.b = B + (size_t)u.pn * 256 * ldb * 2; u.ooff = 0; u.aoff = 0; u.roff = 0; return true;
    }
};

template <int RS  , int ACT  > struct EpiBf16 {
    static constexpr bool PERM = true;
    bf16* O; int ldc; const float* rs; int rsw; float cs;
    __device__ __forceinline__ void pre(const Unit& u, int wr, int fr, float (&pv)[8]) const {
        const int row0 = u.pm * BM + wr * 64 + fr;
#pragma unroll
        for (int i = 0; i < 8; ++i) { const int row = row0 + (i >> 2) * HALF + (i & 3) * 16; pv[i] = RS == 1 ? rs[row] : RS == 2 ? rs[2 * row + rsw] : 0.f; }
    }
    __device__ __forceinline__ void operator()(const f32x4 (&acc)[2][2][4][2], const Unit& u, int wr, int wc, int fr, int fq, const float (&pv)[8]) const {
        const int row0 = u.pm * BM + wr * 64 + fr, col0 = u.pn * BM + wc * 32 + 8 * fq;
#pragma unroll
        for (int ai = 0; ai < 2; ++ai)
#pragma unroll
            for (int m = 0; m < 4; ++m) { const int row = row0 + ai * HALF + m * 16; float s = cs;
                if (RS == 1) s *= pv[ai * 4 + m];
                if (RS == 2) s *= rsqrtf(pv[ai * 4 + m] * (1.0f / 512.0f) + EPS);
                if (RS == 3) { float t = 0.f;
#pragma unroll
                    for (int j = 0; j < 8; ++j) { const float* pp = rs + (size_t)(4 * j) * T + row; t += (pp[0] + pp[T]) + (pp[2 * (size_t)T] + pp[3 * (size_t)T]); }
                    s *= rsqrtf(t * (1.f / D) + EPS); }
                bf16* rowp = O + u.ooff + (size_t)row * ldc + col0;
#pragma unroll
                for (int bj = 0; bj < 2; ++bj) { f32x4 v0 = acc[ai][bj][m][0] * s, v1 = acc[ai][bj][m][1] * s;
                    if (RS == 4) { const f32x4 c0 = *(const f32x4*)(rs + u.roff + col0 + bj * HALF), c1 = *(const f32x4*)(rs + u.roff + col0 + bj * HALF + 4); v0 = v0 * c0; v1 = v1 * c1; }
                    if (RS == 5) { const f32x4 c0 = *(const f32x4*)(rs + u.roff + col0 + bj * HALF), c1 = *(const f32x4*)(rs + u.roff + col0 + bj * HALF + 4); const float sg = (row & 1) ? -s : s; v0 = v0 + c0 * sg; v1 = v1 + c1 * sg; }
                    if (ACT == 1) {
#pragma unroll
                        for (int j = 0; j < 4; ++j) { const float a = fmaxf(v0[j], 0.f), b = fmaxf(v1[j], 0.f); v0[j] = a * a; v1[j] = b * b; } }
                    u32x4 w; w.x = cvt_pk_bf16(v0[0], v0[1]); w.y = cvt_pk_bf16(v0[2], v0[3]); w.z = cvt_pk_bf16(v1[0], v1[1]); w.w = cvt_pk_bf16(v1[2], v1[3]);
                    *(u32x4*)(rowp + bj * HALF) = w; } }
    }
};
template <bool FINAL> struct EpiResid {
    static constexpr bool PERM = true;
    bf16* Xb; float* ssp; float* out;
    __device__ __forceinline__ void pre(const Unit&, int, int, float (&)[8]) const {}
    __device__ __forceinline__ void operator()(const f32x4 (&acc)[2][2][4][2], const Unit& u, int wr, int wc, int fr, int fq, const float (&)[8]) const {
        const int row0 = u.pm * BM + wr * 64 + fr, col0 = u.pn * BM + wc * 32 + 8 * fq, lane_ = fq * 16 + fr;
        u32x4 o[2][4][2];
#pragma unroll
        for (int ai = 0; ai < 2; ++ai)
#pragma unroll
            for (int m = 0; m < 4; ++m)
#pragma unroll
                for (int bj = 0; bj < 2; ++bj) o[ai][m][bj] = *(const u32x4*)(Xb + (size_t)(row0 + ai * HALF + m * 16) * D + col0 + bj * HALF);
#pragma unroll
        for (int ai = 0; ai < 2; ++ai) { float qv[4] = {0.f, 0.f, 0.f, 0.f};
#pragma unroll
            for (int m = 0; m < 4; ++m) { const int row = row0 + ai * HALF + m * 16; bf16* xp = Xb + (size_t)row * D + col0; float q = 0.f;
#pragma unroll
                for (int bj = 0; bj < 2; ++bj) { const u32x4 ov = o[ai][m][bj];
                    f32x4 v0 = acc[ai][bj][m][0], v1 = acc[ai][bj][m][1];
                    v0[0] += bflo(ov[0]); v0[1] += bfhi(ov[0]); v0[2] += bflo(ov[1]); v0[3] += bfhi(ov[1]); v1[0] += bflo(ov[2]); v1[1] += bfhi(ov[2]); v1[2] += bflo(ov[3]); v1[3] += bfhi(ov[3]);
                    if (FINAL) { float* op = out + (size_t)row * D + col0 + bj * HALF; *(f32x4*)op = v0; *(f32x4*)(op + 4) = v1; }
                    else { u32x4 w; w.x = cvt_pk_bf16(v0[0], v0[1]); w.y = cvt_pk_bf16(v0[2], v0[3]); w.z = cvt_pk_bf16(v1[0], v1[1]); w.w = cvt_pk_bf16(v1[2], v1[3]);
                        *(u32x4*)(xp + bj * HALF) = w;
#pragma unroll
                        for (int j = 0; j < 4; ++j) { const float a = bflo(w[j]), b = bfhi(w[j]); q += a * a + b * b; } } }
                if (!FINAL) { q += shx(q, 16, lane_); q += shx(q, 32, lane_); qv[m] = q; } }
            if (!FINAL) { const float v = fq == 0 ? qv[0] : fq == 1 ? qv[1] : fq == 2 ? qv[2] : qv[3];
                ssp[(size_t)(u.pn * 4 + wc) * T + u.pm * BM + ai * HALF + wr * 64 + lane_] = v; }
            asm volatile("" ::: "memory"); }
    }
};

struct EpiFnetSym {
    static constexpr bool PERM = true;
    bf16* Y; const bf16* Ab; const float* xcm; int L; float cs;
    __device__ __forceinline__ void pre(const Unit&, int, int, float (&)[8]) const {}
    __device__ __forceinline__ void operator()(const f32x4 (&acc)[2][2][4][2], const Unit& u, int wr, int wc, int fr, int fq, const float (&)[8]) const {
        const int row0 = u.pm * BM + wr * 64 + fr, col0 = u.pn * BM + wc * 32 + 8 * fq;
        f32x4 b0[2], b1[2];
#pragma unroll
        for (int bj = 0; bj < 2; ++bj) { b0[bj] = *(const f32x4*)(xcm + u.roff + col0 + bj * HALF); b1[bj] = *(const f32x4*)(xcm + u.roff + col0 + bj * HALF + 4); }
#pragma unroll
        for (int ai = 0; ai < 2; ++ai)
#pragma unroll
            for (int m = 0; m < 4; ++m) { const int row = row0 + ai * HALF + m * 16; const float sg = (row & 1) ? -1.f : 1.f;
                const bf16* ap = Ab + u.aoff + (size_t)row * 512 + col0;
                bf16* y1 = Y + u.ooff + (size_t)row * D + col0; bf16* y2 = Y + u.ooff + (size_t)(L - row) * D + col0;
#pragma unroll
                for (int bj = 0; bj < 2; ++bj) { const u32x4 a = *(const u32x4*)(ap + bj * HALF);
                    f32x4 a0 = {bflo(a[0]), bfhi(a[0]), bflo(a[1]), bfhi(a[1])}, a1 = {bflo(a[2]), bfhi(a[2]), bflo(a[3]), bfhi(a[3])};
                    a0 = a0 + b0[bj] * sg; a1 = a1 + b1[bj] * sg;
                    const f32x4 p0 = (a0 + acc[ai][bj][m][0]) * cs, p1 = (a1 + acc[ai][bj][m][1]) * cs, q0 = (a0 - acc[ai][bj][m][0]) * cs, q1 = (a1 - acc[ai][bj][m][1]) * cs;
                    u32x4 w; w.x = cvt_pk_bf16(p0[0], p0[1]); w.y = cvt_pk_bf16(p0[2], p0[3]); w.z = cvt_pk_bf16(p1[0], p1[1]); w.w = cvt_pk_bf16(p1[2], p1[3]);
                    *(u32x4*)(y1 + bj * HALF) = w;
                    if (row > 0) { u32x4 v; v.x = cvt_pk_bf16(q0[0], q0[1]); v.y = cvt_pk_bf16(q0[2], q0[3]); v.z = cvt_pk_bf16(q1[0], q1[1]); v.w = cvt_pk_bf16(q1[2], q1[3]);
                        *(u32x4*)(y2 + bj * HALF) = v; } } }
    }
};

template <class Epi, class Sched>
__device__ __forceinline__ void gemm_phase(LAS unsigned char* lds, const int K, const int lda, const int ldb, const Sched& S, const Epi& E, const int widS) {
    const int tid = opaque_tid(widS), wid = __builtin_amdgcn_readfirstlane(tid >> 6), lane = tid & 63, wr = wid >> 2, wc = wid & 3, fr = lane & 15, fq = lane >> 4;
    const int nt = K / BK;
    unsigned voffA[2], voffB[2];
#pragma unroll
    for (int i = 0; i < 2; ++i) { int R, C; stage_rc(tid * 16 + i * 8192, R, C); const int Rb = Epi::PERM ? ((R & ~31) + perm32(R & 31)) : R;
        voffA[i] = (unsigned)(R * lda + C) * 2u; voffB[i] = (unsigned)(Rb * ldb + C) * 2u; }
    const size_t kstep = (size_t)(BK * 2);
    const size_t hstepA = (size_t)HALF * lda * 2, hstepB = (size_t)HALF * ldb * 2;
    const unsigned ldsw = (unsigned)wid * 1024u;
    const int aoff = lds_byte(wr * 64 + fr, fq * 8), boff = lds_byte(wc * 32 + fr, fq * 8);
#define PG8_SA(b, h) (((b) * 2 + (h)) * HTB)
#define PG8_SB(b, h) ((4 + (b) * 2 + (h)) * HTB)
#define PG8_STAGE(bufoff, gbase, voff) do { _Pragma("unroll") for (int _i = 0; _i < 2; ++_i) \
        __builtin_amdgcn_global_load_lds((const unsigned*)((const char*)(gbase) + (voff)[_i]), (LAS unsigned*)(lds + (bufoff) + ldsw + _i * 8192), 16, 0, 0); } while (0)
#define PG8_LDA(dst, b, h) do { _Pragma("unroll") for (int m = 0; m < 4; ++m) _Pragma("unroll") for (int k = 0; k < 2; ++k) dst[m][k] = *(const LAS bf16x8*)(lds + PG8_SA(b, h) + aoff + m * 2048 + k * 1024); } while (0)
#define PG8_LDB(dst, b, h) do { _Pragma("unroll") for (int n = 0; n < 2; ++n) _Pragma("unroll") for (int k = 0; k < 2; ++k) dst[n][k] = *(const LAS bf16x8*)(lds + PG8_SB(b, h) + boff + n * 2048 + k * 1024); } while (0)
#define PG8_MMA(ai, bj, At, Bt) do { __builtin_amdgcn_s_setprio(1); _Pragma("unroll") for (int m = 0; m < 4; ++m) _Pragma("unroll") for (int n = 0; n < 2; ++n) _Pragma("unroll") for (int k = 0; k < 2; ++k) \
        acc[ai][bj][m][n] = __builtin_amdgcn_mfma_f32_16x16x32_bf16(Bt[n][k], At[m][k], acc[ai][bj][m][n], 0, 0, 0); __builtin_amdgcn_s_setprio(0); } while (0)
#define PG8_WAIT_V(n) asm volatile("s_waitcnt vmcnt(" #n ")" ::: "memory")
#define PG8_WAIT_L(n) asm volatile("s_waitcnt lgkmcnt(" #n ")" ::: "memory")
#define PG8_BAR __builtin_amdgcn_s_barrier()
#define PG8_SCHED __builtin_amdgcn_sched_barrier(0)
    Unit cur, nxt; int ui = 0;
    if (!S.next(0, cur)) return;
    f32x4 acc[2][2][4][2];
#pragma unroll
    for (int a = 0; a < 2; ++a)
#pragma unroll
        for (int b = 0; b < 2; ++b)
#pragma unroll
            for (int m = 0; m < 4; ++m)
#pragma unroll
                for (int n = 0; n < 2; ++n) acc[a][b][m][n] = (f32x4){0.f, 0.f, 0.f, 0.f};
    bf16x8 At[4][2], B0[2][2], B1[2][2];
    const char* cA = cur.a; const char* cB = cur.b;
    float pv[8]; E.pre(cur, wr, fr, pv);
    PG8_STAGE(PG8_SB(0, 0), cB, voffB); PG8_STAGE(PG8_SB(0, 1), cB + hstepB, voffB); PG8_STAGE(PG8_SA(0, 0), cA, voffA); PG8_STAGE(PG8_SA(0, 1), cA + hstepA, voffA);
    PG8_STAGE(PG8_SB(1, 0), cB + kstep, voffB); PG8_STAGE(PG8_SA(1, 0), cA + kstep, voffA); PG8_STAGE(PG8_SB(1, 1), cB + hstepB + kstep, voffB);
    if (wr == 1) PG8_BAR;
    PG8_WAIT_V(8); PG8_BAR;
    PG8_WAIT_V(6); PG8_BAR;
    for (;;) {
        const bool has_next = S.next(ui + 1, nxt);
        const char* nA = has_next ? nxt.a : cA; const char* nB = has_next ? nxt.b : cB;
#define PG8_WAIT_V8R(flag) asm volatile("s_waitcnt vmcnt(24)\n\ts_cmp_eq_u32 %0, 0\n\ts_cbranch_scc0 .Lpg8r_%=\n\ts_waitcnt vmcnt(8)\n.Lpg8r_%=:" :: "s"(flag) : "memory", "scc")
        for (int t = 0; t < nt; t += 2) {
            const bool last = (t == nt - 2);
            const int relax = __builtin_amdgcn_readfirstlane((int)(t == 0) & (int)(ui > 0));
            const char* a1 = cA + (size_t)(t + 1) * kstep;
            const char* a2 = last ? nA : cA + (size_t)(t + 2) * kstep; const char* b2 = last ? nB : cB + (size_t)(t + 2) * kstep;
            const char* a3 = a2 + kstep; const char* b3 = b2 + kstep;
            PG8_LDB(B0, 0, 0); PG8_LDB(B1, 0, 1); PG8_SCHED; PG8_LDA(At, 0, 0); PG8_STAGE(PG8_SA(1, 1), a1 + hstepA, voffA);
            PG8_WAIT_V8R(relax); PG8_WAIT_L(0); PG8_BAR; PG8_MMA(0, 0, At, B0); PG8_MMA(0, 1, At, B1); PG8_BAR; PG8_SCHED;
            PG8_LDA(At, 0, 1); PG8_STAGE(PG8_SB(0, 0), b2, voffB); PG8_STAGE(PG8_SB(0, 1), b2 + hstepB, voffB); PG8_STAGE(PG8_SA(0, 0), a2, voffA);
            PG8_WAIT_V8R(relax); PG8_WAIT_L(0); PG8_BAR; PG8_MMA(1, 0, At, B0); PG8_MMA(1, 1, At, B1); PG8_BAR; PG8_SCHED;
            PG8_LDB(B0, 1, 0); PG8_LDB(B1, 1, 1); PG8_SCHED; PG8_LDA(At, 1, 0); PG8_STAGE(PG8_SA(0, 1), a2 + hstepA, voffA);
            PG8_WAIT_V(8); PG8_WAIT_L(0); PG8_BAR; PG8_MMA(0, 0, At, B0); PG8_MMA(0, 1, At, B1); PG8_BAR; PG8_SCHED;
            PG8_LDA(At, 1, 1); PG8_STAGE(PG8_SB(1, 0), b3, voffB); PG8_STAGE(PG8_SB(1, 1), b3 + hstepB, voffB); PG8_STAGE(PG8_SA(1, 0), a3, voffA);
            PG8_WAIT_V(8); PG8_WAIT_L(0); PG8_BAR; PG8_MMA(1, 0, At, B0); PG8_MMA(1, 1, At, B1); PG8_BAR; PG8_SCHED;
        }
#undef PG8_WAIT_V8R
        if (wr == 0) PG8_BAR;
        E(acc, cur, wr, wc, fr, fq, pv);
        if (!has_next) break;
#pragma unroll
        for (int a = 0; a < 2; ++a)
#pragma unroll
            for (int b = 0; b < 2; ++b)
#pragma unroll
                for (int m = 0; m < 4; ++m)
#pragma unroll
                    for (int n = 0; n < 2; ++n) acc[a][b][m][n] = (f32x4){0.f, 0.f, 0.f, 0.f};
        cur = nxt; cA = nA; cB = nB; ++ui;
        E.pre(cur, wr, fr, pv);
        if (wr == 1) PG8_BAR;
    }
    PG8_WAIT_V(0);
    PG8_BAR;
#undef PG8_SA
#undef PG8_SB
#undef PG8_STAGE
#undef PG8_LDA
#undef PG8_LDB
#undef PG8_MMA
#undef PG8_WAIT_V
#undef PG8_WAIT_L
#undef PG8_BAR
#undef PG8_SCHED
}
}

namespace att {
constexpr int NW = 8, QBLK = 32, KVBLK = 64, DV = 128;
constexpr int SHM_V = KVBLK * DV * 2;
template <int DQK> struct Geo { static constexpr int KROW = DQK * 2, SHM_K = KVBLK * KROW, NQ = DQK / 16, CPR = DQK / 8  , NKI = SHM_K / 8192  ; };
template <int DQK> __device__ __forceinline__ int kswz(int row) { return DQK == 192 ? ((row >> 1) & 7) : (row & 15); }
#define SBAR() __builtin_amdgcn_sched_barrier(0)
__device__ __forceinline__ int crow(int r, int hi) { return (r & 3) + 8 * (r >> 2) + 4 * hi; }
template <bool FIRST>
__device__ __forceinline__ void partialSM(f32x16& p0, f32x16& p1, f32x16& negm, float& alpha, float& l_reg) {
    constexpr float THR2 = 8.f * 1.4426950408889634f;
    float pmax = p0[0];
#pragma unroll
    for (int r = 1; r < 16; ++r) pmax = fmaxf(pmax, p0[r]);
#pragma unroll
    for (int r = 0; r < 16; ++r) pmax = fmaxf(pmax, p1[r]);
    { auto rr = __builtin_amdgcn_permlane32_swap(__float_as_uint(pmax), __float_as_uint(pmax), false, false);
      asm("v_max_f32 %0, %1, %2" : "=v"(pmax) : "v"(rr[0]), "v"(rr[1])); }
    if (!FIRST && __builtin_expect(__all(pmax <= THR2), 1)) { alpha = 1.f; }
    else { const float d = FIRST ? pmax : fmaxf(pmax, 0.f); alpha = FIRST ? 1.f : __builtin_amdgcn_exp2f(-d); if (!FIRST) l_reg *= alpha;
#pragma unroll
        for (int r = 0; r < 16; ++r) { p0[r] -= d; p1[r] -= d; negm[r] -= d; } }
#pragma unroll
    for (int r = 0; r < 16; ++r) p0[r] = __builtin_amdgcn_exp2f(p0[r]);
}
__device__ __forceinline__ void finishSM(f32x16& p0, f32x16& p1, float& l_reg, bf16x8& pa0, bf16x8& pa1, bf16x8& pa2, bf16x8& pa3) {
#pragma unroll
    for (int r = 0; r < 16; ++r) p1[r] = __builtin_amdgcn_exp2f(p1[r]);
    float ps = 0;
#pragma unroll
    for (int r = 0; r < 16; ++r) ps += p0[r];
#pragma unroll
    for (int r = 0; r < 16; ++r) ps += p1[r];
    l_reg += ps;
#define PK4(P, BASE, OUT) do { u32x4 w; w[0] = cvt_pk_bf16(P[BASE + 0], P[BASE + 1]); w[1] = cvt_pk_bf16(P[BASE + 2], P[BASE + 3]);   \
    w[2] = cvt_pk_bf16(P[BASE + 4], P[BASE + 5]); w[3] = cvt_pk_bf16(P[BASE + 6], P[BASE + 7]);     \
    { auto r0 = __builtin_amdgcn_permlane32_swap(w[0], w[2], false, false); w[0] = r0[0]; w[2] = r0[1]; } \
    { auto r1 = __builtin_amdgcn_permlane32_swap(w[1], w[3], false, false); w[1] = r1[0]; w[3] = r1[1]; } \
    OUT = *reinterpret_cast<bf16x8*>(&w); } while (0)
    PK4(p0, 0, pa0); PK4(p0, 8, pa1); PK4(p1, 0, pa2); PK4(p1, 8, pa3);
#undef PK4
}
template <int DQK> struct KAddr { static constexpr int KB = DQK == 192 ? 4 : 8; };
template <int DQK>
__device__ __forceinline__ void qkt(f32x16& p0, f32x16& p1, const char* Kt  , const int kx  , const bf16x8* qr, const f32x16& negm) {
    constexpr int NQ = Geo<DQK>::NQ, RB = 32 * Geo<DQK>::KROW, KB = KAddr<DQK>::KB;
#define KOFF(d0) (((32 * ((d0) % KB)) ^ kx) + ((d0) / KB) * 32 * KB)
    const char* Ksl = Kt;
    bf16x8 f0[2], f1[2];
    f0[0] = *reinterpret_cast<const bf16x8*>(Ksl + KOFF(0)); f1[0] = *reinterpret_cast<const bf16x8*>(Ksl + KOFF(0) + RB);
    __builtin_amdgcn_sched_group_barrier(0x100, 2, 0);
#pragma unroll
    for (int d0 = 0; d0 < NQ; ++d0) {
        if (d0 + 1 < NQ) { f0[(d0 + 1) & 1] = *reinterpret_cast<const bf16x8*>(Ksl + KOFF(d0 + 1)); f1[(d0 + 1) & 1] = *reinterpret_cast<const bf16x8*>(Ksl + KOFF(d0 + 1) + RB); }
        if (d0 == 0) {
            asm("v_mfma_f32_32x32x16_bf16 %0, %1, %2, %3" : "=&v"(p0) : "v"(f0[0]), "v"(qr[0]), "v"(negm));
            asm("v_mfma_f32_32x32x16_bf16 %0, %1, %2, %3" : "=&v"(p1) : "v"(f1[0]), "v"(qr[0]), "v"(negm));
        } else {
            p0 = __builtin_amdgcn_mfma_f32_32x32x16_bf16(f0[d0 & 1], qr[d0], p0, 0, 0, 0);
            p1 = __builtin_amdgcn_mfma_f32_32x32x16_bf16(f1[d0 & 1], qr[d0], p1, 0, 0, 0); }
        __builtin_amdgcn_sched_group_barrier(0x100, 2, 0); __builtin_amdgcn_sched_group_barrier(0x8, 2, 0); }
#undef KOFF
}
__device__ __forceinline__ int v_st(int k, int c) { const int kk = (k & ~0xC) | ((k & 4) << 1) | ((k & 8) >> 1); return ((kk >> 3) * 4 + (c >> 5)) * 512 + ((kk & 7) * 32 + (c & 31)) * 2; }
__device__ __forceinline__ int v_rd_base(int lane) { return ((lane & 3) << 3) | (((lane >> 2) & 3) << 6) | (((lane >> 4) & 1) << 5) | (((lane >> 5) & 1) << 8); }
constexpr int v_rd_off(int d0, int ks, int half) { return d0 * 512 + ks * 4096 + half * 2048; }
template <int OFF> __device__ __forceinline__ s16x4 tr_read(int vb) {
    s16x4 r; asm volatile("ds_read_b64_tr_b16 %0, %1 offset:%2" : "=&v"(r) : "v"(vb), "i"(OFF) : "memory"); return r;
}
template <int D0> __device__ __forceinline__ void pv_one(f32x16& od, int vb, bf16x8 pa0, bf16x8 pa1, bf16x8 pa2, bf16x8 pa3) {
    const s16x4 l0 = tr_read<v_rd_off(D0, 0, 0)>(vb), h0 = tr_read<v_rd_off(D0, 0, 1)>(vb), l1 = tr_read<v_rd_off(D0, 1, 0)>(vb), h1 = tr_read<v_rd_off(D0, 1, 1)>(vb);
    const s16x4 l2 = tr_read<v_rd_off(D0, 2, 0)>(vb), h2 = tr_read<v_rd_off(D0, 2, 1)>(vb), l3 = tr_read<v_rd_off(D0, 3, 0)>(vb), h3 = tr_read<v_rd_off(D0, 3, 1)>(vb);
    asm volatile("s_waitcnt lgkmcnt(0)" ::: "memory"); SBAR();
#define PK(L, H) (bf16x8){L[0], L[1], L[2], L[3], H[0], H[1], H[2], H[3]}
    od = __builtin_amdgcn_mfma_f32_32x32x16_bf16(pa0, PK(l0, h0), od, 0, 0, 0);
    od = __builtin_amdgcn_mfma_f32_32x32x16_bf16(pa1, PK(l1, h1), od, 0, 0, 0);
    od = __builtin_amdgcn_mfma_f32_32x32x16_bf16(pa2, PK(l2, h2), od, 0, 0, 0);
    od = __builtin_amdgcn_mfma_f32_32x32x16_bf16(pa3, PK(l3, h3), od, 0, 0, 0);
#undef PK
}
__device__ __forceinline__ void pv_d0(f32x16* o, int vb, bf16x8 pa0, bf16x8 pa1, bf16x8 pa2, bf16x8 pa3) {
    pv_one<0>(o[0], vb, pa0, pa1, pa2, pa3); pv_one<1>(o[1], vb, pa0, pa1, pa2, pa3); pv_one<2>(o[2], vb, pa0, pa1, pa2, pa3); pv_one<3>(o[3], vb, pa0, pa1, pa2, pa3);
}

template <int DQK, bool ROPE>
__device__ __forceinline__ void attn_unit(const bf16* __restrict__ Qb, int ldq, const bf16* __restrict__ Kh, int ldk, const bf16* __restrict__ Vh, int ldv,
                                          bf16* __restrict__ Ob, int ldo, int nkeys, const float* __restrict__ qg, const float* __restrict__ ropec, const float* __restrict__ ropes,
                                          int pos0, const float sm_scale, const float* __restrict__ qrs, char* lds, const int widS) {
    using G = Geo<DQK>; constexpr int NQ = G::NQ;
    const int tid = opaque_tid(widS), wid = __builtin_amdgcn_readfirstlane(tid >> 6), lane = tid & 63, r32 = lane & 31, hi = lane >> 5;
    char* V_lds = lds; char* K_lds = lds + 3 * SHM_V;
    float* wsp = (float*)(lds + 3 * SHM_V + 2 * G::SHM_K) + wid * 64; float* li_l = wsp; float* al_l = wsp + 32;
    const float C = sm_scale * 1.4426950408889634f;
    float l_reg = 0; f32x16 o[4] = {}; f32x16 negm = {}; bf16x8 qr[NQ];
    {
        const bf16* Qw = Qb + (long)(wid * QBLK + r32) * ldq + hi * 8;
        u32x4 raw[NQ]; float ssq = 0.f;
#pragma unroll
        for (int d0 = 0; d0 < NQ; ++d0) { raw[d0] = *reinterpret_cast<const u32x4*>(Qw + d0 * 16);
#pragma unroll
            for (int j = 0; j < 4; ++j) { const float a = bflo(raw[d0][j]), b = bfhi(raw[d0][j]); ssq += a * a + b * b; } }
        ssq += shx(ssq, 32, lane);
        const float qs_ = qrs ? qrs[wid * QBLK + r32] : 1.f;
        const float rstd = C * qs_ * rsqrtf(qs_ * qs_ * ssq * (1.0f / DQK) + EPS);
        constexpr int NPLAIN = ROPE ? 8 : NQ;
#pragma unroll
        for (int d0 = 0; d0 < NPLAIN; ++d0) { const f32x4 g0 = *reinterpret_cast<const f32x4*>(qg + d0 * 16 + hi * 8), g1 = *reinterpret_cast<const f32x4*>(qg + d0 * 16 + hi * 8 + 4);
            u32x4 w;
#pragma unroll
            for (int j = 0; j < 4; ++j) { const float gl = j < 2 ? g0[2 * j] : g1[2 * j - 4], gh = j < 2 ? g0[2 * j + 1] : g1[2 * j - 3]; w[j] = cvt_pk_bf16(bflo(raw[d0][j]) * rstd * gl, bfhi(raw[d0][j]) * rstd * gh); }
            qr[d0] = *reinterpret_cast<bf16x8*>(&w); }
        if constexpr (ROPE) {
            const long pos = pos0 + wid * QBLK + r32;
#pragma unroll
            for (int dd = 0; dd < 2; ++dd) { const int d0 = 8 + dd, i0 = dd * 16 + hi * 8;
                float cs[8], sn[8], ga[8], gb[8];
                { const f32x4 c0 = *reinterpret_cast<const f32x4*>(ropec + pos * 32 + i0), c1 = *reinterpret_cast<const f32x4*>(ropec + pos * 32 + i0 + 4);
                  const f32x4 s0 = *reinterpret_cast<const f32x4*>(ropes + pos * 32 + i0), s1 = *reinterpret_cast<const f32x4*>(ropes + pos * 32 + i0 + 4);
                  const f32x4 a0 = *reinterpret_cast<const f32x4*>(qg + d0 * 16 + hi * 8), a1 = *reinterpret_cast<const f32x4*>(qg + d0 * 16 + hi * 8 + 4);
                  const f32x4 b0 = *reinterpret_cast<const f32x4*>(qg + (d0 + 2) * 16 + hi * 8), b1 = *reinterpret_cast<const f32x4*>(qg + (d0 + 2) * 16 + hi * 8 + 4);
#pragma unroll
                  for (int j = 0; j < 4; ++j) { cs[j] = c0[j]; cs[4 + j] = c1[j]; sn[j] = s0[j]; sn[4 + j] = s1[j]; ga[j] = a0[j]; ga[4 + j] = a1[j]; gb[j] = b0[j]; gb[4 + j] = b1[j]; } }
                u32x4 w1, w2;
#pragma unroll
                for (int j = 0; j < 4; ++j) {
                    const float x1l = bflo(raw[d0][j]) * rstd * ga[2 * j], x1h = bfhi(raw[d0][j]) * rstd * ga[2 * j + 1];
                    const float x2l = bflo(raw[d0 + 2][j]) * rstd * gb[2 * j], x2h = bfhi(raw[d0 + 2][j]) * rstd * gb[2 * j + 1];
                    w1[j] = cvt_pk_bf16(x1l * cs[2 * j] - x2l * sn[2 * j], x1h * cs[2 * j + 1] - x2h * sn[2 * j + 1]);
                    w2[j] = cvt_pk_bf16(x1l * sn[2 * j] + x2l * cs[2 * j], x1h * sn[2 * j + 1] + x2h * cs[2 * j + 1]); }
                qr[d0] = *reinterpret_cast<bf16x8*>(&w1); qr[d0 + 2] = *reinterpret_cast<bf16x8*>(&w2); }
        }
    }
    const int vb0 = (int)(uintptr_t)V_lds + v_rd_base(lane);
    unsigned kgo[G::NKI], vgo[1];
#pragma unroll
    for (int t = 0; t < G::NKI; ++t) { const int q = (wid * G::NKI + t) * 64 + lane, row = q / G::CPR, pc = q % G::CPR; kgo[t] = (unsigned)(row * ldk * 2 + ((pc ^ kswz<DQK>(row)) * 16)); }
#pragma unroll
    for (int t = 0; t < 1; ++t) { const int q = (wid * 2 + t) * 64 + lane, sub = q >> 5, within = q & 31;   const int kk = ((sub >> 2) << 3) | (within >> 2), cc = (sub & 3) * 32 + (within & 3) * 8;
        const int key = (kk & ~0xC) | ((kk & 4) << 1) | ((kk & 8) >> 1); vgo[t] = (unsigned)(key * ldv * 2 + cc * 2); }
    const int koffs = r32 * G::KROW + (hi ^ kswz<DQK>(r32)) * 16;
    const char* Kg = (const char*)Kh; const char* Vg = (const char*)Vh;
#define SDMA(tile, kslot, vslot) do { const char* kb_ = Kg + (size_t)(tile) * KVBLK * ldk * 2; const char* vb_ = Vg + (size_t)(tile) * KVBLK * ldv * 2; \
    asm volatile("" : "+s"(kb_), "+s"(vb_));     \
    _Pragma("unroll") for (int t_ = 0; t_ < G::NKI; ++t_) { unsigned ko_ = kgo[t_]; asm volatile("" : "+v"(ko_)); __builtin_amdgcn_global_load_lds((const unsigned*)(kb_ + ko_), (LAS unsigned*)(K_lds + (kslot) * G::SHM_K + (wid * G::NKI + t_) * 1024), 16, 0, 0); } \
    _Pragma("unroll") for (int t_ = 0; t_ < 2; ++t_) { unsigned vo_ = vgo[0] + t_ * 128; asm volatile("" : "+v"(vo_)); __builtin_amdgcn_global_load_lds((const unsigned*)(vb_ + vo_), (LAS unsigned*)(V_lds + (vslot) * SHM_V + (wid * 2 + t_) * 1024), 16, 0, 0); } } while (0)
#define RESC(a) do { if (__any((a) < 1.f)) { if (hi == 0) al_l[r32] = (a); asm volatile("s_waitcnt lgkmcnt(0)" ::: "memory"); \
    _Pragma("unroll") for (int d = 0; d < 4; ++d) _Pragma("unroll") for (int r = 0; r < 16; ++r) o[d][r] *= al_l[crow(r, hi)]; } } while (0)
    f32x16 pA0, pA1, pB0, pB1; bf16x8 pa0, pa1, pa2, pa3; const int NT = nkeys / KVBLK;
    const char* Ksl = K_lds;
    SDMA(0, 0, 0); __syncthreads();
    SDMA(1, 1, 1);
    qkt<DQK>(pA0, pA1, Ksl, koffs, qr, negm); { float al0; partialSM<true>(pA0, pA1, negm, al0, l_reg); }
    __syncthreads();
    int vs = 0;
    for (int j = 1; j + 1 < NT; j += 2) {
        const int v1 = vs == 2 ? 0 : vs + 1, v2 = v1 == 2 ? 0 : v1 + 1;
        SDMA(j + 1, 0, v2);
        SBAR(); qkt<DQK>(pB0, pB1, Ksl + G::SHM_K, koffs, qr, negm);
        finishSM(pA0, pA1, l_reg, pa0, pa1, pa2, pa3); SBAR();
        pv_d0(o, vb0 + vs * SHM_V, pa0, pa1, pa2, pa3); { float al_; partialSM<false>(pB0, pB1, negm, al_, l_reg); RESC(al_); } __syncthreads();
        const int v3 = v2 == 2 ? 0 : v2 + 1;
        SDMA(j + 2, 1, v3);
        SBAR(); qkt<DQK>(pA0, pA1, Ksl, koffs, qr, negm);
        finishSM(pB0, pB1, l_reg, pa0, pa1, pa2, pa3); SBAR();
        pv_d0(o, vb0 + v1 * SHM_V, pa0, pa1, pa2, pa3); { float al_; partialSM<false>(pA0, pA1, negm, al_, l_reg); RESC(al_); } __syncthreads();
        vs = v2;
    }
    {   const int v1 = vs == 2 ? 0 : vs + 1;
        SBAR(); qkt<DQK>(pB0, pB1, Ksl + G::SHM_K, koffs, qr, negm);
        finishSM(pA0, pA1, l_reg, pa0, pa1, pa2, pa3); SBAR();
        pv_d0(o, vb0 + vs * SHM_V, pa0, pa1, pa2, pa3); { float al_; partialSM<false>(pB0, pB1, negm, al_, l_reg); RESC(al_); }
        finishSM(pB0, pB1, l_reg, pa0, pa1, pa2, pa3); SBAR();
        pv_d0(o, vb0 + v1 * SHM_V, pa0, pa1, pa2, pa3); }
    { auto rr = __builtin_amdgcn_permlane32_swap(__float_as_uint(l_reg), __float_as_uint(l_reg), false, false); l_reg = __uint_as_float(rr[0]) + __uint_as_float(rr[1]); }
    if (hi == 0) li_l[r32] = l_reg; asm volatile("s_waitcnt lgkmcnt(0)" ::: "memory");
    const int lane_e = opaque_lane(), hi_e = lane_e >> 5;
    float rli[16];
#pragma unroll
    for (int r = 0; r < 16; ++r) rli[r] = __builtin_amdgcn_rcpf(li_l[crow(r, hi_e)]);
    bf16* Ow = Ob + (long)(wid * QBLK) * ldo;
    char* ost = lds + 3 * SHM_V + 2 * G::SHM_K + 2048 + wid * 4608;
#pragma unroll
    for (int h = 0; h < 2; ++h) {
#pragma unroll
        for (int r = 0; r < 16; ++r) { const unsigned w = cvt_pk_bf16(o[2 * h][r] * rli[r], o[2 * h + 1][r] * rli[r]); char* q = ost + crow(r, hi_e) * 144 + (lane_e & 31) * 2;
            *(unsigned short*)q = (unsigned short)(w & 0xffffu); *(unsigned short*)(q + 64) = (unsigned short)(w >> 16); }
        asm volatile("s_waitcnt lgkmcnt(0)" ::: "memory");
#pragma unroll
        for (int i = 0; i < 4; ++i) { const int row = (lane_e >> 3) + 8 * i; const u32x4 v = *(const u32x4*)(ost + row * 144 + (lane_e & 7) * 16);
            *(u32x4*)(Ow + (long)row * ldo + h * 64 + (lane_e & 7) * 8) = v; }
    }
    __syncthreads();
#undef SDMA
#undef RESC
}
}

#define XB_TMO      128
#define XB_XCNT(j)  (256  + 64 * (j))
#define XB_XSUB(j)  (1280 + 64 * (j))
#define XB_XGEN(j)  (2304 + 64 * (j))
#define XB_TOP      3328
#define XB_TOPGEN   3392
#define XCD_BAR_WORDS 3456
#define XB_SPIN_CAP (1u << 20)
__device__ __forceinline__ unsigned xb_ld(unsigned* p)              { return __hip_atomic_load(p, __ATOMIC_RELAXED, __HIP_MEMORY_SCOPE_AGENT); }
__device__ __forceinline__ unsigned xb_add(unsigned* p, unsigned v) { return __hip_atomic_fetch_add(p, v, __ATOMIC_RELAXED, __HIP_MEMORY_SCOPE_AGENT); }
__device__ __forceinline__ unsigned xb_xcc_id() { return (unsigned)__builtin_amdgcn_s_getreg((3 << 11) | 20) & 0xFu; }
#define XB_SPIN(cond, bar) do { unsigned _sp = 0; while (cond) { __builtin_amdgcn_s_sleep(1); \
    if ((++_sp & 255u) == 0u) { if (xb_ld(&(bar)[XB_TMO])) break; if (_sp > XB_SPIN_CAP) { atomicAdd(&(bar)[XB_TMO], 1u); break; } } } } while (0)
struct XcdBarrier { unsigned* bar; unsigned x; volatile LAS unsigned* st; int w; };
__device__ __forceinline__ XcdBarrier xcd_barrier_post(unsigned* bar, volatile LAS unsigned* st) {
    XcdBarrier b; b.bar = bar; b.x = xb_xcc_id(); b.st = st;
    if (threadIdx.x == 0) (void)xb_add(&bar[XB_XCNT(b.x)], 1u);
    return b;
}
__device__ __forceinline__ void xcd_barrier_complete(unsigned* bar, unsigned x, unsigned& nloc, unsigned& nx) {
    const unsigned G = gridDim.x * gridDim.y * gridDim.z;
    unsigned sum, cnt, mine, sp = 0u;
    for (;;) {
        sum = 0u; cnt = 0u; mine = 0u;
#pragma unroll
        for (unsigned j = 0; j < 16; ++j) { const unsigned c = xb_ld(&bar[XB_XCNT(j)]); sum += c; cnt += (c > 0u) ? 1u : 0u; mine = (j == x) ? c : mine; }
        if (sum == G) break;
        __builtin_amdgcn_s_sleep(1);
        if ((++sp & 255u) == 0u) { if (xb_ld(&bar[XB_TMO])) break; if (sp > XB_SPIN_CAP) { atomicAdd(&bar[XB_TMO], 1u); break; } }
    }
    nloc = mine > 0u ? mine : 1u; nx = cnt > 0u ? cnt : 1u;
}
__device__ __forceinline__ void xcd_barrier(const XcdBarrier& b) {
    asm volatile("s_waitcnt vmcnt(0)" ::: "memory");
    __syncthreads();
    if (opaque_tid(b.w) == 0) {
        unsigned* bar = b.bar;
        __builtin_amdgcn_s_waitcnt(0);
        unsigned nloc = b.st[0], nx = b.st[1];
        if (nloc == 0u) { xcd_barrier_complete(bar, b.x, nloc, nx); b.st[0] = nloc; b.st[1] = nx; }
        const unsigned old = xb_add(&bar[XB_XSUB(b.x)], 1u);
        const unsigned gen = old / nloc;
        if (old + 1u == (gen + 1u) * nloc) {
            __builtin_amdgcn_fence(__ATOMIC_RELEASE, "agent");
            asm volatile("s_waitcnt vmcnt(0)" ::: "memory");
            const unsigned og = xb_add(&bar[XB_TOP], 1u);
            const unsigned tg = og / nx;
            if (og + 1u == (tg + 1u) * nx) xb_add(&bar[XB_TOPGEN], 1u);
            else XB_SPIN(xb_ld(&bar[XB_TOPGEN]) == tg, bar);
            __builtin_amdgcn_fence(__ATOMIC_ACQUIRE, "agent");
            xb_add(&bar[XB_XGEN(b.x)], 1u);
            asm volatile("s_waitcnt vmcnt(0)" ::: "memory");
        } else {
            XB_SPIN(xb_ld(&bar[XB_XGEN(b.x)]) == gen, bar);
            __builtin_amdgcn_fence(__ATOMIC_ACQUIRE, "agent");
            asm volatile("s_waitcnt vmcnt(0)" ::: "memory");
        }
    }
    __syncthreads();
}

template <int MODE>
__device__ __forceinline__ void transpose_item(const float* __restrict__ W, int K, int N, bf16* __restrict__ WT, const float* __restrict__ gk, LAS float* scr, int item, int lane) {
    const int nblk = N / 32, kb = item / nblk, nb = item % nblk, k0 = 64 * kb, n0 = 32 * nb;
#pragma unroll 8
    for (int i = 0; i < 32; ++i) { const int kk = 2 * i + (lane >> 5); float w = W[(size_t)(k0 + kk) * N + n0 + (lane & 31)]; if (gk) w *= gk[k0 + kk]; scr[kk * 33 + (lane & 31)] = w; }
    LDS_WAIT(); asm volatile("" ::: "memory");
    const int c = lane & 7;
#pragma unroll
    for (int j = 0; j < 4; ++j) { const int n = (lane >> 3) + 8 * j; const LAS float* s = scr + (8 * c) * 33 + n;
        u32x4 o; o.x = cvt_pk_bf16(s[0 * 33], s[1 * 33]); o.y = cvt_pk_bf16(s[2 * 33], s[3 * 33]); o.z = cvt_pk_bf16(s[4 * 33], s[5 * 33]); o.w = cvt_pk_bf16(s[6 * 33], s[7 * 33]);
        int nn = n0 + n; if (MODE == 1) { const int hh = nn >> 8, jj = nn & 255; nn = hh * 320 + (jj < 128 ? jj : jj + 64); }
        *(u32x4*)(WT + (size_t)nn * K + k0 + 8 * c) = o; }
    LDS_WAIT(); asm volatile("" ::: "memory");
}
__device__ __forceinline__ void rms_row_to_bf16(const float* __restrict__ xrow, const float* __restrict__ g, bf16* __restrict__ orow, int lane) {
    const f32x4* xr = (const f32x4*)xrow + lane; f32x4 v[8]; float s = 0.f;
#pragma unroll
    for (int j = 0; j < 8; ++j) { v[j] = xr[64 * j]; s += (v[j].x * v[j].x + v[j].y * v[j].y) + (v[j].z * v[j].z + v[j].w * v[j].w); }
    const float r = rsqrtf(wave_sum(s, lane) * (1.f / D) + EPS);
    u32x2* o8 = (u32x2*)orow + lane;
#pragma unroll
    for (int j = 0; j < 8; ++j) { const f32x4 gg = ((const f32x4*)g)[lane + 64 * j]; u32x2 w; w.x = cvt_pk_bf16(v[j].x * r * gg.x, v[j].y * r * gg.y); w.y = cvt_pk_bf16(v[j].z * r * gg.z, v[j].w * r * gg.w); o8[64 * j] = w; }
}

template <int NK>
__device__ __forceinline__ void hgrn_scan_item(const bf16* __restrict__ Zv, int row0, int L, int hh, int dir, int kbase, const float* __restrict__ lbl, bf16* __restrict__ Oo,
                                               LAS unsigned char* lds, const unsigned char* lds_gen, int tid, int lane, int wave) {
    constexpr int NPAIR = NK / 2, NPART = 256 / NPAIR, SPT = 64 / NPART, QROW = NK * 2 + 16, ND0 = NK / 16, NKB = NK / 32;
    constexpr int O_KT = 64 * QROW, O_KTT = 128 * QROW, O_VL = 128 * QROW + NK * 144, O_FAC = O_VL + 16384, BUF = O_FAC + 3 * NK * 4;
    static_assert(2 * BUF + NPART * NK * 4 <= 147328, "HGRN LDS");
    LAS float* TOT = (LAS float*)(lds + 2 * BUF);
    const int nchunk = L >> 6;
#define HG_POS(n) (dir ? (L - 1 - (n)) : (n))
    if (wave >= 4) {
        const int ptid = tid - 256, kp = ptid % NPAIR, part = ptid / NPAIR, vr = ptid >> 4, sc = (ptid & 15) * 8;
        const int zc = hh * 128 + kbase + 2 * kp;
        float lb0, lb1; { const float* lg = lbl + dir * 2048 + zc; const f32x2 l0 = *(const f32x2*)lg, l1 = *(const f32x2*)(lg + 4096), l2 = *(const f32x2*)(lg + 8192), l3 = *(const f32x2*)(lg + 12288);
            { const float mx = fmaxf(fmaxf(l0.x, l1.x), fmaxf(l2.x, l3.x)); const float e0 = __expf(l0.x - mx), e1 = __expf(l1.x - mx), e2 = __expf(l2.x - mx), e3 = __expf(l3.x - mx); lb0 = e1 / (e0 + e1 + e2 + e3); }
            { const float mx = fmaxf(fmaxf(l0.y, l1.y), fmaxf(l2.y, l3.y)); const float e0 = __expf(l0.y - mx), e1 = __expf(l1.y - mx), e2 = __expf(l2.y - mx), e3 = __expf(l3.y - mx); lb1 = e1 / (e0 + e1 + e2 + e3); } }
        int vst[4];
#pragma unroll
        for (int i = 0; i < 4; ++i) vst[i] = att::v_st(vr + 16 * i, sc);
        unsigned hq_[SPT], hz_[SPT]; bf16x8 rv[4];
#define HG_LOAD(ch) do { _Pragma("unroll") for (int i = 0; i < SPT; ++i) { const int n = (ch) * 64 + part * SPT + i; const bf16* zr = Zv + (size_t)(row0 + HG_POS(n)) * 10240 + zc; hq_[i] = *(const unsigned*)zr; hz_[i] = *(const unsigned*)(zr + 2048 + dir * 2048); } \
        _Pragma("unroll") for (int i = 0; i < 4; ++i) rv[i] = *(const bf16x8*)(Zv + (size_t)(row0 + HG_POS((ch) * 64 + vr + 16 * i)) * 10240 + 6144 + hh * 128 + sc); } while (0)
        HG_LOAD(0);
        for (int s = -1; s < nchunk; ++s) {
            const bool work = s + 1 < nchunk; LAS unsigned char* B = lds + ((s + 1) & 1) * BUF;
            float run0[SPT], run1[SPT], kk0[SPT], kk1[SPT]; unsigned qraw[SPT];
            if (work) {
                float a0 = 0.f, a1 = 0.f;
#pragma unroll
                for (int i = 0; i < SPT; ++i) { const float z0 = bflo(hz_[i]), z1 = bfhi(hz_[i]);
                    const float s0 = __builtin_amdgcn_rcpf(1.f + __expf(-z0)), s1 = __builtin_amdgcn_rcpf(1.f + __expf(-z1));
                    const float f0 = lb0 + (1.f - lb0) * s0, f1 = lb1 + (1.f - lb1) * s1;
                    kk0[i] = (1.f - lb0) * (1.f - s0); kk1[i] = (1.f - lb1) * (1.f - s1);
                    a0 += __logf(f0); a1 += __logf(f1); run0[i] = a0; run1[i] = a1; qraw[i] = hq_[i]; }
                *(LAS f32x2*)(TOT + part * NK + 2 * kp) = (f32x2){a0, a1};
#pragma unroll
                for (int i = 0; i < 4; ++i) *(LAS bf16x8*)(B + O_VL + vst[i]) = rv[i];
            }
            __syncthreads();
            if (work) {
                float base0 = 0.f, base1 = 0.f, rr0 = 0.f, rr1 = 0.f, bl0 = 0.f, bl1 = 0.f;
#pragma unroll
                for (int q = 0; q < NPART; ++q) { const f32x2 t = *(const LAS f32x2*)(TOT + q * NK + 2 * kp); if (q < part) { base0 += t.x; base1 += t.y; } if (q < NPART / 2) { rr0 += t.x; rr1 += t.y; } bl0 += t.x; bl1 += t.y; }
                base0 -= rr0; base1 -= rr1;
                unsigned kw0[SPT / 2], kw1[SPT / 2];
#pragma unroll
                for (int i = 0; i < SPT; i += 2) {
                    const float d00 = fminf(fmaxf(base0 + run0[i], -60.f), 60.f), d01 = fminf(fmaxf(base1 + run1[i], -60.f), 60.f);
                    const float d10 = fminf(fmaxf(base0 + run0[i + 1], -60.f), 60.f), d11 = fminf(fmaxf(base1 + run1[i + 1], -60.f), 60.f);
                    const float ka0 = kk0[i] * __expf(-d00), ka1 = kk1[i] * __expf(-d01), kb0 = kk0[i + 1] * __expf(-d10), kb1 = kk1[i + 1] * __expf(-d11);
                    const int st = part * SPT + i;
                    *(LAS unsigned*)(B + st * QROW + kp * 4) = cvt_pk_bf16(bflo(qraw[i]) * __expf(d00), bfhi(qraw[i]) * __expf(d01));
                    *(LAS unsigned*)(B + (st + 1) * QROW + kp * 4) = cvt_pk_bf16(bflo(qraw[i + 1]) * __expf(d10), bfhi(qraw[i + 1]) * __expf(d11));
                    *(LAS unsigned*)(B + O_KT + st * QROW + kp * 4) = cvt_pk_bf16(ka0, ka1);
                    *(LAS unsigned*)(B + O_KT + (st + 1) * QROW + kp * 4) = cvt_pk_bf16(kb0, kb1);
                    kw0[i >> 1] = cvt_pk_bf16(ka0, kb0); kw1[i >> 1] = cvt_pk_bf16(ka1, kb1); }
#pragma unroll
                for (int i = 0; i < SPT / 8; ++i) {
                    *(LAS u32x4*)(B + O_KTT + (2 * kp) * 144 + part * SPT * 2 + 16 * i) = (u32x4){kw0[4 * i], kw0[4 * i + 1], kw0[4 * i + 2], kw0[4 * i + 3]};
                    *(LAS u32x4*)(B + O_KTT + (2 * kp + 1) * 144 + part * SPT * 2 + 16 * i) = (u32x4){kw1[4 * i], kw1[4 * i + 1], kw1[4 * i + 2], kw1[4 * i + 3]}; }
                if (part == 0) { LAS float* FAC = (LAS float*)(B + O_FAC);
                    *(LAS f32x2*)(FAC + 2 * kp) = (f32x2){__expf(rr0), __expf(rr1)}; *(LAS f32x2*)(FAC + NK + 2 * kp) = (f32x2){__expf(bl0), __expf(bl1)}; *(LAS f32x2*)(FAC + 2 * NK + 2 * kp) = (f32x2){__expf(bl0 - rr0), __expf(bl1 - rr1)}; }
                if (s + 2 < nchunk) HG_LOAD(s + 2);
            }
            __syncthreads();
        }
#undef HG_LOAD
    } else {
        const int vb = wave, r32 = lane & 31, hi = lane >> 5;
        const int olane = (dir ? 63 - 4 * hi : 4 * hi) * (D * 2) + r32 * 2;
        f32x16 St[NKB];
#pragma unroll
        for (int i = 0; i < NKB; ++i) St[i] = f32x16{};
#define HG_PK(L_, H_) (bf16x8){L_[0], L_[1], L_[2], L_[3], H_[0], H_[1], H_[2], H_[3]}
#define HG_PK4(P_, BASE_, OUT_) do { unsigned a0_ = cvt_pk_bf16(P_[BASE_ + 0], P_[BASE_ + 1]), a1_ = cvt_pk_bf16(P_[BASE_ + 2], P_[BASE_ + 3]); \
    unsigned b0_ = cvt_pk_bf16(P_[BASE_ + 4], P_[BASE_ + 5]), b1_ = cvt_pk_bf16(P_[BASE_ + 6], P_[BASE_ + 7]); \
    auto r0_ = __builtin_amdgcn_permlane32_swap(a0_, b0_, false, false); auto r1_ = __builtin_amdgcn_permlane32_swap(a1_, b1_, false, false); \
    u32x4 w_ = {r0_[0], r1_[0], r0_[1], r1_[1]}; OUT_ = *reinterpret_cast<bf16x8*>(&w_); } while (0)
        for (int s = -1; s < nchunk; ++s) {
            LAS unsigned char* QT = lds + (s & 1) * BUF; LAS unsigned char* KT = QT + O_KT; LAS unsigned char* KTT = QT + O_KTT; LAS float* FAC = (LAS float*)(QT + O_FAC);
            bf16x8 vf[4]; f32x16 od0 = f32x16{}, od1 = f32x16{};
            if (s >= 0) {
                const int vbase = (int)(uintptr_t)(lds_gen + (s & 1) * BUF + O_VL) + att::v_rd_base(lane) + vb * 512;
                { const s16x4 l0 = att::tr_read<att::v_rd_off(0, 0, 0)>(vbase), h0 = att::tr_read<att::v_rd_off(0, 0, 1)>(vbase), l1 = att::tr_read<att::v_rd_off(0, 1, 0)>(vbase), h1 = att::tr_read<att::v_rd_off(0, 1, 1)>(vbase);
                  const s16x4 l2 = att::tr_read<att::v_rd_off(0, 2, 0)>(vbase), h2 = att::tr_read<att::v_rd_off(0, 2, 1)>(vbase), l3 = att::tr_read<att::v_rd_off(0, 3, 0)>(vbase), h3 = att::tr_read<att::v_rd_off(0, 3, 1)>(vbase);
                  asm volatile("s_waitcnt lgkmcnt(0)" ::: "memory"); __builtin_amdgcn_sched_barrier(0);
                  vf[0] = HG_PK(l0, h0); vf[1] = HG_PK(l1, h1); vf[2] = HG_PK(l2, h2); vf[3] = HG_PK(l3, h3); }
                {
                    f32x16 p0 = f32x16{};
#pragma unroll
                    for (int d0 = 0; d0 < ND0; ++d0) { const int cb = (d0 * 16 + hi * 8) * 2;
                        const bf16x8 a = *(const LAS bf16x8*)(KT + r32 * QROW + cb), b = *(const LAS bf16x8*)(QT + r32 * QROW + cb);
                        p0 = __builtin_amdgcn_mfma_f32_32x32x16_bf16(a, b, p0, 0, 0, 0); }
#pragma unroll
                    for (int r = 0; r < 16; ++r) if (att::crow(r, hi) > r32) p0[r] = 0.f;
                    bf16x8 pa0, pa1; HG_PK4(p0, 0, pa0); HG_PK4(p0, 8, pa1);
                    od0 = __builtin_amdgcn_mfma_f32_32x32x16_bf16(pa0, vf[0], od0, 0, 0, 0); od0 = __builtin_amdgcn_mfma_f32_32x32x16_bf16(pa1, vf[1], od0, 0, 0, 0); }
                {
                    f32x16 p0 = f32x16{}, p1 = f32x16{};
#pragma unroll
                    for (int d0 = 0; d0 < ND0; ++d0) { const int cb = (d0 * 16 + hi * 8) * 2;
                        const bf16x8 a0_ = *(const LAS bf16x8*)(KT + r32 * QROW + cb), a1_ = *(const LAS bf16x8*)(KT + (32 + r32) * QROW + cb), b = *(const LAS bf16x8*)(QT + (32 + r32) * QROW + cb);
                        p0 = __builtin_amdgcn_mfma_f32_32x32x16_bf16(a0_, b, p0, 0, 0, 0); p1 = __builtin_amdgcn_mfma_f32_32x32x16_bf16(a1_, b, p1, 0, 0, 0); }
#pragma unroll
                    for (int r = 0; r < 16; ++r) if (att::crow(r, hi) > r32) p1[r] = 0.f;
                    bf16x8 pa0, pa1, pa2, pa3; HG_PK4(p0, 0, pa0); HG_PK4(p0, 8, pa1); HG_PK4(p1, 0, pa2); HG_PK4(p1, 8, pa3);
                    od1 = __builtin_amdgcn_mfma_f32_32x32x16_bf16(pa0, vf[0], od1, 0, 0, 0); od1 = __builtin_amdgcn_mfma_f32_32x32x16_bf16(pa1, vf[1], od1, 0, 0, 0);
                    od1 = __builtin_amdgcn_mfma_f32_32x32x16_bf16(pa2, vf[2], od1, 0, 0, 0); od1 = __builtin_amdgcn_mfma_f32_32x32x16_bf16(pa3, vf[3], od1, 0, 0, 0); }
            }
            __syncthreads();
            if (s >= 0) {
#pragma unroll
                for (int kb = 0; kb < NKB; ++kb) {
                    float er[16];
#pragma unroll
                    for (int m = 0; m < 4; ++m) { const f32x4 e4 = *(const LAS f32x4*)(FAC + 32 * kb + 8 * m + 4 * hi); er[4 * m] = e4[0]; er[4 * m + 1] = e4[1]; er[4 * m + 2] = e4[2]; er[4 * m + 3] = e4[3]; }
#pragma unroll
                    for (int s2 = 0; s2 < 2; ++s2) {
                        u32x4 bw;
#pragma unroll
                        for (int j = 0; j < 4; ++j) bw[j] = cvt_pk_bf16(St[kb][8 * s2 + 2 * j] * er[8 * s2 + 2 * j], St[kb][8 * s2 + 2 * j + 1] * er[8 * s2 + 2 * j + 1]);
                        const bf16x8 bfr = *reinterpret_cast<bf16x8*>(&bw);
                        const int ko = (32 * kb + 16 * s2 + 4 * hi) * 2;
                        const u32x2 x0 = *(const LAS u32x2*)(QT + r32 * QROW + ko), x1 = *(const LAS u32x2*)(QT + r32 * QROW + ko + 16);
                        const u32x2 y0 = *(const LAS u32x2*)(QT + (32 + r32) * QROW + ko), y1 = *(const LAS u32x2*)(QT + (32 + r32) * QROW + ko + 16);
                        u32x4 aw0 = {x0[0], x0[1], x1[0], x1[1]}, aw1 = {y0[0], y0[1], y1[0], y1[1]};
                        od0 = __builtin_amdgcn_mfma_f32_32x32x16_bf16(*reinterpret_cast<bf16x8*>(&aw0), bfr, od0, 0, 0, 0);
                        od1 = __builtin_amdgcn_mfma_f32_32x32x16_bf16(*reinterpret_cast<bf16x8*>(&aw1), bfr, od1, 0, 0, 0); } }
                {   unsigned char* Ob = (unsigned char*)(Oo + (size_t)(row0 + (dir ? L - 64 - s * 64 : s * 64)) * D + hh * 128 + 32 * vb);
#define HG_ST(SG_) do { _Pragma("unroll") for (int r = 0; r < 16; r += 2) { constexpr int c0 = 0; const int cr = (r & 3) + 8 * (r >> 2) + c0;     \
                        const unsigned w0 = cvt_pk_bf16(od0[r], od0[r + 1]), w1 = cvt_pk_bf16(od1[r], od1[r + 1]); \
                        *(unsigned short*)(Ob + (unsigned)(ol_ + (SG_) * cr * (D * 2))) = (unsigned short)(w0 & 0xffffu); *(unsigned short*)(Ob + (unsigned)(ol_ + (SG_) * (cr + 1) * (D * 2))) = (unsigned short)(w0 >> 16); \
                        *(unsigned short*)(Ob + (unsigned)(ol_ + (SG_) * (cr + 32) * (D * 2))) = (unsigned short)(w1 & 0xffffu); *(unsigned short*)(Ob + (unsigned)(ol_ + (SG_) * (cr + 33) * (D * 2))) = (unsigned short)(w1 >> 16); } } while (0)
                    int ol_ = olane; asm volatile("" : "+v"(ol_));
                    if (dir) HG_ST(-1); else HG_ST(1);
#undef HG_ST
                }
#pragma unroll
                for (int kb = 0; kb < NKB; ++kb) {
                    f32x16 U = f32x16{};
#pragma unroll
                    for (int ks = 0; ks < 4; ++ks) { const bf16x8 a = *(const LAS bf16x8*)(KTT + (32 * kb + r32) * 144 + (16 * ks + 8 * hi) * 2); U = __builtin_amdgcn_mfma_f32_32x32x16_bf16(a, vf[ks], U, 0, 0, 0); }
#pragma unroll
                    for (int m = 0; m < 4; ++m) { const f32x4 el = *(const LAS f32x4*)(FAC + NK + 32 * kb + 8 * m + 4 * hi), elr = *(const LAS f32x4*)(FAC + 2 * NK + 32 * kb + 8 * m + 4 * hi);
#pragma unroll
                        for (int e = 0; e < 4; ++e) St[kb][4 * m + e] = el[e] * St[kb][4 * m + e] + elr[e] * U[4 * m + e]; } }
            }
            __syncthreads();
        }
#undef HG_PK
#undef HG_PK4
    }
#undef HG_POS
    __syncthreads();
}

__device__ __forceinline__ void reduce_rstd(const float* __restrict__ ssp, float* __restrict__ rstd, int i0, int stride) {
    for (int row = i0; row < T; row += stride) { float s = 0.f;
#pragma unroll
        for (int j = 0; j < 8; ++j) { const float* p = ssp + (size_t)(4 * j) * T + row; s += (p[0] + p[T]) + (p[2 * (size_t)T] + p[3 * (size_t)T]); }
        rstd[row] = rsqrtf(s * (1.f / D) + EPS); }
}
struct Args { const float* in[28]; float* out; unsigned char* ws; int ph_lo, ph_hi, li, pad; };
constexpr int RING_BYTES = 131072, LDS_BYTES = 147456, MISC_OFF = LDS_BYTES - 128;

__host__ __device__ constexpr int n_phases() {
    int n = 1;
    for (int layer = 0; layer < 4; ++layer) {
        n += 1;
        if (layer == 0) n += 1;
        const int kind = layer % 3;
        if (kind == 0) n += 2 + 3 * 3 + 1;
        else if (kind == 1) n += 3 * 3 + 1;
        else n += 5;
        n += 3;
        n += 1 + 4;
    }
    return n;
}
constexpr int NPH = n_phases();

#define H      ((bf16*)X)
#define Xb     ((bf16*)(ws + LO(WS_H)))
#define rstd_  ((float*)(ws + LO(WS_RSTD)))
#define ssp_   ((float*)(ws + LO(WS_SSP)))
#define ropec  ((float*)(ws + LO(WS_ROPE)))
#define ropes  ((float*)(ws + LO(WS_ROPE)) + 4096 * 32)
#define mem_rs ((float*)(ws + LO(WS_MEMRS)))
#define mem_b  ((bf16*)(ws + LO(WS_MEMB)))
#define memkv  ((bf16*)(ws + LO(WS_MEMKV)))
#define w1t    ((bf16*)(ws + LO(WS_W1)))
#define w2t    ((bf16*)(ws + LO(WS_W2)))
#define rq     ((float*)(ws + LO(WS_SS0)))
#define rkv_   ((float*)(ws + LO(WS_SS0) + 262144))
#define P      ((bf16*)(ws + LO(S_P)))
#define Qv     ((bf16*)(ws + LO(S_QC)) - (size_t)c * CH * 3072)
#define KVv    ((bf16*)(ws + LO(S_KVC)) - (size_t)c * CH * 5120)
#define Zv     ((bf16*)(ws + LO(S_Z)) - (size_t)c * CH * 10240)
#define OFv    ((bf16*)(ws + LO(S_OF)) - (size_t)c * CH * D)
#define OBv    ((bf16*)(ws + LO(S_OB)) - (size_t)c * CH * D)
#define OP2v   ((bf16*)X + (size_t)T * D - (size_t)c * CH * D)
#define OP3v   ((bf16*)X + (size_t)T * D + (size_t)CH * D - (size_t)c * CH * D)
#define T1     ((bf16*)(ws + LO(S_T1)))
#define Qm     ((bf16*)(ws + LO(S_QM)))
#define Om     ((bf16*)(ws + LO(S_OM)))
#define Hv     ((bf16*)(ws + LO(S_HID) + (size_t)(c & 1) * 256 * MiB) - (size_t)c * CH * DFF)
__global__ void __launch_bounds__(NWAVES * 64, 2) fwd(Args args) {
    extern __shared__ __attribute__((aligned(16))) unsigned char lds_raw[];
    LAS unsigned char* lds = (LAS unsigned char*)lds_raw;
    const int G0_ = gridDim.x, bx0_ = blockIdx.x, wid0_ = __builtin_amdgcn_readfirstlane((int)(threadIdx.x >> 6));
    const int vcu0_ = (G0_ % 8 == 0) ? (bx0_ % 8) * (G0_ / 8) + bx0_ / 8 : bx0_;
    unsigned* ctl = (unsigned*)(args.ws + WS_CTL);
    volatile LAS unsigned* MISC = (volatile LAS unsigned*)(lds + MISC_OFF);
    if (threadIdx.x < 16) MISC[threadIdx.x] = 0u;
    __syncthreads();
    const int lo = args.ph_lo, hi = args.ph_hi;
    XcdBarrier bar; bar.bar = ctl + CW_BAR + args.li * XCD_BAR_WORDS; bar.x = 0; bar.st = MISC + 8; bar.w = wid0_;
    if (hi - lo > 1) { bar = xcd_barrier_post(ctl + CW_BAR + args.li * XCD_BAR_WORDS, MISC + 8); bar.w = wid0_; }
    int ph = 0;
#define PH_BEGIN(id) asm volatile("" : "+s"(ph)); if (ph >= lo && ph < hi) { if (PHMASK & (1ull << (id))) for (int rep_ = 0; rep_ < (((REPMASK >> (id)) & 1ull) ? 2 : 1); ++rep_) { if (rep_) __syncthreads(); const int G = launder_i(G0_), bx = launder_i(bx0_), vcu = launder_i(vcu0_), NGW = G * NWAVES; (void)bx; (void)NGW; const int wave = launder_i(wid0_), tid = opaque_tid(wave), lane = tid & 63, gw = vcu * NWAVES + wave; (void)lane; (void)gw; unsigned char* ws = launder_p(args.ws); float* X = (float*)launder_p((unsigned char*)args.out); (void)X;
#define PH_END   } if (ph + 1 < hi) { XcdBarrier b2_ = bar; b2_.bar = (unsigned*)launder_p((unsigned char*)bar.bar); xcd_barrier(b2_); } } ++ph;


    PH_BEGIN(0)
    {
        for (int m = gw; m < T; m += NGW) { const float* src_ = (m < TPR ? in_ptr(0) + (size_t)m * D : in_ptr(1) + (size_t)(m - TPR) * D);
            const f32x4* xr = (const f32x4*)src_ + lane; f32x4 v[8]; float s = 0.f;
#pragma unroll
            for (int j = 0; j < 8; ++j) { v[j] = xr[64 * j]; s += (v[j].x * v[j].x + v[j].y * v[j].y) + (v[j].z * v[j].z + v[j].w * v[j].w); }
            s = wave_sum(s, lane); if (lane == 0) rstd_[m] = rsqrtf(s * (1.f / D) + EPS);
            u32x2* o8 = (u32x2*)(Xb + (size_t)m * D) + lane;
#pragma unroll
            for (int j = 0; j < 8; ++j) { u32x2 w; w.x = cvt_pk_bf16(v[j].x, v[j].y); w.y = cvt_pk_bf16(v[j].z, v[j].w); o8[64 * j] = w; } }
        for (int i = bx * 512 + tid; i < 4096 * 32; i += G * 512) { const int p = i >> 5, k = i & 31; const float inv = 1.0f / powf(10000.0f, (float)(2 * k) / 64.0f); const float ang = (float)p * inv; float s, c; sincosf(ang, &s, &c); ropec[i] = c; ropes[i] = s; }
        { bf16* Dc = (bf16*)(ws + LO(WS_DC)); const float* g2 = in_ptr(4) + 2 * D;
          for (int i = bx * 512 + tid; i < 4 * 2 * 512 * 512; i += G * 512) { const int k = i & 511, cp = (i >> 9) & 511, part = (i >> 18) & 1, g = i >> 19; const int r = (cp * k) & 511; const float x = (float)r * (2.0f / 512.0f);
              const float v = (part ? sinpif(x) : cospif(x)) * g2[g * 512 + k]; Dc[i] = (bf16)(cvt_pk_bf16(v, 0.f) & 0xffffu); } }
        { bf16* DL = (bf16*)(ws + LO(WS_DL2)); for (int i = bx * 512 + tid; i < 2048 * 2048; i += G * 512) { const int k = i & 2047, lp = i >> 11; const int j = k & 1023; const int r = (lp * j) & 2047; const float x = (float)r * (2.0f / 2048.0f);
              const float v = (k < 1024) ? cospif(x) : -sinpif(x); DL[i] = (bf16)(cvt_pk_bf16(v, 0.f) & 0xffffu); } }
        { bf16* DL = (bf16*)(ws + LO(WS_DL4)); for (int i = bx * 512 + tid; i < 4096 * 4096; i += G * 512) { const int k = i & 4095, lp = i >> 12; const int j = k & 2047; const int r = (lp * j) & 4095; const float x = (float)r * (2.0f / 4096.0f);
              const float v = (k < 2048) ? cospif(x) : -sinpif(x); DL[i] = (bf16)(cvt_pk_bf16(v, 0.f) & 0xffffu); } }
        for (int m = gw; m < 4096; m += NGW) { const float* src = (m < 2048 ? in_ptr(2) + (size_t)m * D : in_ptr(3) + (size_t)(m - 2048) * D);
            const f32x4* xr = (const f32x4*)src + lane; f32x4 v[8]; float s = 0.f;
#pragma unroll
            for (int j = 0; j < 8; ++j) { v[j] = xr[64 * j]; s += (v[j].x * v[j].x + v[j].y * v[j].y) + (v[j].z * v[j].z + v[j].w * v[j].w); }
            s = wave_sum(s, lane); if (lane == 0) mem_rs[m] = rsqrtf(s * (1.f / D) + EPS);
            u32x2* o8 = (u32x2*)(mem_b + (size_t)m * D) + lane;
#pragma unroll
            for (int j = 0; j < 8; ++j) { u32x2 w; w.x = cvt_pk_bf16(v[j].x, v[j].y); w.y = cvt_pk_bf16(v[j].z, v[j].w); o8[64 * j] = w; } }
        { u32x4 z = {0u, 0u, 0u, 0u};
          for (int i = bx * 512 + tid; i < 2 * 192 * 2048 / 8; i += G * 512) { const int j = i / (192 * 2048 / 8), r = i % (192 * 2048 / 8); *(u32x4*)((bf16*)(ws + LO(WS_MLA_WIN)) + (size_t)j * 1280 * 2048 + (size_t)1088 * 2048 + (size_t)r * 8) = z; }
          for (int i = bx * 512 + tid; i < 2 * 16 * 64 * 512 / 8; i += G * 512) { const int j = i / (16 * 64 * 512 / 8), r = i % (16 * 64 * 512 / 8), hh = r / (64 * 512 / 8), q = r % (64 * 512 / 8);
              *(u32x4*)((bf16*)(ws + LO(WS_MLA_WKVB)) + (size_t)j * 5120 * 512 + (size_t)(hh * 320 + 128) * 512 + (size_t)q * 8) = z; } }
        LAS float* scr = (LAS float*)(lds + wave * 16384);
        {
            constexpr int I_WIN = 32 * 34, I_QB = 8 * 96, I_KVB = 8 * 128, I_WO = 32 * 64, I_HIN = 32 * 320, I_MQ = 32 * 16, I_MKV = 32 * 32, I_MO = 8 * 64;
            constexpr int NIT = 2 * I_WIN + 2 * I_QB + 2 * I_KVB + 2 * I_WO + I_HIN + I_WO + I_WO + 4 * I_MQ + 4 * I_MKV + 4 * I_MO;
            for (int it = gw; it < NIT; it += NGW) {
                int r = it;
                if (r < 2 * I_WIN) { const int j = r / I_WIN; transpose_item<0>(in_ptr(5) + (size_t)j * 2048 * 1088, 2048, 1088, (bf16*)(ws + LO(WS_MLA_WIN)) + (size_t)j * 1280 * 2048, in_ptr(4) + (3 * j) * D, scr, r % I_WIN, lane); continue; } r -= 2 * I_WIN;
                if (r < 2 * I_QB) { const int j = r / I_QB; transpose_item<0>(in_ptr(8) + (size_t)j * 512 * 3072, 512, 3072, (bf16*)(ws + LO(WS_MLA_WQB)) + (size_t)j * 3072 * 512, in_ptr(6) + j * 512, scr, r % I_QB, lane); continue; } r -= 2 * I_QB;
                if (r < 2 * I_KVB) { const int j = r / I_KVB; transpose_item<1>(in_ptr(9) + (size_t)j * 512 * 4096, 512, 4096, (bf16*)(ws + LO(WS_MLA_WKVB)) + (size_t)j * 5120 * 512, in_ptr(7) + j * 512, scr, r % I_KVB, lane); continue; } r -= 2 * I_KVB;
                if (r < 2 * I_WO) { const int j = r / I_WO; transpose_item<0>(in_ptr(12) + (size_t)j * 2048 * 2048, 2048, 2048, (bf16*)(ws + LO(WS_MLA_WO)) + (size_t)j * 2048 * 2048, nullptr, scr, r % I_WO, lane); continue; } r -= 2 * I_WO;
                if (r < I_HIN) { transpose_item<0>(in_ptr(13), 2048, 10240, (bf16*)(ws + LO(WS_HG_WIN)), in_ptr(4) + 1 * D, scr, r, lane); continue; } r -= I_HIN;
                if (r < I_WO) { transpose_item<0>(in_ptr(16), 2048, 2048, (bf16*)(ws + LO(WS_HG_WO)), nullptr, scr, r, lane); continue; } r -= I_WO;
                if (r < I_WO) { transpose_item<0>(in_ptr(17), 2048, 2048, (bf16*)(ws + LO(WS_FN_WO)), nullptr, scr, r, lane); continue; } r -= I_WO;
                if (r < 4 * I_MQ) { const int j = r / I_MQ; transpose_item<0>(in_ptr(20) + (size_t)j * 2048 * 512, 2048, 512, (bf16*)(ws + LO(WS_MEM_WQ)) + (size_t)j * 512 * 2048, in_ptr(18) + j * D, scr, r % I_MQ, lane); continue; } r -= 4 * I_MQ;
                if (r < 4 * I_MKV) { const int j = r / I_MKV; transpose_item<0>(in_ptr(21) + (size_t)j * 2048 * 1024, 2048, 1024, (bf16*)(ws + LO(WS_MEM_WKV)) + (size_t)j * 1024 * 2048, in_ptr(19) + j * 2048, scr, r % I_MKV, lane); continue; } r -= 4 * I_MKV;
                { const int j = r / I_MO; transpose_item<0>(in_ptr(24) + (size_t)j * 512 * 2048, 512, 2048, (bf16*)(ws + LO(WS_MEM_WO)) + (size_t)j * 2048 * 512, nullptr, scr, r % I_MO, lane); }
            }
        }
        __syncthreads();
    }
    PH_END

#pragma unroll 1
    for (int layer = 0; layer < 4; ++layer) {
        const int kind = layer % 3, jm = layer / 3;
        PH_BEGIN(1)
        {
            if (layer > 0) reduce_rstd(ssp_, rstd_, bx * 512 + tid, G * 512);
            LAS float* scr = (LAS float*)(lds + wave * 16384);
            constexpr int I_1 = 32 * 256, I_2 = 128 * 64;
            for (int it = gw; it < I_1 + I_2; it += NGW) {
                if (it < I_1) transpose_item<0>(in_ptr(26) + (size_t)layer * D * DFF, D, DFF, w1t, in_ptr(25) + layer * D, scr, it, lane);
                else transpose_item<0>(in_ptr(27) + (size_t)layer * DFF * D, DFF, D, w2t, nullptr, scr, it - I_1, lane);
            }
            __syncthreads();
            if (layer == 0) {
                pg8::TileOrder S; S.init(mem_b, D, ws + WS_MEM_WKV, D, 0, 16, 16, G, bx);
                pg8::EpiBf16<1, 0> E{memkv, 4096, mem_rs, 0, 1.f};
                pg8::gemm_phase(lds, D, D, D, S, E, wave);
            }
        }
        PH_END
        if (layer == 0) {
            PH_BEGIN(2)
            for (int m = gw; m < 4096; m += NGW) { const int ly = lane >> 4, hh = (lane >> 2) & 3, qq = lane & 3;
                bf16* p = memkv + (size_t)m * 4096 + ly * 1024 + hh * 128 + qq * 32; const float* g = in_ptr(23) + ly * 128 + qq * 32;
                u32x4 raw[4]; float x[32]; float s = 0.f;
#pragma unroll
                for (int j = 0; j < 4; ++j) { raw[j] = *(const u32x4*)(p + 8 * j);
#pragma unroll
                    for (int e = 0; e < 4; ++e) { x[8 * j + 2 * e] = bflo(raw[j][e]); x[8 * j + 2 * e + 1] = bfhi(raw[j][e]); } }
#pragma unroll
                for (int e = 0; e < 32; ++e) s += x[e] * x[e];
                s += shx(s, 1, lane); s += shx(s, 2, lane);
                const float r = rsqrtf(s * (1.f / 128.f) + EPS);
#pragma unroll
                for (int j = 0; j < 4; ++j) { u32x4 w;
#pragma unroll
                    for (int e = 0; e < 4; ++e) w[e] = cvt_pk_bf16(x[8 * j + 2 * e] * r * g[8 * j + 2 * e], x[8 * j + 2 * e + 1] * r * g[8 * j + 2 * e + 1]);
                    *(u32x4*)(p + 8 * j) = w; } }
            PH_END
        }

        if (kind == 0) {
            PH_BEGIN(3)
            {   pg8::TileOrder S; S.init(Xb, D, (bf16*)(ws + LO(WS_MLA_WIN)) + (size_t)jm * 1280 * 2048, D, 0, T / 256, 5, G, bx);
                pg8::EpiBf16<1, 0> E{P, 1280, rstd_, 0, 1.f};
                pg8::gemm_phase(lds, D, D, D, S, E, wave); }
            PH_END
            PH_BEGIN(24)
            for (int m = gw; m < T; m += NGW) {
                const u32x4 a = *(const u32x4*)(P + (size_t)m * 1280 + lane * 16), b = *(const u32x4*)(P + (size_t)m * 1280 + lane * 16 + 8); float q2 = 0.f;
#pragma unroll
                for (int e = 0; e < 4; ++e) { const float a0 = bflo(a[e]), a1 = bfhi(a[e]), b0 = bflo(b[e]), b1 = bfhi(b[e]); q2 += (a0 * a0 + a1 * a1) + (b0 * b0 + b1 * b1); }
#pragma unroll
                for (int o = 1; o < 32; o <<= 1) q2 += shx(q2, o, lane);
                const float rs_ = rsqrtf(q2 * (1.f / 512.f) + EPS);
                if (lane == 0) rq[m] = rs_; if (lane == 32) rkv_[m] = rs_; }
            PH_END
#pragma unroll 1
            for (int c = 0; c < 3; ++c) {
                PH_BEGIN(4)
                {   pg8::TileOrder S; S.init(P, 1280, (bf16*)(ws + LO(WS_MLA_WQB)) + (size_t)jm * 3072 * 512, 512, c * 64, 64, 12, G, bx);
                    pg8::EpiBf16<1, 0> E{Qv, 3072, rq, 0, 1.f};
                    pg8::gemm_phase(lds, 512, 1280, 512, S, E, wave); }
                {   pg8::TileOrder S; S.init(P + 512, 1280, (bf16*)(ws + LO(WS_MLA_WKVB)) + (size_t)jm * 5120 * 512, 512, c * 64, 64, 20, G, bx);
                    pg8::EpiBf16<1, 0> E{KVv, 5120, rkv_, 0, 1.f};
                    pg8::gemm_phase(lds, 512, 1280, 512, S, E, wave); }
                PH_END
                PH_BEGIN(5)
                {   const float* gk = in_ptr(11) + jm * 192; const int hh = lane >> 2, qq = lane & 3;
                    for (int m = c * CH + gw; m < (c + 1) * CH; m += NGW) {
                        const int pos = m < TPR ? (m & 2047) : ((m - TPR) & 4095);
                        bf16* kp = KVv + (size_t)m * 5120 + hh * 320; const bf16* pr = P + (size_t)m * 1280 + 1024;
                        u32x4 raw[4]; float x[32], x1[8], x2[8]; float s = 0.f;
#pragma unroll
                        for (int j = 0; j < 4; ++j) { raw[j] = *(const u32x4*)(kp + qq * 32 + 8 * j);
#pragma unroll
                            for (int e = 0; e < 4; ++e) { x[8 * j + 2 * e] = bflo(raw[j][e]); x[8 * j + 2 * e + 1] = bfhi(raw[j][e]); } }
                        { const u32x4 r1 = *(const u32x4*)(pr + qq * 8), r2 = *(const u32x4*)(pr + 32 + qq * 8);
#pragma unroll
                          for (int e = 0; e < 4; ++e) { x1[2 * e] = bflo(r1[e]); x1[2 * e + 1] = bfhi(r1[e]); x2[2 * e] = bflo(r2[e]); x2[2 * e + 1] = bfhi(r2[e]); } }
#pragma unroll
                        for (int e = 0; e < 32; ++e) s += x[e] * x[e];
#pragma unroll
                        for (int e = 0; e < 8; ++e) s += x1[e] * x1[e] + x2[e] * x2[e];
                        s += shx(s, 1, lane); s += shx(s, 2, lane);
                        const float r = rsqrtf(s * (1.f / 192.f) + EPS);
#pragma unroll
                        for (int j = 0; j < 4; ++j) { u32x4 w;
#pragma unroll
                            for (int e = 0; e < 4; ++e) w[e] = cvt_pk_bf16(x[8 * j + 2 * e] * r * gk[qq * 32 + 8 * j + 2 * e], x[8 * j + 2 * e + 1] * r * gk[qq * 32 + 8 * j + 2 * e + 1]);
                            *(u32x4*)(kp + qq * 32 + 8 * j) = w; }
                        float y1[8], y2[8];
#pragma unroll
                        for (int e = 0; e < 8; ++e) { const int i = qq * 8 + e; const float cc = ropec[pos * 32 + i], sn = ropes[pos * 32 + i];
                            const float a = x1[e] * r * gk[128 + i], b = x2[e] * r * gk[160 + i]; y1[e] = a * cc - b * sn; y2[e] = a * sn + b * cc; }
                        u32x4 w1, w2;
#pragma unroll
                        for (int e = 0; e < 4; ++e) { w1[e] = cvt_pk_bf16(y1[2 * e], y1[2 * e + 1]); w2[e] = cvt_pk_bf16(y2[2 * e], y2[2 * e + 1]); }
                        *(u32x4*)(kp + 128 + qq * 8) = w1; *(u32x4*)(kp + 160 + qq * 8) = w2;
                    } }
                PH_END
                PH_BEGIN(6)
                {   const int nqb = (c == 0) ? 8 : 16, nun = 1024;
                    for (int idx = vcu; idx < nun; idx += G) {
                        const int qb = idx % nqb, hh = (idx / nqb) & 15, sl = idx / (nqb * 16); const int s = (c == 0) ? sl : 8 + (c - 1) * 4 + sl;
                        const int row0 = seq_row0(s), L = seq_len(s);
                        att::attn_unit<192, true>(Qv + (size_t)(row0 + qb * 256) * 3072 + hh * 192, 3072, KVv + (size_t)row0 * 5120 + hh * 320, 5120, KVv + (size_t)row0 * 5120 + hh * 320 + 192, 5120,
                                                  H + (size_t)(row0 + qb * 256) * D + hh * 128, D, L, in_ptr(10) + jm * 192, ropec, ropes, qb * 256, 0.07216878364870322f, nullptr, (char*)lds_raw, wave);
                    } }
                PH_END
            }
            PH_BEGIN(7)
            {   pg8::TileOrder S; S.init(H, D, (bf16*)(ws + LO(WS_MLA_WO)) + (size_t)jm * 2048 * 2048, D, 0, T / 256, 8, G, bx);
                pg8::EpiResid<false> E{Xb, ssp_, nullptr};
                pg8::gemm_phase(lds, D, D, D, S, E, wave); }
            PH_END
        } else if (kind == 1) {
#pragma unroll 1
            for (int c = 0; c < 3; ++c) {
                PH_BEGIN(8)
                {   pg8::TileOrder S; S.init(Xb, D, ws + WS_HG_WIN, D, c * 64, 64, 40, G, bx);
                    pg8::EpiBf16<1, 0> E{Zv, 10240, rstd_, 0, 1.f};
                    pg8::gemm_phase(lds, D, D, D, S, E, wave); }
                PH_END
                PH_BEGIN(9)
                {
                    if (c == 0) {
                        for (int it = vcu; it < 256; it += G) { const int dir = it & 1, hh = (it >> 1) & 15, s = it >> 5;
                            hgrn_scan_item<128>(Zv, seq_row0(s), seq_len(s), hh, dir, 0, in_ptr(14), dir ? OBv : OFv, lds, lds_raw, tid, lane, wave); }
                    } else {
                        for (int it = vcu; it < 256; it += G) { const int kh = it & 1, dir = (it >> 1) & 1, hh = (it >> 2) & 15, s = 8 + (c - 1) * 4 + (it >> 6);
                            bf16* Oo = kh ? (dir ? OP3v : OP2v) : (dir ? OBv : OFv);
                            hgrn_scan_item<64>(Zv, seq_row0(s), seq_len(s), hh, dir, kh * 64, in_ptr(14), Oo, lds, lds_raw, tid, lane, wave); }
                    } }
                PH_END
                PH_BEGIN(10)
                {   const float* go = in_ptr(15) + (lane & 3) * 32;
                    for (int m = c * CH + gw; m < (c + 1) * CH; m += NGW) {
                        const bf16* pf = OFv + (size_t)m * D + lane * 32; const bf16* pb = OBv + (size_t)m * D + lane * 32; const bf16* pg = Zv + (size_t)m * 10240 + 8192 + lane * 32;
                        const bf16* p2 = OP2v + (size_t)m * D + lane * 32; const bf16* p3 = OP3v + (size_t)m * D + lane * 32;
                        float x[32]; float s = 0.f;
#pragma unroll
                        for (int j = 0; j < 4; ++j) { const u32x4 a = *(const u32x4*)(pf + 8 * j), b = *(const u32x4*)(pb + 8 * j);
#pragma unroll
                            for (int e = 0; e < 4; ++e) { x[8 * j + 2 * e] = bflo(a[e]) + bflo(b[e]); x[8 * j + 2 * e + 1] = bfhi(a[e]) + bfhi(b[e]); }
                            if (c > 0) { const u32x4 a2 = *(const u32x4*)(p2 + 8 * j), b2 = *(const u32x4*)(p3 + 8 * j);
#pragma unroll
                                for (int e = 0; e < 4; ++e) { x[8 * j + 2 * e] += bflo(a2[e]) + bflo(b2[e]); x[8 * j + 2 * e + 1] += bfhi(a2[e]) + bfhi(b2[e]); } } }
#pragma unroll
                        for (int e = 0; e < 32; ++e) s += x[e] * x[e];
                        s += shx(s, 1, lane); s += shx(s, 2, lane);
                        const float r = rsqrtf(s * (1.f / 128.f) + EPS);
#pragma unroll
                        for (int j = 0; j < 4; ++j) { const u32x4 gr = *(const u32x4*)(pg + 8 * j); u32x4 w;
#pragma unroll
                            for (int e = 0; e < 4; ++e) { const float g0 = bflo(gr[e]), g1 = bfhi(gr[e]); const float s0 = g0 / (1.f + __expf(-g0)), s1 = g1 / (1.f + __expf(-g1));
                                w[e] = cvt_pk_bf16(x[8 * j + 2 * e] * r * go[8 * j + 2 * e] * s0, x[8 * j + 2 * e + 1] * r * go[8 * j + 2 * e + 1] * s1); }
                            *(u32x4*)(H + (size_t)m * D + lane * 32 + 8 * j) = w; } } }
                PH_END
            }
            PH_BEGIN(11)
            {   pg8::TileOrder S; S.init(H, D, ws + WS_HG_WO, D, 0, T / 256, 8, G, bx);
                pg8::EpiResid<false> E{Xb, ssp_, nullptr};
                pg8::gemm_phase(lds, D, D, D, S, E, wave); }
            PH_END
        } else {
            struct F1Order { const char* Dc; const char* HEb; const char* HOb; int G, c, smp;
                __device__ __forceinline__ bool next(int i, pg8::Unit& u) const {
                    const int idx = i * G + c; const int npn = smp ? 8 : 4, per = 16 * npn; if (idx >= 8 * per) return false;
                    const int s = (smp ? 8 : 0) + idx / per, rem = idx % per; const int g = rem / (4 * npn), part = (rem / (2 * npn)) & 1, pn = (rem % (2 * npn)) / 2, pm = rem & 1;
                    const int row0 = seq_row0(s), L = seq_len(s);
                    u.pm = pm; u.pn = pn; u.a = Dc + ((size_t)((g * 2 + part) * 512 + pm * 256) * 512) * 2; u.b = (part ? HOb : HEb) + ((size_t)(row0 / 2 + pn * 256) * D + g * 512) * 2;
                    u.ooff = (long)row0 * D + (long)g * 512 * L + (long)part * (L / 2); u.aoff = 0; u.roff = 0; return true; } };
            struct F2Order { const char* DL; const char* T1b; int G, c, smp, half;
                __device__ __forceinline__ bool next(int i, pg8::Unit& u) const {
                    const int idx = i * G + c; const int L = smp ? 4096 : 2048, npm = L / 512; if (idx >= npm * 64) return false;
                    const int pm = idx / 64, sgp = idx % 64; const int s = (smp ? 8 : 0) + sgp / 8, g = (sgp % 8) / 2, pn = sgp % 2; const int row0 = seq_row0(s);
                    u.pm = pm; u.pn = pn; u.a = DL + ((size_t)pm * 256 * L + half * (L / 2)) * 2; u.b = T1b + ((size_t)row0 * D + (size_t)g * 512 * L + (size_t)pn * 256 * L + half * (L / 2)) * 2;
                    u.aoff = (long)(row0 / 2) * D + (long)g * (L / 2) * 512; u.ooff = half ? (long)row0 * D + g * 512 : u.aoff; u.roff = s * D + g * 512; return true; } };
            PH_BEGIN(22)
            {
                bf16* HE = (bf16*)(ws + LO(S_HE)); bf16* HO = (bf16*)(ws + LO(S_HO)); float* xcm = (float*)(ws + LO(WS_XCMID));
                for (int m = gw; m < T / 2; m += NGW) {
                    const int s = m < 8192 ? m / 1024 : 8 + (m - 8192) / 2048; const int row0 = seq_row0(s), L = seq_len(s), j = m - row0 / 2;
                    const bf16* pa = Xb + (size_t)(row0 + j) * D + lane * 32; const bf16* pb = Xb + (size_t)(row0 + (j ? L - j : 0)) * D + lane * 32;
                    const float ra = rstd_[row0 + j], rb = j ? rstd_[row0 + L - j] : 0.f;
#pragma unroll
                    for (int q = 0; q < 4; ++q) { const u32x4 a = *(const u32x4*)(pa + 8 * q), b = *(const u32x4*)(pb + 8 * q); u32x4 we, wo;
#pragma unroll
                        for (int e = 0; e < 4; ++e) { const float a0 = bflo(a[e]) * ra, a1 = bfhi(a[e]) * ra, b0 = bflo(b[e]) * rb, b1 = bfhi(b[e]) * rb; we[e] = cvt_pk_bf16(a0 + b0, a1 + b1); wo[e] = j ? cvt_pk_bf16(a0 - b0, a1 - b1) : 0u; }
                        *(u32x4*)(HE + (size_t)m * D + lane * 32 + 8 * q) = we; *(u32x4*)(HO + (size_t)m * D + lane * 32 + 8 * q) = wo; } }
                const bf16* Dcc = (const bf16*)(ws + LO(WS_DC));
                for (int t = gw; t < 16 * D; t += NGW) { const int s = t >> 11, col = t & 2047, g = col >> 9, cp = col & 511; const int mid = seq_row0(s) + seq_len(s) / 2;
                    const u32x4 dv = *(const u32x4*)(Dcc + ((size_t)(g * 2) * 512 + cp) * 512 + lane * 8), xv = *(const u32x4*)(Xb + (size_t)mid * D + g * 512 + lane * 8); float a = 0.f;
#pragma unroll
                    for (int e = 0; e < 4; ++e) a += bflo(dv[e]) * bflo(xv[e]) + bfhi(dv[e]) * bfhi(xv[e]);
                    a = wave_sum(a, lane); if (lane == 0) xcm[t] = a * rstd_[mid]; } }
            PH_END
            PH_BEGIN(12)
            {   F1Order S{(const char*)(ws + LO(WS_DC)), (const char*)(ws + LO(S_HE)), (const char*)(ws + LO(S_HO)), G, bx, 1}; pg8::EpiBf16<0, 0> E{T1, 4096, nullptr, 0, 1.f};
                pg8::gemm_phase(lds, 512, 512, D, S, E, wave); }
            {   F1Order S{(const char*)(ws + LO(WS_DC)), (const char*)(ws + LO(S_HE)), (const char*)(ws + LO(S_HO)), G, bx, 0}; pg8::EpiBf16<0, 0> E{T1, 2048, nullptr, 0, 1.f};
                pg8::gemm_phase(lds, 512, 512, D, S, E, wave); }
            PH_END
            PH_BEGIN(13)
            {   F2Order S{(const char*)(ws + LO(WS_DL4)), (const char*)T1, G, bx, 1, 0}; pg8::EpiBf16<0, 0> E{(bf16*)(ws + LO(S_HE)), 512, nullptr, 0, 1.f};
                pg8::gemm_phase(lds, 2048, 4096, 4096, S, E, wave); }
            {   F2Order S{(const char*)(ws + LO(WS_DL2)), (const char*)T1, G, bx, 0, 0}; pg8::EpiBf16<0, 0> E{(bf16*)(ws + LO(S_HE)), 512, nullptr, 0, 1.f};
                pg8::gemm_phase(lds, 1024, 2048, 2048, S, E, wave); }
            PH_END
            PH_BEGIN(23)
            {   F2Order S{(const char*)(ws + LO(WS_DL4)), (const char*)T1, G, bx, 1, 1}; pg8::EpiFnetSym E{H, (const bf16*)(ws + LO(S_HE)), (const float*)(ws + LO(WS_XCMID)), 4096, 6.905339660024878e-4f};
                pg8::gemm_phase(lds, 2048, 4096, 4096, S, E, wave); }
            {   F2Order S{(const char*)(ws + LO(WS_DL2)), (const char*)T1, G, bx, 0, 1}; pg8::EpiFnetSym E{H, (const bf16*)(ws + LO(S_HE)), (const float*)(ws + LO(WS_XCMID)), 2048, 9.765625e-4f};
                pg8::gemm_phase(lds, 1024, 2048, 2048, S, E, wave); }
            {
                const float* xcm = (const float*)(ws + LO(WS_XCMID));
                for (int t = gw; t < 16 * D; t += NGW) { const int s = t >> 11, col = t & 2047, g = col >> 9, cp = col & 511; const int row0 = seq_row0(s), L = seq_len(s);
                    const bf16* tp = T1 + (size_t)row0 * D + (size_t)g * 512 * L + (size_t)cp * L; float a = 0.f;
                    for (int j0 = lane * 8; j0 < L / 2; j0 += 512) { const u32x4 v = *(const u32x4*)(tp + j0);
#pragma unroll
                        for (int e = 0; e < 4; ++e) a += bflo(v[e]) - bfhi(v[e]); }
                    a = wave_sum(a, lane);
                    if (lane == 0) H[(size_t)(row0 + L / 2) * D + col] = (bf16)(cvt_pk_bf16((a + xcm[t]) * (L == 4096 ? 6.905339660024878e-4f : 9.765625e-4f), 0.f) & 0xffffu); } }
            PH_END
            PH_BEGIN(14)
            {   pg8::TileOrder S; S.init(H, D, ws + WS_FN_WO, D, 0, T / 256, 8, G, bx);
                pg8::EpiResid<false> E{Xb, ssp_, nullptr};
                pg8::gemm_phase(lds, D, D, D, S, E, wave); }
            PH_END
        }

        {
            PH_BEGIN(16)
            {   pg8::TileOrder S; S.init(Xb, D, (bf16*)(ws + LO(WS_MEM_WQ)) + (size_t)layer * 512 * 2048, D, 0, T / 256, 2, G, bx);
                pg8::EpiBf16<3, 0> E{Qm, 512, ssp_, 0, 1.f};
                pg8::gemm_phase(lds, D, D, D, S, E, wave); }
            PH_END
            PH_BEGIN(17)
            for (int idx = vcu; idx < 768; idx += G) {
                const int hh = idx & 3, rb = idx >> 2; const int s = rb < 64 ? rb / 8 : 8 + (rb - 64) / 16;
                const bf16* kp = memkv + (size_t)(s * 256) * 4096 + layer * 1024 + hh * 128;
                att::attn_unit<128, false>(Qm + (size_t)rb * 256 * 512 + hh * 128, 512, kp, 4096, kp + 512, 4096, Om + (size_t)rb * 256 * 512 + hh * 128, 512, 256,
                                           in_ptr(22) + layer * 128, nullptr, nullptr, 0, 0.08838834764831845f, nullptr, (char*)lds_raw, wave);
            }
            PH_END
            PH_BEGIN(18)
            {   pg8::TileOrder S; S.init(Om, 512, (bf16*)(ws + LO(WS_MEM_WO)) + (size_t)layer * 2048 * 512, 512, 0, T / 256, 8, G, bx);
                pg8::EpiResid<false> E{Xb, ssp_, nullptr};
                pg8::gemm_phase(lds, 512, 512, 512, S, E, wave); }
            PH_END
        }
        {
            PH_BEGIN(19)
            reduce_rstd(ssp_, rstd_, bx * 512 + tid, G * 512);
            PH_END
#pragma unroll 1
            for (int cc = 0; cc < 4; ++cc) {
                PH_BEGIN(20)
                if (cc > 0) { const int c = cc - 1;
                    pg8::TileOrder S; S.init(Hv, DFF, w2t, DFF, c * 64, 64, 8, G, bx);
                    if (layer == 3) { pg8::EpiResid<true> E{Xb, nullptr, X}; pg8::gemm_phase(lds, DFF, DFF, DFF, S, E, wave); }
                    else { pg8::EpiResid<false> E{Xb, ssp_, nullptr}; pg8::gemm_phase(lds, DFF, DFF, DFF, S, E, wave); } }
                if (cc < 3) { const int c = cc;
                    pg8::TileOrder S; S.init(Xb, D, w1t, D, c * 64, 64, 32, G, bx);
                    pg8::EpiBf16<1, 1> E{Hv, DFF, rstd_, 0, 1.f};
                    pg8::gemm_phase(lds, D, D, D, S, E, wave); }
                PH_END
            }
        }
    }
#undef PH_BEGIN
#undef PH_END
}

extern "C" void kernel_launch(void* const* d_in, const int* in_sizes, int n_in, void* d_out, int out_size, void* d_ws, size_t ws_size, hipStream_t stream) {
    static int grid = 0;
    if (grid == 0) {
        if (n_in != 28 || out_size != T * D || ws_size < WS_END) { fprintf(stderr, "kernel_launch: unexpected shapes (n_in %d out %d ws %zu)\n", n_in, out_size, ws_size); grid = -1; return; }
        int dev = 0, cus = 0, per_cu = 0;
        if (hipGetDevice(&dev) != hipSuccess || hipDeviceGetAttribute(&cus, hipDeviceAttributeMultiprocessorCount, dev) != hipSuccess) { grid = -1; return; }
        if (hipFuncSetAttribute((const void*)fwd, hipFuncAttributeMaxDynamicSharedMemorySize, LDS_BYTES) != hipSuccess) { fprintf(stderr, "kernel_launch: hipFuncSetAttribute failed\n"); grid = -1; return; }
        if (hipOccupancyMaxActiveBlocksPerMultiprocessor(&per_cu, (const void*)fwd, NWAVES * 64, LDS_BYTES) != hipSuccess || per_cu < 1) fprintf(stderr, "kernel_launch: occupancy query says %d\n", per_cu);
        (void)hipGetLastError();
        grid = cus;
    }
    if (grid < 0) return;
    (void)hipMemsetAsync((char*)d_ws + WS_CTL, 0, CTL_BYTES, stream);
    Args a{};
    for (int i = 0; i < 28; ++i) a.in[i] = (const float*)d_in[i];
    a.out = (float*)d_out; a.ws = (unsigned char*)d_ws; a.pad = 0;
#if N_LAUNCH_MODE == 0
    a.ph_lo = 0; a.ph_hi = NPH; a.li = 0;
    hipLaunchKernelGGL(fwd, dim3(grid), dim3(NWAVES * 64), LDS_BYTES, stream, a);
#else
    for (int p = 0; p < NPH; ++p) { a.ph_lo = p; a.ph_hi = p + 1; a.li = 0; hipLaunchKernelGGL(fwd, dim3(grid), dim3(NWAVES * 64), LDS_BYTES, stream, a); }
#endif
    const hipError_t le = hipPeekAtLastError();
    if (le != hipSuccess) fprintf(stderr, "kernel_launch: launch failed: %s\n", hipGetErrorName(le));
}
```

```cpp
#include <hip/hip_runtime.h>
#include <cstdio>
#include <cstdint>

#ifndef PHMASK
#define PHMASK 0xFFFFFFFFFFFFFFFFull
#endif
#ifndef REPMASK
#define REPMASK 0x0ull
#endif
#ifndef N_LAUNCH_MODE
#define N_LAUNCH_MODE 0
#endif

#define LAS __attribute__((address_space(3)))
#define GAS __attribute__((address_space(1)))
typedef unsigned short bf16;
typedef short bf16x8 __attribute__((ext_vector_type(8)));
typedef short s16x4 __attribute__((ext_vector_type(4)));
typedef float f32x4 __attribute__((ext_vector_type(4)));
typedef float f32x2 __attribute__((ext_vector_type(2)));
typedef float f32x16 __attribute__((ext_vector_type(16)));
typedef unsigned u32x4 __attribute__((ext_vector_type(4)));
typedef unsigned u32x2 __attribute__((ext_vector_type(2)));

constexpr int D = 2048, T = 49152, TPR = 16384, CH = 16384, DFF = 8192, NWAVES = 8;
constexpr float EPS = 1e-6f;
__host__ __device__ __forceinline__ int seq_row0(int s) { return s < 8 ? s * 2048 : 16384 + (s - 8) * 4096; }
__host__ __device__ __forceinline__ int seq_len(int s) { return s < 8 ? 2048 : 4096; }

constexpr size_t MiB = 1u << 20;
constexpr size_t WS_CTL = 0, CTL_BYTES = 4 * MiB;
constexpr size_t WS_SS0 = 1 * MiB, WS_RSTD = 2 * MiB;
constexpr size_t WS_ROPE = 4 * MiB;
constexpr size_t WS_MEMRS = 5 * MiB;
constexpr size_t WS_MLA_WIN = 6 * MiB, WS_MLA_WQB = 16 * MiB, WS_MLA_WKVB = 22 * MiB, WS_MLA_WO = 32 * MiB;
constexpr size_t WS_HG_WIN = 48 * MiB, WS_HG_WO = 88 * MiB, WS_FN_WO = 96 * MiB;
constexpr size_t WS_MEM_WQ = 104 * MiB, WS_MEM_WKV = 112 * MiB, WS_MEM_WO = 128 * MiB;
constexpr size_t WS_W1 = 136 * MiB, WS_W2 = 168 * MiB;
constexpr size_t WS_DC = 200 * MiB, WS_DL2 = 204 * MiB, WS_DL4 = 220 * MiB;
constexpr size_t WS_MEMB = 284 * MiB, WS_MEMKV = 300 * MiB;
constexpr size_t WS_H = 332 * MiB;
constexpr size_t WS_S = 524 * MiB;
constexpr size_t WS_SSP = 1036 * MiB;
constexpr size_t WS_END = 1044 * MiB;
constexpr size_t S_P = WS_S, S_QC = WS_S + 120 * MiB, S_KVC = WS_S + 216 * MiB;
constexpr size_t S_Z = WS_S, S_OF = WS_S + 320 * MiB, S_OB = WS_S + 384 * MiB;
constexpr size_t S_HE = WS_S, S_HO = WS_S + 96 * MiB, S_T1 = WS_S + 192 * MiB;
constexpr size_t WS_XCMID = WS_MEMRS + 65536;
constexpr size_t S_QM = WS_S, S_OM = WS_S + 48 * MiB;
constexpr size_t S_HID = WS_S;
constexpr int CW_TMO = 0, CW_BAR = 4096;

typedef __bf16 bf16x2_t __attribute__((ext_vector_type(2)));
__device__ __forceinline__ unsigned cvt_pk_bf16(float lo, float hi) { const f32x2 f = {lo, hi}; const bf16x2_t v = __builtin_convertvector(f, bf16x2_t); return __builtin_bit_cast(unsigned, v); }
__device__ __forceinline__ float bf2f(unsigned short b) { return __uint_as_float(((unsigned)b) << 16); }
__device__ __forceinline__ float bflo(unsigned w) { return __uint_as_float(w << 16); }
__device__ __forceinline__ float bfhi(unsigned w) { return __uint_as_float(w & 0xffff0000u); }
__device__ __forceinline__ float shx(float v, int m, int lane) { return __int_as_float(__builtin_amdgcn_ds_bpermute((lane ^ m) << 2, __float_as_int(v))); }
__device__ __forceinline__ float shl_(float v, int src) { return __int_as_float(__builtin_amdgcn_ds_bpermute(src << 2, __float_as_int(v))); }
__device__ __forceinline__ float wave_sum(float v, int lane) {
#pragma unroll
    for (int o = 1; o < 64; o <<= 1) v += shx(v, o, lane);
    return v;
}
__device__ __forceinline__ int opaque_lane() { unsigned z = 0u; asm volatile("" : "+v"(z)); return (int)__builtin_amdgcn_mbcnt_hi(~0u, __builtin_amdgcn_mbcnt_lo(~0u, z)); }
__device__ __forceinline__ int opaque_tid(int w) { return (w << 6) | opaque_lane(); }
__device__ __forceinline__ const float* in_ptr(int i) {
    const __attribute__((address_space(4))) char* ka = (const __attribute__((address_space(4))) char*)__builtin_amdgcn_kernarg_segment_ptr();
    int off = i * 8; asm volatile("" : "+s"(off));
    const float* p = *(const float* const __attribute__((address_space(4)))*)(ka + off);
    return (const float*)(const __attribute__((address_space(1))) float*)p;
}
__device__ __forceinline__ size_t LO(size_t v) { asm volatile("" : "+s"(v)); return v; }
__device__ __forceinline__ int launder_i(int v) { asm volatile("" : "+s"(v)); return v; }
__device__ __forceinline__ unsigned char* launder_p(unsigned char* p) { unsigned z = 0u; asm volatile("" : "+s"(z)); return p + z; }
#define LDS_WAIT() asm volatile("s_waitcnt lgkmcnt(0)" ::: "memory")
#define VM_WAIT() asm volatile("s_waitcnt vmcnt(0)" ::: "memory")

namespace pg8 {
constexpr int BM = 256, BK = 64, HALF = 128, HTB = HALF * BK * 2, STAGE_BYTES = 8 * HTB, NXCD = 8;
__host__ __device__ __forceinline__ int lds_byte(int r, int c) { const int st = (r >> 4) * 2 + (c >> 5), rr = r & 15, cc = c & 31, ob = rr * 64 + cc * 2; return st * 1024 + (ob ^ (((ob >> 9) & 1) << 5)); }
__host__ __device__ __forceinline__ void stage_rc(int b, int& R, int& C) { const int st = b / 1024, sb = b % 1024, swz = sb ^ (((sb >> 9) & 1) << 5); R = (st >> 1) * 16 + swz / 64; C = (st & 1) * 32 + (swz % 64) / 2; }
__host__ __device__ __forceinline__ int perm32(int rho) { const int n = rho >> 4, i = rho & 15; return 8 * (i >> 2) + 4 * n + (i & 3); }

struct Unit { int pm, pn; const char* a; const char* b; long ooff; long aoff; int roff; };

struct TileOrder {
    const char* A; const char* B; int lda, ldb, nM, nN, nwg, G, c, pm0, WGM;
    __device__ __forceinline__ void init(const void* A_, int lda_, const void* B_, int ldb_, int pm0_, int nM_, int nN_, int G_, int c_, int wgm_ = 4) {
        A = (const char*)A_; B = (const char*)B_; lda = lda_; ldb = ldb_; pm0 = pm0_; nM = nM_; nN = nN_; nwg = nM_ * nN_; G = G_; c = c_; WGM = wgm_; }
    __device__ __forceinline__ bool next(int i, Unit& u) const {
        const long L = (long)i * G + c; if (L >= nwg) return false;
        int wgid = (int)L; { const int q = nwg / NXCD, r = nwg % NXCD, xcd = wgid % NXCD, off = wgid / NXCD; wgid = (xcd < r ? xcd * (q + 1) : r * (q + 1) + (xcd - r) * q) + off; }
        const int nig = WGM * nN, gid = wgid / nig, fm = gid * WGM, gsz = (nM - fm) < WGM ? (nM - fm) : WGM;
        u.pm = pm0 + fm + ((wgid % nig) % gsz); u.pn = (wgid % nig) / gsz;
        u.a = A + (size_t)u.pm * 256 * lda * 2; u.b = B + (size_t)u.pn * 256 * ldb * 2; u.ooff = 0; u.aoff = 0; u.roff = 0; return true;
    }
};

template <int RS  , int ACT  > struct EpiBf16 {
    static constexpr bool PERM = true;
    bf16* O; int ldc; const float* rs; int rsw; float cs;
    __device__ __forceinline__ void pre(const Unit& u, int wr, int fr, float (&pv)[8]) const {
        const int row0 = u.pm * BM + wr * 64 + fr;
#pragma unroll
        for (int i = 0; i < 8; ++i) { const int row = row0 + (i >> 2) * HALF + (i & 3) * 16; pv[i] = RS == 1 ? rs[row] : RS == 2 ? rs[2 * row + rsw] : 0.f; }
    }
    __device__ __forceinline__ void operator()(const f32x4 (&acc)[2][2][4][2], const Unit& u, int wr, int wc, int fr, int fq, const float (&pv)[8]) const {
        const int row0 = u.pm * BM + wr * 64 + fr, col0 = u.pn * BM + wc * 32 + 8 * fq;
#pragma unroll
        for (int ai = 0; ai < 2; ++ai)
#pragma unroll
            for (int m = 0; m < 4; ++m) { const int row = row0 + ai * HALF + m * 16; float s = cs;
                if (RS == 1) s *= pv[ai * 4 + m];
                if (RS == 2) s *= rsqrtf(pv[ai * 4 + m] * (1.0f / 512.0f) + EPS);
                if (RS == 3) { float t = 0.f;
#pragma unroll
                    for (int j = 0; j < 8; ++j) { const float* pp = rs + (size_t)(4 * j) * T + row; t += (pp[0] + pp[T]) + (pp[2 * (size_t)T] + pp[3 * (size_t)T]); }
                    s *= rsqrtf(t * (1.f / D) + EPS); }
                bf16* rowp = O + u.ooff + (size_t)row * ldc + col0;
#pragma unroll
                for (int bj = 0; bj < 2; ++bj) { f32x4 v0 = acc[ai][bj][m][0] * s, v1 = acc[ai][bj][m][1] * s;
                    if (RS == 4) { const f32x4 c0 = *(const f32x4*)(rs + u.roff + col0 + bj * HALF), c1 = *(const f32x4*)(rs + u.roff + col0 + bj * HALF + 4); v0 = v0 * c0; v1 = v1 * c1; }
                    if (RS == 5) { const f32x4 c0 = *(const f32x4*)(rs + u.roff + col0 + bj * HALF), c1 = *(const f32x4*)(rs + u.roff + col0 + bj * HALF + 4); const float sg = (row & 1) ? -s : s; v0 = v0 + c0 * sg; v1 = v1 + c1 * sg; }
                    if (ACT == 1) {
#pragma unroll
                        for (int j = 0; j < 4; ++j) { const float a = fmaxf(v0[j], 0.f), b = fmaxf(v1[j], 0.f); v0[j] = a * a; v1[j] = b * b; } }
                    u32x4 w; w.x = cvt_pk_bf16(v0[0], v0[1]); w.y = cvt_pk_bf16(v0[2], v0[3]); w.z = cvt_pk_bf16(v1[0], v1[1]); w.w = cvt_pk_bf16(v1[2], v1[3]);
                    *(u32x4*)(rowp + bj * HALF) = w; } }
    }
};
template <bool FINAL> struct EpiResid {
    static constexpr bool PERM = true;
    bf16* Xb; float* ssp; float* out;
    __device__ __forceinline__ void pre(const Unit&, int, int, float (&)[8]) const {}
    __device__ __forceinline__ void operator()(const f32x4 (&acc)[2][2][4][2], const Unit& u, int wr, int wc, int fr, int fq, const float (&)[8]) const {
        const int row0 = u.pm * BM + wr * 64 + fr, col0 = u.pn * BM + wc * 32 + 8 * fq, lane_ = fq * 16 + fr;
        u32x4 o[2][4][2];
#pragma unroll
        for (int ai = 0; ai < 2; ++ai)
#pragma unroll
            for (int m = 0; m < 4; ++m)
#pragma unroll
                for (int bj = 0; bj < 2; ++bj) o[ai][m][bj] = *(const u32x4*)(Xb + (size_t)(row0 + ai * HALF + m * 16) * D + col0 + bj * HALF);
#pragma unroll
        for (int ai = 0; ai < 2; ++ai) { float qv[4] = {0.f, 0.f, 0.f, 0.f};
#pragma unroll
            for (int m = 0; m < 4; ++m) { const int row = row0 + ai * HALF + m * 16; bf16* xp = Xb + (size_t)row * D + col0; float q = 0.f;
#pragma unroll
                for (int bj = 0; bj < 2; ++bj) { const u32x4 ov = o[ai][m][bj];
                    f32x4 v0 = acc[ai][bj][m][0], v1 = acc[ai][bj][m][1];
                    v0[0] += bflo(ov[0]); v0[1] += bfhi(ov[0]); v0[2] += bflo(ov[1]); v0[3] += bfhi(ov[1]); v1[0] += bflo(ov[2]); v1[1] += bfhi(ov[2]); v1[2] += bflo(ov[3]); v1[3] += bfhi(ov[3]);
                    if (FINAL) { float* op = out + (size_t)row * D + col0 + bj * HALF; *(f32x4*)op = v0; *(f32x4*)(op + 4) = v1; }
                    else { u32x4 w; w.x = cvt_pk_bf16(v0[0], v0[1]); w.y = cvt_pk_bf16(v0[2], v0[3]); w.z = cvt_pk_bf16(v1[0], v1[1]); w.w = cvt_pk_bf16(v1[2], v1[3]);
                        *(u32x4*)(xp + bj * HALF) = w;
#pragma unroll
                        for (int j = 0; j < 4; ++j) { const float a = bflo(w[j]), b = bfhi(w[j]); q += a * a + b * b; } } }
                if (!FINAL) { q += shx(q, 16, lane_); q += shx(q, 32, lane_); qv[m] = q; } }
            if (!FINAL) { const float v = fq == 0 ? qv[0] : fq == 1 ? qv[1] : fq == 2 ? qv[2] : qv[3];
                ssp[(size_t)(u.pn * 4 + wc) * T + u.pm * BM + ai * HALF + wr * 64 + lane_] = v; }
            asm volatile("" ::: "memory"); }
    }
};

struct EpiFnetSym {
    static constexpr bool PERM = true;
    bf16* Y; const bf16* Ab; const float* xcm; int L; float cs;
    __device__ __forceinline__ void pre(const Unit&, int, int, float (&)[8]) const {}
    __device__ __forceinline__ void operator()(const f32x4 (&acc)[2][2][4][2], const Unit& u, int wr, int wc, int fr, int fq, const float (&)[8]) const {
        const int row0 = u.pm * BM + wr * 64 + fr, col0 = u.pn * BM + wc * 32 + 8 * fq;
        f32x4 b0[2], b1[2];
#pragma unroll
        for (int bj = 0; bj < 2; ++bj) { b0[bj] = *(const f32x4*)(xcm + u.roff + col0 + bj * HALF); b1[bj] = *(const f32x4*)(xcm + u.roff + col0 + bj * HALF + 4); }
#pragma unroll
        for (int ai = 0; ai < 2; ++ai)
#pragma unroll
            for (int m = 0; m < 4; ++m) { const int row = row0 + ai * HALF + m * 16; const float sg = (row & 1) ? -1.f : 1.f;
                const bf16* ap = Ab + u.aoff + (size_t)row * 512 + col0;
                bf16* y1 = Y + u.ooff + (size_t)row * D + col0; bf16* y2 = Y + u.ooff + (size_t)(L - row) * D + col0;
#pragma unroll
                for (int bj = 0; bj < 2; ++bj) { const u32x4 a = *(const u32x4*)(ap + bj * HALF);
                    f32x4 a0 = {bflo(a[0]), bfhi(a[0]), bflo(a[1]), bfhi(a[1])}, a1 = {bflo(a[2]), bfhi(a[2]), bflo(a[3]), bfhi(a[3])};
                    a0 = a0 + b0[bj] * sg; a1 = a1 + b1[bj] * sg;
                    const f32x4 p0 = (a0 + acc[ai][bj][m][0]) * cs, p1 = (a1 + acc[ai][bj][m][1]) * cs, q0 = (a0 - acc[ai][bj][m][0]) * cs, q1 = (a1 - acc[ai][bj][m][1]) * cs;
                    u32x4 w; w.x = cvt_pk_bf16(p0[0], p0[1]); w.y = cvt_pk_bf16(p0[2], p0[3]); w.z = cvt_pk_bf16(p1[0], p1[1]); w.w = cvt_pk_bf16(p1[2], p1[3]);
                    *(u32x4*)(y1 + bj * HALF) = w;
                    if (row > 0) { u32x4 v; v.x = cvt_pk_bf16(q0[0], q0[1]); v.y = cvt_pk_bf16(q0[2], q0[3]); v.z = cvt_pk_bf16(q1[0], q1[1]); v.w = cvt_pk_bf16(q1[2], q1[3]);
                        *(u32x4*)(y2 + bj * HALF) = v; } } }
    }
};

template <class Epi, class Sched>
__device__ __forceinline__ void gemm_phase(LAS unsigned char* lds, const int K, const int lda, const int ldb, const Sched& S, const Epi& E, const int widS) {
    const int tid = opaque_tid(widS), wid = __builtin_amdgcn_readfirstlane(tid >> 6), lane = tid & 63, wr = wid >> 2, wc = wid & 3, fr = lane & 15, fq = lane >> 4;
    const int nt = K / BK;
    unsigned voffA[2], voffB[2];
#pragma unroll
    for (int i = 0; i < 2; ++i) { int R, C; stage_rc(tid * 16 + i * 8192, R, C); const int Rb = Epi::PERM ? ((R & ~31) + perm32(R & 31)) : R;
        voffA[i] = (unsigned)(R * lda + C) * 2u; voffB[i] = (unsigned)(Rb * ldb + C) * 2u; }
    const size_t kstep = (size_t)(BK * 2);
    const size_t hstepA = (size_t)HALF * lda * 2, hstepB = (size_t)HALF * ldb * 2;
    const unsigned ldsw = (unsigned)wid * 1024u;
    const int aoff = lds_byte(wr * 64 + fr, fq * 8), boff = lds_byte(wc * 32 + fr, fq * 8);
#define PG8_SA(b, h) (((b) * 2 + (h)) * HTB)
#define PG8_SB(b, h) ((4 + (b) * 2 + (h)) * HTB)
#define PG8_STAGE(bufoff, gbase, voff) do { _Pragma("unroll") for (int _i = 0; _i < 2; ++_i) \
        __builtin_amdgcn_global_load_lds((const unsigned*)((const char*)(gbase) + (voff)[_i]), (LAS unsigned*)(lds + (bufoff) + ldsw + _i * 8192), 16, 0, 0); } while (0)
#define PG8_LDA(dst, b, h) do { _Pragma("unroll") for (int m = 0; m < 4; ++m) _Pragma("unroll") for (int k = 0; k < 2; ++k) dst[m][k] = *(const LAS bf16x8*)(lds + PG8_SA(b, h) + aoff + m * 2048 + k * 1024); } while (0)
#define PG8_LDB(dst, b, h) do { _Pragma("unroll") for (int n = 0; n < 2; ++n) _Pragma("unroll") for (int k = 0; k < 2; ++k) dst[n][k] = *(const LAS bf16x8*)(lds + PG8_SB(b, h) + boff + n * 2048 + k * 1024); } while (0)
#define PG8_MMA(ai, bj, At, Bt) do { __builtin_amdgcn_s_setprio(1); _Pragma("unroll") for (int m = 0; m < 4; ++m) _Pragma("unroll") for (int n = 0; n < 2; ++n) _Pragma("unroll") for (int k = 0; k < 2; ++k) \
        acc[ai][bj][m][n] = __builtin_amdgcn_mfma_f32_16x16x32_bf16(Bt[n][k], At[m][k], acc[ai][bj][m][n], 0, 0, 0); __builtin_amdgcn_s_setprio(0); } while (0)
#define PG8_WAIT_V(n) asm volatile("s_waitcnt vmcnt(" #n ")" ::: "memory")
#define PG8_WAIT_L(n) asm volatile("s_waitcnt lgkmcnt(" #n ")" ::: "memory")
#define PG8_BAR __builtin_amdgcn_s_barrier()
#define PG8_SCHED __builtin_amdgcn_sched_barrier(0)
    Unit cur, nxt; int ui = 0;
    if (!S.next(0, cur)) return;
    f32x4 acc[2][2][4][2];
#pragma unroll
    for (int a = 0; a < 2; ++a)
#pragma unroll
        for (int b = 0; b < 2; ++b)
#pragma unroll
            for (int m = 0; m < 4; ++m)
#pragma unroll
                for (int n = 0; n < 2; ++n) acc[a][b][m][n] = (f32x4){0.f, 0.f, 0.f, 0.f};
    bf16x8 At[4][2], B0[2][2], B1[2][2];
    const char* cA = cur.a; const char* cB = cur.b;
    float pv[8]; E.pre(cur, wr, fr, pv);
    PG8_STAGE(PG8_SB(0, 0), cB, voffB); PG8_STAGE(PG8_SB(0, 1), cB + hstepB, voffB); PG8_STAGE(PG8_SA(0, 0), cA, voffA); PG8_STAGE(PG8_SA(0, 1), cA + hstepA, voffA);
    PG8_STAGE(PG8_SB(1, 0), cB + kstep, voffB); PG8_STAGE(PG8_SA(1, 0), cA + kstep, voffA); PG8_STAGE(PG8_SB(1, 1), cB + hstepB + kstep, voffB);
    if (wr == 1) PG8_BAR;
    PG8_WAIT_V(8); PG8_BAR;
    PG8_WAIT_V(6); PG8_BAR;
    for (;;) {
        const bool has_next = S.next(ui + 1, nxt);
        const char* nA = has_next ? nxt.a : cA; const char* nB = has_next ? nxt.b : cB;
#define PG8_WAIT_V8R(flag) asm volatile("s_waitcnt vmcnt(24)\n\ts_cmp_eq_u32 %0, 0\n\ts_cbranch_scc0 .Lpg8r_%=\n\ts_waitcnt vmcnt(8)\n.Lpg8r_%=:" :: "s"(flag) : "memory", "scc")
        for (int t = 0; t < nt; t += 2) {
            const bool last = (t == nt - 2);
            const int relax = __builtin_amdgcn_readfirstlane((int)(t == 0) & (int)(ui > 0));
            const char* a1 = cA + (size_t)(t + 1) * kstep;
            const char* a2 = last ? nA : cA + (size_t)(t + 2) * kstep; const char* b2 = last ? nB : cB + (size_t)(t + 2) * kstep;
            const char* a3 = a2 + kstep; const char* b3 = b2 + kstep;
            PG8_LDB(B0, 0, 0); PG8_LDB(B1, 0, 1); PG8_SCHED; PG8_LDA(At, 0, 0); PG8_STAGE(PG8_SA(1, 1), a1 + hstepA, voffA);
            PG8_WAIT_V8R(relax); PG8_WAIT_L(0); PG8_BAR; PG8_MMA(0, 0, At, B0); PG8_MMA(0, 1, At, B1); PG8_BAR; PG8_SCHED;
            PG8_LDA(At, 0, 1); PG8_STAGE(PG8_SB(0, 0), b2, voffB); PG8_STAGE(PG8_SB(0, 1), b2 + hstepB, voffB); PG8_STAGE(PG8_SA(0, 0), a2, voffA);
            PG8_WAIT_V8R(relax); PG8_WAIT_L(0); PG8_BAR; PG8_MMA(1, 0, At, B0); PG8_MMA(1, 1, At, B1); PG8_BAR; PG8_SCHED;
            PG8_LDB(B0, 1, 0); PG8_LDB(B1, 1, 1); PG8_SCHED; PG8_LDA(At, 1, 0); PG8_STAGE(PG8_SA(0, 1), a2 + hstepA, voffA);
            PG8_WAIT_V(8); PG8_WAIT_L(0); PG8_BAR; PG8_MMA(0, 0, At, B0); PG8_MMA(0, 1, At, B1); PG8_BAR; PG8_SCHED;
            PG8_LDA(At, 1, 1); PG8_STAGE(PG8_SB(1, 0), b3, voffB); PG8_STAGE(PG8_SB(1, 1), b3 + hstepB, voffB); PG8_STAGE(PG8_SA(1, 0), a3, voffA);
            PG8_WAIT_V(8); PG8_WAIT_L(0); PG8_BAR; PG8_MMA(1, 0, At, B0); PG8_MMA(1, 1, At, B1); PG8_BAR; PG8_SCHED;
        }
#undef PG8_WAIT_V8R
        if (wr == 0) PG8_BAR;
        E(acc, cur, wr, wc, fr, fq, pv);
        if (!has_next) break;
#pragma unroll
        for (int a = 0; a < 2; ++a)
#pragma unroll
            for (int b = 0; b < 2; ++b)
#pragma unroll
                for (int m = 0; m < 4; ++m)
#pragma unroll
                    for (int n = 0; n < 2; ++n) acc[a][b][m][n] = (f32x4){0.f, 0.f, 0.f, 0.f};
        cur = nxt; cA = nA; cB = nB; ++ui;
        E.pre(cur, wr, fr, pv);
        if (wr == 1) PG8_BAR;
    }
    PG8_WAIT_V(0);
    PG8_BAR;
#undef PG8_SA
#undef PG8_SB
#undef PG8_STAGE
#undef PG8_LDA
#undef PG8_LDB
#undef PG8_MMA
#undef PG8_WAIT_V
#undef PG8_WAIT_L
#undef PG8_BAR
#undef PG8_SCHED
}
}

namespace att {
constexpr int NW = 8, QBLK = 32, KVBLK = 64, DV = 128;
constexpr int SHM_V = KVBLK * DV * 2;
template <int DQK> struct Geo { static constexpr int KROW = DQK * 2, SHM_K = KVBLK * KROW, NQ = DQK / 16, CPR = DQK / 8  , NKI = SHM_K / 8192  ; };
template <int DQK> __device__ __forceinline__ int kswz(int row) { return DQK == 192 ? ((row >> 1) & 7) : (row & 15); }
#define SBAR() __builtin_amdgcn_sched_barrier(0)
__device__ __forceinline__ int crow(int r, int hi) { return (r & 3) + 8 * (r >> 2) + 4 * hi; }
template <bool FIRST>
__device__ __forceinline__ void partialSM(f32x16& p0, f32x16& p1, f32x16& negm, float& alpha, float& l_reg) {
    constexpr float THR2 = 8.f * 1.4426950408889634f;
    float pmax = p0[0];
#pragma unroll
    for (int r = 1; r < 16; ++r) pmax = fmaxf(pmax, p0[r]);
#pragma unroll
    for (int r = 0; r < 16; ++r) pmax = fmaxf(pmax, p1[r]);
    { auto rr = __builtin_amdgcn_permlane32_swap(__float_as_uint(pmax), __float_as_uint(pmax), false, false);
      pmax = fmaxf(__uint_as_float(rr[0]), __uint_as_float(rr[1])); }
    if (!FIRST && __builtin_expect(__all(pmax <= THR2), 1)) { alpha = 1.f; }
    else { const float d = FIRST ? pmax : fmaxf(pmax, 0.f); alpha = FIRST ? 1.f : __builtin_amdgcn_exp2f(-d); if (!FIRST) l_reg *= alpha;
#pragma unroll
        for (int r = 0; r < 16; ++r) { p0[r] -= d; p1[r] -= d; negm[r] -= d; } }
#pragma unroll
    for (int r = 0; r < 16; ++r) p0[r] = __builtin_amdgcn_exp2f(p0[r]);
}
__device__ __forceinline__ void finishSM(f32x16& p0, f32x16& p1, float& l_reg, bf16x8& pa0, bf16x8& pa1, bf16x8& pa2, bf16x8& pa3) {
#pragma unroll
    for (int r = 0; r < 16; ++r) p1[r] = __builtin_amdgcn_exp2f(p1[r]);
    float ps = 0;
#pragma unroll
    for (int r = 0; r < 16; ++r) ps += p0[r];
#pragma unroll
    for (int r = 0; r < 16; ++r) ps += p1[r];
    { auto rr = __builtin_amdgcn_permlane32_swap(__float_as_uint(ps), __float_as_uint(ps), false, false);
      ps = __uint_as_float(rr[0]) + __uint_as_float(rr[1]); }
    l_reg += ps;
#define PK4(P, BASE, OUT) do { u32x4 w; w[0] = cvt_pk_bf16(P[BASE + 0], P[BASE + 1]); w[1] = cvt_pk_bf16(P[BASE + 2], P[BASE + 3]);   \
    w[2] = cvt_pk_bf16(P[BASE + 4], P[BASE + 5]); w[3] = cvt_pk_bf16(P[BASE + 6], P[BASE + 7]);     \
    { auto r0 = __builtin_amdgcn_permlane32_swap(w[0], w[2], false, false); w[0] = r0[0]; w[2] = r0[1]; } \
    { auto r1 = __builtin_amdgcn_permlane32_swap(w[1], w[3], false, false); w[1] = r1[0]; w[3] = r1[1]; } \
    OUT = *reinterpret_cast<bf16x8*>(&w); } while (0)
    PK4(p0, 0, pa0); PK4(p0, 8, pa1); PK4(p1, 0, pa2); PK4(p1, 8, pa3);
#undef PK4
}
template <int DQK> struct KAddr { static constexpr int KB = DQK == 192 ? 4 : 8; };
template <int DQK>
__device__ __forceinline__ void qkt(f32x16& p0, f32x16& p1, const char* Kt  , const int kx  , const bf16x8* qr, const f32x16& negm) {
    constexpr int NQ = Geo<DQK>::NQ, RB = 32 * Geo<DQK>::KROW, KB = KAddr<DQK>::KB;
#define KOFF(d0) (((32 * ((d0) % KB)) ^ kx) + ((d0) / KB) * 32 * KB)
    const char* Ksl = Kt;
    bf16x8 f0[2], f1[2];
    f0[0] = *reinterpret_cast<const bf16x8*>(Ksl + KOFF(0)); f1[0] = *reinterpret_cast<const bf16x8*>(Ksl + KOFF(0) + RB);
    __builtin_amdgcn_sched_group_barrier(0x100, 2, 0);
#pragma unroll
    for (int d0 = 0; d0 < NQ; ++d0) {
        if (d0 + 1 < NQ) { f0[(d0 + 1) & 1] = *reinterpret_cast<const bf16x8*>(Ksl + KOFF(d0 + 1)); f1[(d0 + 1) & 1] = *reinterpret_cast<const bf16x8*>(Ksl + KOFF(d0 + 1) + RB); }
        if (d0 == 0) {
            asm("v_mfma_f32_32x32x16_bf16 %0, %1, %2, %3" : "=&v"(p0) : "v"(f0[0]), "v"(qr[0]), "v"(negm));
            asm("v_mfma_f32_32x32x16_bf16 %0, %1, %2, %3" : "=&v"(p1) : "v"(f1[0]), "v"(qr[0]), "v"(negm));
        } else {
            p0 = __builtin_amdgcn_mfma_f32_32x32x16_bf16(f0[d0 & 1], qr[d0], p0, 0, 0, 0);
            p1 = __builtin_amdgcn_mfma_f32_32x32x16_bf16(f1[d0 & 1], qr[d0], p1, 0, 0, 0); }
        __builtin_amdgcn_sched_group_barrier(0x100, 2, 0); __builtin_amdgcn_sched_group_barrier(0x8, 2, 0); }
#undef KOFF
}
__device__ __forceinline__ int v_st(int k, int c) { const int kk = (k & ~0xC) | ((k & 4) << 1) | ((k & 8) >> 1); return ((kk >> 3) * 4 + (c >> 5)) * 512 + ((kk & 7) * 32 + (c & 31)) * 2; }
__device__ __forceinline__ int v_rd_base(int lane) { return ((lane & 3) << 3) | (((lane >> 2) & 3) << 6) | (((lane >> 4) & 1) << 5) | (((lane >> 5) & 1) << 8); }
constexpr int v_rd_off(int d0, int ks, int half) { return d0 * 512 + ks * 4096 + half * 2048; }
template <int OFF> __device__ __forceinline__ s16x4 tr_read(int vb) {
    s16x4 r; asm volatile("ds_read_b64_tr_b16 %0, %1 offset:%2" : "=&v"(r) : "v"(vb), "i"(OFF) : "memory"); return r;
}
template <int D0> __device__ __forceinline__ void pv_one(f32x16& od, int vb, bf16x8 pa0, bf16x8 pa1, bf16x8 pa2, bf16x8 pa3) {
    const s16x4 l0 = tr_read<v_rd_off(D0, 0, 0)>(vb), h0 = tr_read<v_rd_off(D0, 0, 1)>(vb), l1 = tr_read<v_rd_off(D0, 1, 0)>(vb), h1 = tr_read<v_rd_off(D0, 1, 1)>(vb);
    const s16x4 l2 = tr_read<v_rd_off(D0, 2, 0)>(vb), h2 = tr_read<v_rd_off(D0, 2, 1)>(vb), l3 = tr_read<v_rd_off(D0, 3, 0)>(vb), h3 = tr_read<v_rd_off(D0, 3, 1)>(vb);
    asm volatile("s_waitcnt lgkmcnt(0)" ::: "memory"); SBAR();
#define PK(L, H) (bf16x8){L[0], L[1], L[2], L[3], H[0], H[1], H[2], H[3]}
    od = __builtin_amdgcn_mfma_f32_32x32x16_bf16(pa0, PK(l0, h0), od, 0, 0, 0);
    od = __builtin_amdgcn_mfma_f32_32x32x16_bf16(pa1, PK(l1, h1), od, 0, 0, 0);
    od = __builtin_amdgcn_mfma_f32_32x32x16_bf16(pa2, PK(l2, h2), od, 0, 0, 0);
    od = __builtin_amdgcn_mfma_f32_32x32x16_bf16(pa3, PK(l3, h3), od, 0, 0, 0);
#undef PK
}
__device__ __forceinline__ void pv_d0(f32x16* o, int vb, bf16x8 pa0, bf16x8 pa1, bf16x8 pa2, bf16x8 pa3) {
    pv_one<0>(o[0], vb, pa0, pa1, pa2, pa3); pv_one<1>(o[1], vb, pa0, pa1, pa2, pa3); pv_one<2>(o[2], vb, pa0, pa1, pa2, pa3); pv_one<3>(o[3], vb, pa0, pa1, pa2, pa3);
}

template <int DQK, bool ROPE>
__device__ __forceinline__ void attn_unit(const bf16* __restrict__ Qb, int ldq, const bf16* __restrict__ Kh, int ldk, const bf16* __restrict__ Vh, int ldv,
                                          bf16* __restrict__ Ob, int ldo, int nkeys, const float* __restrict__ qg, const float* __restrict__ ropec, const float* __restrict__ ropes,
                                          int pos0, const float sm_scale, const float* __restrict__ qrs, char* lds, const int widS) {
    using G = Geo<DQK>; constexpr int NQ = G::NQ;
    const int tid = opaque_tid(widS), wid = __builtin_amdgcn_readfirstlane(tid >> 6), lane = tid & 63, r32 = lane & 31, hi = lane >> 5;
    char* V_lds = lds; char* K_lds = lds + 3 * SHM_V;
    float* wsp = (float*)(lds + 3 * SHM_V + 2 * G::SHM_K) + wid * 64; float* li_l = wsp; float* al_l = wsp + 32;
    const float C = sm_scale * 1.4426950408889634f;
    float l_reg = 0; f32x16 o[4] = {}; f32x16 negm = {}; bf16x8 qr[NQ];
    {
        const bf16* Qw = Qb + (long)(wid * QBLK + r32) * ldq + hi * 8;
        u32x4 raw[NQ]; float ssq = 0.f;
#pragma unroll
        for (int d0 = 0; d0 < NQ; ++d0) { raw[d0] = *reinterpret_cast<const u32x4*>(Qw + d0 * 16);
#pragma unroll
            for (int j = 0; j < 4; ++j) { const float a = bflo(raw[d0][j]), b = bfhi(raw[d0][j]); ssq += a * a + b * b; } }
        ssq += shx(ssq, 32, lane);
        const float qs_ = qrs ? qrs[wid * QBLK + r32] : 1.f;
        const float rstd = C * qs_ * rsqrtf(qs_ * qs_ * ssq * (1.0f / DQK) + EPS);
        constexpr int NPLAIN = ROPE ? 8 : NQ;
#pragma unroll
        for (int d0 = 0; d0 < NPLAIN; ++d0) { const f32x4 g0 = *reinterpret_cast<const f32x4*>(qg + d0 * 16 + hi * 8), g1 = *reinterpret_cast<const f32x4*>(qg + d0 * 16 + hi * 8 + 4);
            u32x4 w;
#pragma unroll
            for (int j = 0; j < 4; ++j) { const float gl = j < 2 ? g0[2 * j] : g1[2 * j - 4], gh = j < 2 ? g0[2 * j + 1] : g1[2 * j - 3]; w[j] = cvt_pk_bf16(bflo(raw[d0][j]) * rstd * gl, bfhi(raw[d0][j]) * rstd * gh); }
            qr[d0] = *reinterpret_cast<bf16x8*>(&w); }
        if constexpr (ROPE) {
            const long pos = pos0 + wid * QBLK + r32;
#pragma unroll
            for (int dd = 0; dd < 2; ++dd) { const int d0 = 8 + dd, i0 = dd * 16 + hi * 8;
                float cs[8], sn[8], ga[8], gb[8];
                { const f32x4 c0 = *reinterpret_cast<const f32x4*>(ropec + pos * 32 + i0), c1 = *reinterpret_cast<const f32x4*>(ropec + pos * 32 + i0 + 4);
                  const f32x4 s0 = *reinterpret_cast<const f32x4*>(ropes + pos * 32 + i0), s1 = *reinterpret_cast<const f32x4*>(ropes + pos * 32 + i0 + 4);
                  const f32x4 a0 = *reinterpret_cast<const f32x4*>(qg + d0 * 16 + hi * 8), a1 = *reinterpret_cast<const f32x4*>(qg + d0 * 16 + hi * 8 + 4);
                  const f32x4 b0 = *reinterpret_cast<const f32x4*>(qg + (d0 + 2) * 16 + hi * 8), b1 = *reinterpret_cast<const f32x4*>(qg + (d0 + 2) * 16 + hi * 8 + 4);
#pragma unroll
                  for (int j = 0; j < 4; ++j) { cs[j] = c0[j]; cs[4 + j] = c1[j]; sn[j] = s0[j]; sn[4 + j] = s1[j]; ga[j] = a0[j]; ga[4 + j] = a1[j]; gb[j] = b0[j]; gb[4 + j] = b1[j]; } }
                u32x4 w1, w2;
#pragma unroll
                for (int j = 0; j < 4; ++j) {
                    const float x1l = bflo(raw[d0][j]) * rstd * ga[2 * j], x1h = bfhi(raw[d0][j]) * rstd * ga[2 * j + 1];
                    const float x2l = bflo(raw[d0 + 2][j]) * rstd * gb[2 * j], x2h = bfhi(raw[d0 + 2][j]) * rstd * gb[2 * j + 1];
                    w1[j] = cvt_pk_bf16(x1l * cs[2 * j] - x2l * sn[2 * j], x1h * cs[2 * j + 1] - x2h * sn[2 * j + 1]);
                    w2[j] = cvt_pk_bf16(x1l * sn[2 * j] + x2l * cs[2 * j], x1h * sn[2 * j + 1] + x2h * cs[2 * j + 1]); }
                qr[d0] = *reinterpret_cast<bf16x8*>(&w1); qr[d0 + 2] = *reinterpret_cast<bf16x8*>(&w2); }
        }
    }
    const int vb0 = (int)(uintptr_t)V_lds + v_rd_base(lane);
    unsigned kgo[G::NKI], vgo[1];
#pragma unroll
    for (int t = 0; t < G::NKI; ++t) { const int q = (wid * G::NKI + t) * 64 + lane, row = q / G::CPR, pc = q % G::CPR; kgo[t] = (unsigned)(row * ldk * 2 + ((pc ^ kswz<DQK>(row)) * 16)); }
#pragma unroll
    for (int t = 0; t < 1; ++t) { const int q = (wid * 2 + t) * 64 + lane, sub = q >> 5, within = q & 31;   const int kk = ((sub >> 2) << 3) | (within >> 2), cc = (sub & 3) * 32 + (within & 3) * 8;
        const int key = (kk & ~0xC) | ((kk & 4) << 1) | ((kk & 8) >> 1); vgo[t] = (unsigned)(key * ldv * 2 + cc * 2); }
    const int koffs = r32 * G::KROW + (hi ^ kswz<DQK>(r32)) * 16;
    const char* Kg = (const char*)Kh; const char* Vg = (const char*)Vh;
#define SDMA(tile, kslot, vslot) do { const char* kb_ = Kg + (size_t)(tile) * KVBLK * ldk * 2; const char* vb_ = Vg + (size_t)(tile) * KVBLK * ldv * 2; \
    asm volatile("" : "+s"(kb_), "+s"(vb_));     \
    _Pragma("unroll") for (int t_ = 0; t_ < G::NKI; ++t_) { unsigned ko_ = kgo[t_]; asm volatile("" : "+v"(ko_)); __builtin_amdgcn_global_load_lds((const unsigned*)(kb_ + ko_), (LAS unsigned*)(K_lds + (kslot) * G::SHM_K + (wid * G::NKI + t_) * 1024), 16, 0, 0); } \
    _Pragma("unroll") for (int t_ = 0; t_ < 2; ++t_) { unsigned vo_ = vgo[0] + t_ * 128; asm volatile("" : "+v"(vo_)); __builtin_amdgcn_global_load_lds((const unsigned*)(vb_ + vo_), (LAS unsigned*)(V_lds + (vslot) * SHM_V + (wid * 2 + t_) * 1024), 16, 0, 0); } } while (0)
#define RESC(a) do { if (__any((a) < 1.f)) { if (hi == 0) al_l[r32] = (a); asm volatile("s_waitcnt lgkmcnt(0)" ::: "memory"); \
    _Pragma("unroll") for (int d = 0; d < 4; ++d) _Pragma("unroll") for (int r = 0; r < 16; ++r) o[d][r] *= al_l[crow(r, hi)]; } } while (0)
    f32x16 pA0, pA1, pB0, pB1; bf16x8 pa0, pa1, pa2, pa3; const int NT = nkeys / KVBLK;
    const char* Ksl = K_lds;
    SDMA(0, 0, 0); __syncthreads();
    SDMA(1, 1, 1);
    qkt<DQK>(pA0, pA1, Ksl, koffs, qr, negm); { float al0; partialSM<true>(pA0, pA1, negm, al0, l_reg); }
    __syncthreads();
    int vs = 0;
    for (int j = 1; j + 1 < NT; j += 2) {
        const int v1 = vs == 2 ? 0 : vs + 1, v2 = v1 == 2 ? 0 : v1 + 1;
        SDMA(j + 1, 0, v2);
        SBAR(); qkt<DQK>(pB0, pB1, Ksl + G::SHM_K, koffs, qr, negm);
        finishSM(pA0, pA1, l_reg, pa0, pa1, pa2, pa3); SBAR();
        pv_d0(o, vb0 + vs * SHM_V, pa0, pa1, pa2, pa3); { float al_; partialSM<false>(pB0, pB1, negm, al_, l_reg); RESC(al_); } __syncthreads();
        const int v3 = v2 == 2 ? 0 : v2 + 1;
        SDMA(j + 2, 1, v3);
        SBAR(); qkt<DQK>(pA0, pA1, Ksl, koffs, qr, negm);
        finishSM(pB0, pB1, l_reg, pa0, pa1, pa2, pa3); SBAR();
        pv_d0(o, vb0 + v1 * SHM_V, pa0, pa1, pa2, pa3); { float al_; partialSM<false>(pA0, pA1, negm, al_, l_reg); RESC(al_); } __syncthreads();
        vs = v2;
    }
    {   const int v1 = vs == 2 ? 0 : vs + 1;
        SBAR(); qkt<DQK>(pB0, pB1, Ksl + G::SHM_K, koffs, qr, negm);
        finishSM(pA0, pA1, l_reg, pa0, pa1, pa2, pa3); SBAR();
        pv_d0(o, vb0 + vs * SHM_V, pa0, pa1, pa2, pa3); { float al_; partialSM<false>(pB0, pB1, negm, al_, l_reg); RESC(al_); }
        finishSM(pB0, pB1, l_reg, pa0, pa1, pa2, pa3); SBAR();
        pv_d0(o, vb0 + v1 * SHM_V, pa0, pa1, pa2, pa3); }
    if (hi == 0) li_l[r32] = l_reg; asm volatile("s_waitcnt lgkmcnt(0)" ::: "memory");
    const int lane_e = opaque_lane(), hi_e = lane_e >> 5;
    float rli[16];
#pragma unroll
    for (int r = 0; r < 16; ++r) rli[r] = __builtin_amdgcn_rcpf(li_l[crow(r, hi_e)]);
    bf16* Ow = Ob + (long)(wid * QBLK) * ldo;
    char* ost = lds + 3 * SHM_V + 2 * G::SHM_K + 2048 + wid * 4608;
#pragma unroll
    for (int h = 0; h < 2; ++h) {
#pragma unroll
        for (int r = 0; r < 16; ++r) { const unsigned w = cvt_pk_bf16(o[2 * h][r] * rli[r], o[2 * h + 1][r] * rli[r]); char* q = ost + crow(r, hi_e) * 144 + (lane_e & 31) * 2;
            *(unsigned short*)q = (unsigned short)(w & 0xffffu); *(unsigned short*)(q + 64) = (unsigned short)(w >> 16); }
        asm volatile("s_waitcnt lgkmcnt(0)" ::: "memory");
#pragma unroll
        for (int i = 0; i < 4; ++i) { const int row = (lane_e >> 3) + 8 * i; const u32x4 v = *(const u32x4*)(ost + row * 144 + (lane_e & 7) * 16);
            *(u32x4*)(Ow + (long)row * ldo + h * 64 + (lane_e & 7) * 8) = v; }
    }
    __syncthreads();
#undef SDMA
#undef RESC
}
}

#define XB_TMO      128
#define XB_XCNT(j)  (256  + 64 * (j))
#define XB_XSUB(j)  (1280 + 64 * (j))
#define XB_XGEN(j)  (2304 + 64 * (j))
#define XB_TOP      3328
#define XB_TOPGEN   3392
#define XCD_BAR_WORDS 3456
#define XB_SPIN_CAP (1u << 20)
__device__ __forceinline__ unsigned xb_ld(unsigned* p)              { return __hip_atomic_load(p, __ATOMIC_RELAXED, __HIP_MEMORY_SCOPE_AGENT); }
__device__ __forceinline__ unsigned xb_add(unsigned* p, unsigned v) { return __hip_atomic_fetch_add(p, v, __ATOMIC_RELAXED, __HIP_MEMORY_SCOPE_AGENT); }
__device__ __forceinline__ unsigned xb_xcc_id() { return (unsigned)__builtin_amdgcn_s_getreg((3 << 11) | 20) & 0xFu; }
#define XB_SPIN(cond, bar) do { unsigned _sp = 0; while (cond) { __builtin_amdgcn_s_sleep(1); \
    if ((++_sp & 255u) == 0u) { if (xb_ld(&(bar)[XB_TMO])) break; if (_sp > XB_SPIN_CAP) { atomicAdd(&(bar)[XB_TMO], 1u); break; } } } } while (0)
struct XcdBarrier { unsigned* bar; unsigned x; volatile LAS unsigned* st; int w; };
__device__ __forceinline__ XcdBarrier xcd_barrier_post(unsigned* bar, volatile LAS unsigned* st) {
    XcdBarrier b; b.bar = bar; b.x = xb_xcc_id(); b.st = st;
    if (threadIdx.x == 0) (void)xb_add(&bar[XB_XCNT(b.x)], 1u);
    return b;
}
__device__ __forceinline__ void xcd_barrier_complete(unsigned* bar, unsigned x, unsigned& nloc, unsigned& nx) {
    const unsigned G = gridDim.x * gridDim.y * gridDim.z;
    unsigned sum, cnt, mine, sp = 0u;
    for (;;) {
        sum = 0u; cnt = 0u; mine = 0u;
#pragma unroll
        for (unsigned j = 0; j < 16; ++j) { const unsigned c = xb_ld(&bar[XB_XCNT(j)]); sum += c; cnt += (c > 0u) ? 1u : 0u; mine = (j == x) ? c : mine; }
        if (sum == G) break;
        __builtin_amdgcn_s_sleep(1);
        if ((++sp & 255u) == 0u) { if (xb_ld(&bar[XB_TMO])) break; if (sp > XB_SPIN_CAP) { atomicAdd(&bar[XB_TMO], 1u); break; } }
    }
    nloc = mine > 0u ? mine : 1u; nx = cnt > 0u ? cnt : 1u;
}
__device__ __forceinline__ void xcd_barrier(const XcdBarrier& b) {
    asm volatile("s_waitcnt vmcnt(0)" ::: "memory");
    __syncthreads();
    if (opaque_tid(b.w) == 0) {
        unsigned* bar = b.bar;
        __builtin_amdgcn_s_waitcnt(0);
        unsigned nloc = b.st[0], nx = b.st[1];
        if (nloc == 0u) { xcd_barrier_complete(bar, b.x, nloc, nx); b.st[0] = nloc; b.st[1] = nx; }
        const unsigned old = xb_add(&bar[XB_XSUB(b.x)], 1u);
        const unsigned gen = old / nloc;
        if (old + 1u == (gen + 1u) * nloc) {
            __builtin_amdgcn_fence(__ATOMIC_RELEASE, "agent");
            asm volatile("s_waitcnt vmcnt(0)" ::: "memory");
            const unsigned og = xb_add(&bar[XB_TOP], 1u);
            const unsigned tg = og / nx;
            if (og + 1u == (tg + 1u) * nx) xb_add(&bar[XB_TOPGEN], 1u);
            else XB_SPIN(xb_ld(&bar[XB_TOPGEN]) == tg, bar);
            __builtin_amdgcn_fence(__ATOMIC_ACQUIRE, "agent");
            xb_add(&bar[XB_XGEN(b.x)], 1u);
            asm volatile("s_waitcnt vmcnt(0)" ::: "memory");
        } else {
            XB_SPIN(xb_ld(&bar[XB_XGEN(b.x)]) == gen, bar);
            __builtin_amdgcn_fence(__ATOMIC_ACQUIRE, "agent");
            asm volatile("s_waitcnt vmcnt(0)" ::: "memory");
        }
    }
    __syncthreads();
}

template <int MODE>
__device__ __forceinline__ void transpose_item(const float* __restrict__ W, int K, int N, bf16* __restrict__ WT, const float* __restrict__ gk, LAS float* scr, int item, int lane) {
    const int nblk = N / 32, kb = item / nblk, nb = item % nblk, k0 = 64 * kb, n0 = 32 * nb;
    { const int kq = lane >> 3, n4 = (lane & 7) * 4; f32x4 w[8];
#pragma unroll
      for (int i = 0; i < 8; ++i) w[i] = *(const f32x4*)(W + (size_t)(k0 + kq + 8 * i) * N + n0 + n4);
      if (gk) {
#pragma unroll
          for (int i = 0; i < 8; ++i) { const float g = gk[k0 + kq + 8 * i]; w[i] = w[i] * g; } }
#pragma unroll
      for (int i = 0; i < 8; ++i) { LAS float* d = scr + (kq + 8 * i) * 33 + n4; d[0] = w[i].x; d[1] = w[i].y; d[2] = w[i].z; d[3] = w[i].w; } }
    LDS_WAIT(); asm volatile("" ::: "memory");
    const int c = lane & 7;
#pragma unroll
    for (int j = 0; j < 4; ++j) { const int n = (lane >> 3) + 8 * j; const LAS float* s = scr + (8 * c) * 33 + n;
        u32x4 o; o.x = cvt_pk_bf16(s[0 * 33], s[1 * 33]); o.y = cvt_pk_bf16(s[2 * 33], s[3 * 33]); o.z = cvt_pk_bf16(s[4 * 33], s[5 * 33]); o.w = cvt_pk_bf16(s[6 * 33], s[7 * 33]);
        int nn = n0 + n; if (MODE == 1) { const int hh = nn >> 8, jj = nn & 255; nn = hh * 320 + (jj < 128 ? jj : jj + 64); }
        *(u32x4*)(WT + (size_t)nn * K + k0 + 8 * c) = o; }
    LDS_WAIT(); asm volatile("" ::: "memory");
}
__device__ __forceinline__ void rms_row_to_bf16(const float* __restrict__ xrow, const float* __restrict__ g, bf16* __restrict__ orow, int lane) {
    const f32x4* xr = (const f32x4*)xrow + lane; f32x4 v[8]; float s = 0.f;
#pragma unroll
    for (int j = 0; j < 8; ++j) { v[j] = xr[64 * j]; s += (v[j].x * v[j].x + v[j].y * v[j].y) + (v[j].z * v[j].z + v[j].w * v[j].w); }
    const float r = rsqrtf(wave_sum(s, lane) * (1.f / D) + EPS);
    u32x2* o8 = (u32x2*)orow + lane;
#pragma unroll
    for (int j = 0; j < 8; ++j) { const f32x4 gg = ((const f32x4*)g)[lane + 64 * j]; u32x2 w; w.x = cvt_pk_bf16(v[j].x * r * gg.x, v[j].y * r * gg.y); w.y = cvt_pk_bf16(v[j].z * r * gg.z, v[j].w * r * gg.w); o8[64 * j] = w; }
}

template <int NK>
__device__ __forceinline__ void hgrn_scan_item(const bf16* __restrict__ Zv, int row0, int L, int hh, int dir, int kbase, const float* __restrict__ lbl, bf16* __restrict__ Oo,
                                               LAS unsigned char* lds, const unsigned char* lds_gen, int tid, int lane, int wave) {
    constexpr int NPAIR = NK / 2, NPART = 256 / NPAIR, SPT = 64 / NPART, QROW = NK * 2 + 16, ND0 = NK / 16, NKB = NK / 32;
    constexpr int O_KT = 64 * QROW, O_KTT = 128 * QROW, O_VL = 128 * QROW + NK * 144, O_FAC = O_VL + 16384, BUF = O_FAC + 3 * NK * 4;
    static_assert(2 * BUF + NPART * NK * 4 <= 147328, "HGRN LDS");
    LAS float* TOT = (LAS float*)(lds + 2 * BUF);
    const int nchunk = L >> 6;
#define HG_POS(n) (dir ? (L - 1 - (n)) : (n))
    if (wave >= 4) {
        const int ptid = tid - 256, kp = ptid % NPAIR, part = ptid / NPAIR, vr = ptid >> 4, sc = (ptid & 15) * 8;
        const int zc = hh * 128 + kbase + 2 * kp;
        float lb0, lb1; { const float* lg = lbl + dir * 2048 + zc; const f32x2 l0 = *(const f32x2*)lg, l1 = *(const f32x2*)(lg + 4096), l2 = *(const f32x2*)(lg + 8192), l3 = *(const f32x2*)(lg + 12288);
            { const float mx = fmaxf(fmaxf(l0.x, l1.x), fmaxf(l2.x, l3.x)); const float e0 = __expf(l0.x - mx), e1 = __expf(l1.x - mx), e2 = __expf(l2.x - mx), e3 = __expf(l3.x - mx); lb0 = e1 / (e0 + e1 + e2 + e3); }
            { const float mx = fmaxf(fmaxf(l0.y, l1.y), fmaxf(l2.y, l3.y)); const float e0 = __expf(l0.y - mx), e1 = __expf(l1.y - mx), e2 = __expf(l2.y - mx), e3 = __expf(l3.y - mx); lb1 = e1 / (e0 + e1 + e2 + e3); } }
        int vst[4];
#pragma unroll
        for (int i = 0; i < 4; ++i) vst[i] = att::v_st(vr + 16 * i, sc);
        unsigned hq_[SPT], hz_[SPT]; bf16x8 rv[4];
#define HG_LOAD(ch) do { _Pragma("unroll") for (int i = 0; i < SPT; ++i) { const int n = (ch) * 64 + part * SPT + i; const bf16* zr = Zv + (size_t)(row0 + HG_POS(n)) * 10240 + zc; hq_[i] = *(const unsigned*)zr; hz_[i] = *(const unsigned*)(zr + 2048 + dir * 2048); } \
        _Pragma("unroll") for (int i = 0; i < 4; ++i) rv[i] = *(const bf16x8*)(Zv + (size_t)(row0 + HG_POS((ch) * 64 + vr + 16 * i)) * 10240 + 6144 + hh * 128 + sc); } while (0)
        HG_LOAD(0);
        for (int s = -1; s < nchunk; ++s) {
            const bool work = s + 1 < nchunk; LAS unsigned char* B = lds + ((s + 1) & 1) * BUF;
            float run0[SPT], run1[SPT], kk0[SPT], kk1[SPT]; unsigned qraw[SPT];
            if (work) {
                float a0 = 0.f, a1 = 0.f;
#pragma unroll
                for (int i = 0; i < SPT; ++i) { const float z0 = bflo(hz_[i]), z1 = bfhi(hz_[i]);
                    const float s0 = __builtin_amdgcn_rcpf(1.f + __expf(-z0)), s1 = __builtin_amdgcn_rcpf(1.f + __expf(-z1));
                    const float f0 = lb0 + (1.f - lb0) * s0, f1 = lb1 + (1.f - lb1) * s1;
                    kk0[i] = (1.f - lb0) * (1.f - s0); kk1[i] = (1.f - lb1) * (1.f - s1);
                    a0 += __logf(f0); a1 += __logf(f1); run0[i] = a0; run1[i] = a1; qraw[i] = hq_[i]; }
                *(LAS f32x2*)(TOT + part * NK + 2 * kp) = (f32x2){a0, a1};
#pragma unroll
                for (int i = 0; i < 4; ++i) *(LAS bf16x8*)(B + O_VL + vst[i]) = rv[i];
            }
            __syncthreads();
            if (work) {
                float base0 = 0.f, base1 = 0.f, rr0 = 0.f, rr1 = 0.f, bl0 = 0.f, bl1 = 0.f;
#pragma unroll
                for (int q = 0; q < NPART; ++q) { const f32x2 t = *(const LAS f32x2*)(TOT + q * NK + 2 * kp); if (q < part) { base0 += t.x; base1 += t.y; } if (q < NPART / 2) { rr0 += t.x; rr1 += t.y; } bl0 += t.x; bl1 += t.y; }
                base0 -= rr0; base1 -= rr1;
                unsigned kw0[SPT / 2], kw1[SPT / 2];
#pragma unroll
                for (int i = 0; i < SPT; i += 2) {
                    const float d00 = fminf(fmaxf(base0 + run0[i], -60.f), 60.f), d01 = fminf(fmaxf(base1 + run1[i], -60.f), 60.f);
                    const float d10 = fminf(fmaxf(base0 + run0[i + 1], -60.f), 60.f), d11 = fminf(fmaxf(base1 + run1[i + 1], -60.f), 60.f);
                    const float ka0 = kk0[i] * __expf(-d00), ka1 = kk1[i] * __expf(-d01), kb0 = kk0[i + 1] * __expf(-d10), kb1 = kk1[i + 1] * __expf(-d11);
                    const int st = part * SPT + i;
                    *(LAS unsigned*)(B + st * QROW + kp * 4) = cvt_pk_bf16(bflo(qraw[i]) * __expf(d00), bfhi(qraw[i]) * __expf(d01));
                    *(LAS unsigned*)(B + (st + 1) * QROW + kp * 4) = cvt_pk_bf16(bflo(qraw[i + 1]) * __expf(d10), bfhi(qraw[i + 1]) * __expf(d11));
                    *(LAS unsigned*)(B + O_KT + st * QROW + kp * 4) = cvt_pk_bf16(ka0, ka1);
                    *(LAS unsigned*)(B + O_KT + (st + 1) * QROW + kp * 4) = cvt_pk_bf16(kb0, kb1);
                    kw0[i >> 1] = cvt_pk_bf16(ka0, kb0); kw1[i >> 1] = cvt_pk_bf16(ka1, kb1); }
#pragma unroll
                for (int i = 0; i < SPT / 8; ++i) {
                    *(LAS u32x4*)(B + O_KTT + (2 * kp) * 144 + part * SPT * 2 + 16 * i) = (u32x4){kw0[4 * i], kw0[4 * i + 1], kw0[4 * i + 2], kw0[4 * i + 3]};
                    *(LAS u32x4*)(B + O_KTT + (2 * kp + 1) * 144 + part * SPT * 2 + 16 * i) = (u32x4){kw1[4 * i], kw1[4 * i + 1], kw1[4 * i + 2], kw1[4 * i + 3]}; }
                if (part == 0) { LAS float* FAC = (LAS float*)(B + O_FAC);
                    *(LAS f32x2*)(FAC + 2 * kp) = (f32x2){__expf(rr0), __expf(rr1)}; *(LAS f32x2*)(FAC + NK + 2 * kp) = (f32x2){__expf(bl0), __expf(bl1)}; *(LAS f32x2*)(FAC + 2 * NK + 2 * kp) = (f32x2){__expf(bl0 - rr0), __expf(bl1 - rr1)}; }
                if (s + 2 < nchunk) HG_LOAD(s + 2);
            }
            __syncthreads();
        }
#undef HG_LOAD
    } else {
        const int vb = wave, r32 = lane & 31, hi = lane >> 5;
        const int olane = (dir ? 63 - 4 * hi : 4 * hi) * (D * 2) + r32 * 2;
        f32x16 St[NKB];
#pragma unroll
        for (int i = 0; i < NKB; ++i) St[i] = f32x16{};
#define HG_PK(L_, H_) (bf16x8){L_[0], L_[1], L_[2], L_[3], H_[0], H_[1], H_[2], H_[3]}
#define HG_PK4(P_, BASE_, OUT_) do { unsigned a0_ = cvt_pk_bf16(P_[BASE_ + 0], P_[BASE_ + 1]), a1_ = cvt_pk_bf16(P_[BASE_ + 2], P_[BASE_ + 3]); \
    unsigned b0_ = cvt_pk_bf16(P_[BASE_ + 4], P_[BASE_ + 5]), b1_ = cvt_pk_bf16(P_[BASE_ + 6], P_[BASE_ + 7]); \
    auto r0_ = __builtin_amdgcn_permlane32_swap(a0_, b0_, false, false); auto r1_ = __builtin_amdgcn_permlane32_swap(a1_, b1_, false, false); \
    u32x4 w_ = {r0_[0], r1_[0], r0_[1], r1_[1]}; OUT_ = *reinterpret_cast<bf16x8*>(&w_); } while (0)
        for (int s = -1; s < nchunk; ++s) {
            LAS unsigned char* QT = lds + (s & 1) * BUF; LAS unsigned char* KT = QT + O_KT; LAS unsigned char* KTT = QT + O_KTT; LAS float* FAC = (LAS float*)(QT + O_FAC);
            bf16x8 vf[4]; f32x16 od0 = f32x16{}, od1 = f32x16{};
            if (s >= 0) {
                const int vbase = (int)(uintptr_t)(lds_gen + (s & 1) * BUF + O_VL) + att::v_rd_base(lane) + vb * 512;
                { const s16x4 l0 = att::tr_read<att::v_rd_off(0, 0, 0)>(vbase), h0 = att::tr_read<att::v_rd_off(0, 0, 1)>(vbase), l1 = att::tr_read<att::v_rd_off(0, 1, 0)>(vbase), h1 = att::tr_read<att::v_rd_off(0, 1, 1)>(vbase);
                  const s16x4 l2 = att::tr_read<att::v_rd_off(0, 2, 0)>(vbase), h2 = att::tr_read<att::v_rd_off(0, 2, 1)>(vbase), l3 = att::tr_read<att::v_rd_off(0, 3, 0)>(vbase), h3 = att::tr_read<att::v_rd_off(0, 3, 1)>(vbase);
                  asm volatile("s_waitcnt lgkmcnt(0)" ::: "memory"); __builtin_amdgcn_sched_barrier(0);
                  vf[0] = HG_PK(l0, h0); vf[1] = HG_PK(l1, h1); vf[2] = HG_PK(l2, h2); vf[3] = HG_PK(l3, h3); }
                {
                    f32x16 p0 = f32x16{};
#pragma unroll
                    for (int d0 = 0; d0 < ND0; ++d0) { const int cb = (d0 * 16 + hi * 8) * 2;
                        const bf16x8 a = *(const LAS bf16x8*)(KT + r32 * QROW + cb), b = *(const LAS bf16x8*)(QT + r32 * QROW + cb);
                        p0 = __builtin_amdgcn_mfma_f32_32x32x16_bf16(a, b, p0, 0, 0, 0); }
#pragma unroll
                    for (int r = 0; r < 16; ++r) if (att::crow(r, hi) > r32) p0[r] = 0.f;
                    bf16x8 pa0, pa1; HG_PK4(p0, 0, pa0); HG_PK4(p0, 8, pa1);
                    od0 = __builtin_amdgcn_mfma_f32_32x32x16_bf16(pa0, vf[0], od0, 0, 0, 0); od0 = __builtin_amdgcn_mfma_f32_32x32x16_bf16(pa1, vf[1], od0, 0, 0, 0); }
                {
                    f32x16 p0 = f32x16{}, p1 = f32x16{};
#pragma unroll
                    for (int d0 = 0; d0 < ND0; ++d0) { const int cb = (d0 * 16 + hi * 8) * 2;
                        const bf16x8 a0_ = *(const LAS bf16x8*)(KT + r32 * QROW + cb), a1_ = *(const LAS bf16x8*)(KT + (32 + r32) * QROW + cb), b = *(const LAS bf16x8*)(QT + (32 + r32) * QROW + cb);
                        p0 = __builtin_amdgcn_mfma_f32_32x32x16_bf16(a0_, b, p0, 0, 0, 0); p1 = __builtin_amdgcn_mfma_f32_32x32x16_bf16(a1_, b, p1, 0, 0, 0); }
#pragma unroll
                    for (int r = 0; r < 16; ++r) if (att::crow(r, hi) > r32) p1[r] = 0.f;
                    bf16x8 pa0, pa1, pa2, pa3; HG_PK4(p0, 0, pa0); HG_PK4(p0, 8, pa1); HG_PK4(p1, 0, pa2); HG_PK4(p1, 8, pa3);
                    od1 = __builtin_amdgcn_mfma_f32_32x32x16_bf16(pa0, vf[0], od1, 0, 0, 0); od1 = __builtin_amdgcn_mfma_f32_32x32x16_bf16(pa1, vf[1], od1, 0, 0, 0);
                    od1 = __builtin_amdgcn_mfma_f32_32x32x16_bf16(pa2, vf[2], od1, 0, 0, 0); od1 = __builtin_amdgcn_mfma_f32_32x32x16_bf16(pa3, vf[3], od1, 0, 0, 0); }
            }
            __syncthreads();
            if (s >= 0) {
#pragma unroll
                for (int kb = 0; kb < NKB; ++kb) {
                    float er[16];
#pragma unroll
                    for (int m = 0; m < 4; ++m) { const f32x4 e4 = *(const LAS f32x4*)(FAC + 32 * kb + 8 * m + 4 * hi); er[4 * m] = e4[0]; er[4 * m + 1] = e4[1]; er[4 * m + 2] = e4[2]; er[4 * m + 3] = e4[3]; }
#pragma unroll
                    for (int s2 = 0; s2 < 2; ++s2) {
                        u32x4 bw;
#pragma unroll
                        for (int j = 0; j < 4; ++j) bw[j] = cvt_pk_bf16(St[kb][8 * s2 + 2 * j] * er[8 * s2 + 2 * j], St[kb][8 * s2 + 2 * j + 1] * er[8 * s2 + 2 * j + 1]);
                        const bf16x8 bfr = *reinterpret_cast<bf16x8*>(&bw);
                        const int ko = (32 * kb + 16 * s2 + 4 * hi) * 2;
                        const u32x2 x0 = *(const LAS u32x2*)(QT + r32 * QROW + ko), x1 = *(const LAS u32x2*)(QT + r32 * QROW + ko + 16);
                        const u32x2 y0 = *(const LAS u32x2*)(QT + (32 + r32) * QROW + ko), y1 = *(const LAS u32x2*)(QT + (32 + r32) * QROW + ko + 16);
                        u32x4 aw0 = {x0[0], x0[1], x1[0], x1[1]}, aw1 = {y0[0], y0[1], y1[0], y1[1]};
                        od0 = __builtin_amdgcn_mfma_f32_32x32x16_bf16(*reinterpret_cast<bf16x8*>(&aw0), bfr, od0, 0, 0, 0);
                        od1 = __builtin_amdgcn_mfma_f32_32x32x16_bf16(*reinterpret_cast<bf16x8*>(&aw1), bfr, od1, 0, 0, 0); } }
                {   unsigned char* Ob = (unsigned char*)(Oo + (size_t)(row0 + (dir ? L - 64 - s * 64 : s * 64)) * D + hh * 128 + 32 * vb);
#define HG_ST(SG_) do { _Pragma("unroll") for (int r = 0; r < 16; r += 2) { constexpr int c0 = 0; const int cr = (r & 3) + 8 * (r >> 2) + c0;     \
                        const unsigned w0 = cvt_pk_bf16(od0[r], od0[r + 1]), w1 = cvt_pk_bf16(od1[r], od1[r + 1]); \
                        *(unsigned short*)(Ob + (unsigned)(ol_ + (SG_) * cr * (D * 2))) = (unsigned short)(w0 & 0xffffu); *(unsigned short*)(Ob + (unsigned)(ol_ + (SG_) * (cr + 1) * (D * 2))) = (unsigned short)(w0 >> 16); \
                        *(unsigned short*)(Ob + (unsigned)(ol_ + (SG_) * (cr + 32) * (D * 2))) = (unsigned short)(w1 & 0xffffu); *(unsigned short*)(Ob + (unsigned)(ol_ + (SG_) * (cr + 33) * (D * 2))) = (unsigned short)(w1 >> 16); } } while (0)
                    int ol_ = olane; asm volatile("" : "+v"(ol_));
                    if (dir) HG_ST(-1); else HG_ST(1);
#undef HG_ST
                }
#pragma unroll
                for (int kb = 0; kb < NKB; ++kb) {
                    f32x16 U = f32x16{};
#pragma unroll
                    for (int ks = 0; ks < 4; ++ks) { const bf16x8 a = *(const LAS bf16x8*)(KTT + (32 * kb + r32) * 144 + (16 * ks + 8 * hi) * 2); U = __builtin_amdgcn_mfma_f32_32x32x16_bf16(a, vf[ks], U, 0, 0, 0); }
#pragma unroll
                    for (int m = 0; m < 4; ++m) { const f32x4 el = *(const LAS f32x4*)(FAC + NK + 32 * kb + 8 * m + 4 * hi), elr = *(const LAS f32x4*)(FAC + 2 * NK + 32 * kb + 8 * m + 4 * hi);
#pragma unroll
                        for (int e = 0; e < 4; ++e) St[kb][4 * m + e] = el[e] * St[kb][4 * m + e] + elr[e] * U[4 * m + e]; } }
            }
            __syncthreads();
        }
#undef HG_PK
#undef HG_PK4
    }
#undef HG_POS
    __syncthreads();
}

__device__ __forceinline__ void reduce_rstd(const float* __restrict__ ssp, float* __restrict__ rstd, int i0, int stride) {
    for (int row = i0; row < T; row += stride) { float s = 0.f;
#pragma unroll
        for (int j = 0; j < 8; ++j) { const float* p = ssp + (size_t)(4 * j) * T + row; s += (p[0] + p[T]) + (p[2 * (size_t)T] + p[3 * (size_t)T]); }
        rstd[row] = rsqrtf(s * (1.f / D) + EPS); }
}
struct Args { const float* in[28]; float* out; unsigned char* ws; int ph_lo, ph_hi, li, pad; };
constexpr int RING_BYTES = 131072, LDS_BYTES = 147456, MISC_OFF = LDS_BYTES - 128;

__host__ __device__ constexpr int n_phases() {
    int n = 1;
    for (int layer = 0; layer < 4; ++layer) {
        n += 1;
        if (layer == 0) n += 1;
        const int kind = layer % 3;
        if (kind == 0) n += 2 + 3 * 3 + 1;
        else if (kind == 1) n += 3 * 3 + 1;
        else n += 5;
        n += 3;
        n += 1 + 4;
    }
    return n;
}
constexpr int NPH = n_phases();

#define H      ((bf16*)X)
#define Xb     ((bf16*)(ws + LO(WS_H)))
#define rstd_  ((float*)(ws + LO(WS_RSTD)))
#define ssp_   ((float*)(ws + LO(WS_SSP)))
#define ropec  ((float*)(ws + LO(WS_ROPE)))
#define ropes  ((float*)(ws + LO(WS_ROPE)) + 4096 * 32)
#define mem_rs ((float*)(ws + LO(WS_MEMRS)))
#define mem_b  ((bf16*)(ws + LO(WS_MEMB)))
#define memkv  ((bf16*)(ws + LO(WS_MEMKV)))
#define w1t    ((bf16*)(ws + LO(WS_W1)))
#define w2t    ((bf16*)(ws + LO(WS_W2)))
#define rq     ((float*)(ws + LO(WS_SS0)))
#define rkv_   ((float*)(ws + LO(WS_SS0) + 262144))
#define P      ((bf16*)(ws + LO(S_P)))
#define Qv     ((bf16*)(ws + LO(S_QC)) - (size_t)c * CH * 3072)
#define KVv    ((bf16*)(ws + LO(S_KVC)) - (size_t)c * CH * 5120)
#define Zv     ((bf16*)(ws + LO(S_Z)) - (size_t)c * CH * 10240)
#define OFv    ((bf16*)(ws + LO(S_OF)) - (size_t)c * CH * D)
#define OBv    ((bf16*)(ws + LO(S_OB)) - (size_t)c * CH * D)
#define OP2v   ((bf16*)X + (size_t)T * D - (size_t)c * CH * D)
#define OP3v   ((bf16*)X + (size_t)T * D + (size_t)CH * D - (size_t)c * CH * D)
#define T1     ((bf16*)(ws + LO(S_T1)))
#define Qm     ((bf16*)(ws + LO(S_QM)))
#define Om     ((bf16*)(ws + LO(S_OM)))
#define Hv     ((bf16*)(ws + LO(S_HID) + (size_t)(c & 1) * 256 * MiB) - (size_t)c * CH * DFF)
__global__ void __launch_bounds__(NWAVES * 64, 2) fwd(Args args) {
    extern __shared__ __attribute__((aligned(16))) unsigned char lds_raw[];
    LAS unsigned char* lds = (LAS unsigned char*)lds_raw;
    const int G0_ = gridDim.x, bx0_ = blockIdx.x, wid0_ = __builtin_amdgcn_readfirstlane((int)(threadIdx.x >> 6));
    const int vcu0_ = (G0_ % 8 == 0) ? (bx0_ % 8) * (G0_ / 8) + bx0_ / 8 : bx0_;
    unsigned* ctl = (unsigned*)(args.ws + WS_CTL);
    volatile LAS unsigned* MISC = (volatile LAS unsigned*)(lds + MISC_OFF);
    if (threadIdx.x < 16) MISC[threadIdx.x] = 0u;
    __syncthreads();
    const int lo = args.ph_lo, hi = args.ph_hi;
    XcdBarrier bar; bar.bar = ctl + CW_BAR + args.li * XCD_BAR_WORDS; bar.x = 0; bar.st = MISC + 8; bar.w = wid0_;
    if (hi - lo > 1) { bar = xcd_barrier_post(ctl + CW_BAR + args.li * XCD_BAR_WORDS, MISC + 8); bar.w = wid0_; }
    int ph = 0;
#define PH_BEGIN(id) asm volatile("" : "+s"(ph)); if (ph >= lo && ph < hi) { if (PHMASK & (1ull << (id))) for (int rep_ = 0; rep_ < (((REPMASK >> (id)) & 1ull) ? 2 : 1); ++rep_) { if (rep_) __syncthreads(); const int G = launder_i(G0_), bx = launder_i(bx0_), vcu = launder_i(vcu0_), NGW = G * NWAVES; (void)bx; (void)NGW; const int wave = launder_i(wid0_), tid = opaque_tid(wave), lane = tid & 63, gw = vcu * NWAVES + wave; (void)lane; (void)gw; unsigned char* ws = launder_p(args.ws); float* X = (float*)launder_p((unsigned char*)args.out); (void)X;
#define PH_END   } if (ph + 1 < hi) { XcdBarrier b2_ = bar; b2_.bar = (unsigned*)launder_p((unsigned char*)bar.bar); xcd_barrier(b2_); } } ++ph;


    PH_BEGIN(0)
    {
        for (int m = gw; m < T; m += NGW) { const float* src_ = (m < TPR ? in_ptr(0) + (size_t)m * D : in_ptr(1) + (size_t)(m - TPR) * D);
            const f32x4* xr = (const f32x4*)src_ + lane; f32x4 v[8]; float s = 0.f;
#pragma unroll
            for (int j = 0; j < 8; ++j) { v[j] = xr[64 * j]; s += (v[j].x * v[j].x + v[j].y * v[j].y) + (v[j].z * v[j].z + v[j].w * v[j].w); }
            s = wave_sum(s, lane); if (lane == 0) rstd_[m] = rsqrtf(s * (1.f / D) + EPS);
            u32x2* o8 = (u32x2*)(Xb + (size_t)m * D) + lane;
#pragma unroll
            for (int j = 0; j < 8; ++j) { u32x2 w; w.x = cvt_pk_bf16(v[j].x, v[j].y); w.y = cvt_pk_bf16(v[j].z, v[j].w); o8[64 * j] = w; } }
        for (int i = bx * 512 + tid; i < 4096 * 32; i += G * 512) { const int p = i >> 5, k = i & 31; const float inv = 1.0f / powf(10000.0f, (float)(2 * k) / 64.0f); const float ang = (float)p * inv; float s, c; sincosf(ang, &s, &c); ropec[i] = c; ropes[i] = s; }
        { bf16* Dc = (bf16*)(ws + LO(WS_DC)); const float* g2 = in_ptr(4) + 2 * D;
          for (int i = bx * 512 + tid; i < 4 * 2 * 512 * 512; i += G * 512) { const int k = i & 511, cp = (i >> 9) & 511, part = (i >> 18) & 1, g = i >> 19; const int r = (cp * k) & 511; const float x = (float)r * (2.0f / 512.0f);
              const float v = (part ? sinpif(x) : cospif(x)) * g2[g * 512 + k]; Dc[i] = (bf16)(cvt_pk_bf16(v, 0.f) & 0xffffu); } }
        { bf16* DL = (bf16*)(ws + LO(WS_DL2)); for (int i = bx * 512 + tid; i < 2048 * 2048; i += G * 512) { const int k = i & 2047, lp = i >> 11; const int j = k & 1023; const int r = (lp * j) & 2047; const float x = (float)r * (2.0f / 2048.0f);
              const float v = (k < 1024) ? cospif(x) : -sinpif(x); DL[i] = (bf16)(cvt_pk_bf16(v, 0.f) & 0xffffu); } }
        { bf16* DL = (bf16*)(ws + LO(WS_DL4)); for (int i = bx * 512 + tid; i < 4096 * 4096; i += G * 512) { const int k = i & 4095, lp = i >> 12; const int j = k & 2047; const int r = (lp * j) & 4095; const float x = (float)r * (2.0f / 4096.0f);
              const float v = (k < 2048) ? cospif(x) : -sinpif(x); DL[i] = (bf16)(cvt_pk_bf16(v, 0.f) & 0xffffu); } }
        for (int m = gw; m < 4096; m += NGW) { const float* src = (m < 2048 ? in_ptr(2) + (size_t)m * D : in_ptr(3) + (size_t)(m - 2048) * D);
            const f32x4* xr = (const f32x4*)src + lane; f32x4 v[8]; float s = 0.f;
#pragma unroll
            for (int j = 0; j < 8; ++j) { v[j] = xr[64 * j]; s += (v[j].x * v[j].x + v[j].y * v[j].y) + (v[j].z * v[j].z + v[j].w * v[j].w); }
            s = wave_sum(s, lane); if (lane == 0) mem_rs[m] = rsqrtf(s * (1.f / D) + EPS);
            u32x2* o8 = (u32x2*)(mem_b + (size_t)m * D) + lane;
#pragma unroll
            for (int j = 0; j < 8; ++j) { u32x2 w; w.x = cvt_pk_bf16(v[j].x, v[j].y); w.y = cvt_pk_bf16(v[j].z, v[j].w); o8[64 * j] = w; } }
        { u32x4 z = {0u, 0u, 0u, 0u};
          for (int i = bx * 512 + tid; i < 2 * 192 * 2048 / 8; i += G * 512) { const int j = i / (192 * 2048 / 8), r = i % (192 * 2048 / 8); *(u32x4*)((bf16*)(ws + LO(WS_MLA_WIN)) + (size_t)j * 1280 * 2048 + (size_t)1088 * 2048 + (size_t)r * 8) = z; }
          for (int i = bx * 512 + tid; i < 2 * 16 * 64 * 512 / 8; i += G * 512) { const int j = i / (16 * 64 * 512 / 8), r = i % (16 * 64 * 512 / 8), hh = r / (64 * 512 / 8), q = r % (64 * 512 / 8);
              *(u32x4*)((bf16*)(ws + LO(WS_MLA_WKVB)) + (size_t)j * 5120 * 512 + (size_t)(hh * 320 + 128) * 512 + (size_t)q * 8) = z; } }
        LAS float* scr = (LAS float*)(lds + wave * 16384);
        {
            constexpr int I_WIN = 32 * 34, I_QB = 8 * 96, I_KVB = 8 * 128, I_WO = 32 * 64, I_HIN = 32 * 320, I_MQ = 32 * 16, I_MKV = 32 * 32, I_MO = 8 * 64;
            constexpr int NIT = 2 * I_WIN + 2 * I_QB + 2 * I_KVB + 2 * I_WO + I_HIN + I_WO + I_WO + 4 * I_MQ + 4 * I_MKV + 4 * I_MO;
            for (int it = gw; it < NIT; it += NGW) {
                int r = it;
                if (r < 2 * I_WIN) { const int j = r / I_WIN; transpose_item<0>(in_ptr(5) + (size_t)j * 2048 * 1088, 2048, 1088, (bf16*)(ws + LO(WS_MLA_WIN)) + (size_t)j * 1280 * 2048, in_ptr(4) + (3 * j) * D, scr, r % I_WIN, lane); continue; } r -= 2 * I_WIN;
                if (r < 2 * I_QB) { const int j = r / I_QB; transpose_item<0>(in_ptr(8) + (size_t)j * 512 * 3072, 512, 3072, (bf16*)(ws + LO(WS_MLA_WQB)) + (size_t)j * 3072 * 512, in_ptr(6) + j * 512, scr, r % I_QB, lane); continue; } r -= 2 * I_QB;
                if (r < 2 * I_KVB) { const int j = r / I_KVB; transpose_item<1>(in_ptr(9) + (size_t)j * 512 * 4096, 512, 4096, (bf16*)(ws + LO(WS_MLA_WKVB)) + (size_t)j * 5120 * 512, in_ptr(7) + j * 512, scr, r % I_KVB, lane); continue; } r -= 2 * I_KVB;
                if (r < 2 * I_WO) { const int j = r / I_WO; transpose_item<0>(in_ptr(12) + (size_t)j * 2048 * 2048, 2048, 2048, (bf16*)(ws + LO(WS_MLA_WO)) + (size_t)j * 2048 * 2048, nullptr, scr, r % I_WO, lane); continue; } r -= 2 * I_WO;
                if (r < I_HIN) { transpose_item<0>(in_ptr(13), 2048, 10240, (bf16*)(ws + LO(WS_HG_WIN)), in_ptr(4) + 1 * D, scr, r, lane); continue; } r -= I_HIN;
                if (r < I_WO) { transpose_item<0>(in_ptr(16), 2048, 2048, (bf16*)(ws + LO(WS_HG_WO)), nullptr, scr, r, lane); continue; } r -= I_WO;
                if (r < I_WO) { transpose_item<0>(in_ptr(17), 2048, 2048, (bf16*)(ws + LO(WS_FN_WO)), nullptr, scr, r, lane); continue; } r -= I_WO;
                if (r < 4 * I_MQ) { const int j = r / I_MQ; transpose_item<0>(in_ptr(20) + (size_t)j * 2048 * 512, 2048, 512, (bf16*)(ws + LO(WS_MEM_WQ)) + (size_t)j * 512 * 2048, in_ptr(18) + j * D, scr, r % I_MQ, lane); continue; } r -= 4 * I_MQ;
                if (r < 4 * I_MKV) { const int j = r / I_MKV; transpose_item<0>(in_ptr(21) + (size_t)j * 2048 * 1024, 2048, 1024, (bf16*)(ws + LO(WS_MEM_WKV)) + (size_t)j * 1024 * 2048, in_ptr(19) + j * 2048, scr, r % I_MKV, lane); continue; } r -= 4 * I_MKV;
                { const int j = r / I_MO; transpose_item<0>(in_ptr(24) + (size_t)j * 512 * 2048, 512, 2048, (bf16*)(ws + LO(WS_MEM_WO)) + (size_t)j * 2048 * 512, nullptr, scr, r % I_MO, lane); }
            }
        }
        __syncthreads();
    }
    PH_END

#pragma unroll 1
    for (int layer = 0; layer < 4; ++layer) {
        const int kind = layer % 3, jm = layer / 3;
        PH_BEGIN(1)
        {
            if (layer > 0) reduce_rstd(ssp_, rstd_, bx * 512 + tid, G * 512);
            LAS float* scr = (LAS float*)(lds + wave * 16384);
            constexpr int I_1 = 32 * 256, I_2 = 128 * 64;
            for (int it = gw; it < I_1 + I_2; it += NGW) {
                if (it < I_1) transpose_item<0>(in_ptr(26) + (size_t)layer * D * DFF, D, DFF, w1t, in_ptr(25) + layer * D, scr, it, lane);
                else transpose_item<0>(in_ptr(27) + (size_t)layer * DFF * D, DFF, D, w2t, nullptr, scr, it - I_1, lane);
            }
            __syncthreads();
            if (layer == 0) {
                pg8::TileOrder S; S.init(mem_b, D, ws + WS_MEM_WKV, D, 0, 16, 16, G, bx);
                pg8::EpiBf16<1, 0> E{memkv, 4096, mem_rs, 0, 1.f};
                pg8::gemm_phase(lds, D, D, D, S, E, wave);
            }
        }
        PH_END
        if (layer == 0) {
            PH_BEGIN(2)
            for (int m = gw; m < 4096; m += NGW) { const int ly = lane >> 4, hh = (lane >> 2) & 3, qq = lane & 3;
                bf16* p = memkv + (size_t)m * 4096 + ly * 1024 + hh * 128 + qq * 32; const float* g = in_ptr(23) + ly * 128 + qq * 32;
                u32x4 raw[4]; float x[32]; float s = 0.f;
#pragma unroll
                for (int j = 0; j < 4; ++j) { raw[j] = *(const u32x4*)(p + 8 * j);
#pragma unroll
                    for (int e = 0; e < 4; ++e) { x[8 * j + 2 * e] = bflo(raw[j][e]); x[8 * j + 2 * e + 1] = bfhi(raw[j][e]); } }
#pragma unroll
                for (int e = 0; e < 32; ++e) s += x[e] * x[e];
                s += shx(s, 1, lane); s += shx(s, 2, lane);
                const float r = rsqrtf(s * (1.f / 128.f) + EPS);
#pragma unroll
                for (int j = 0; j < 4; ++j) { u32x4 w;
#pragma unroll
                    for (int e = 0; e < 4; ++e) w[e] = cvt_pk_bf16(x[8 * j + 2 * e] * r * g[8 * j + 2 * e], x[8 * j + 2 * e + 1] * r * g[8 * j + 2 * e + 1]);
                    *(u32x4*)(p + 8 * j) = w; } }
            PH_END
        }

        if (kind == 0) {
            PH_BEGIN(3)
            {   pg8::TileOrder S; S.init(Xb, D, (bf16*)(ws + LO(WS_MLA_WIN)) + (size_t)jm * 1280 * 2048, D, 0, T / 256, 5, G, bx);
                pg8::EpiBf16<1, 0> E{P, 1280, rstd_, 0, 1.f};
                pg8::gemm_phase(lds, D, D, D, S, E, wave); }
            PH_END
            PH_BEGIN(24)
            for (int m = gw; m < T; m += NGW) {
                const u32x4 a = *(const u32x4*)(P + (size_t)m * 1280 + lane * 16), b = *(const u32x4*)(P + (size_t)m * 1280 + lane * 16 + 8); float q2 = 0.f;
#pragma unroll
                for (int e = 0; e < 4; ++e) { const float a0 = bflo(a[e]), a1 = bfhi(a[e]), b0 = bflo(b[e]), b1 = bfhi(b[e]); q2 += (a0 * a0 + a1 * a1) + (b0 * b0 + b1 * b1); }
#pragma unroll
                for (int o = 1; o < 32; o <<= 1) q2 += shx(q2, o, lane);
                const float rs_ = rsqrtf(q2 * (1.f / 512.f) + EPS);
                if (lane == 0) rq[m] = rs_; if (lane == 32) rkv_[m] = rs_; }
            PH_END
#pragma unroll 1
            for (int c = 0; c < 3; ++c) {
                PH_BEGIN(4)
                {   pg8::TileOrder S; S.init(P, 1280, (bf16*)(ws + LO(WS_MLA_WQB)) + (size_t)jm * 3072 * 512, 512, c * 64, 64, 12, G, bx);
                    pg8::EpiBf16<1, 0> E{Qv, 3072, rq, 0, 1.f};
                    pg8::gemm_phase(lds, 512, 1280, 512, S, E, wave); }
                {   pg8::TileOrder S; S.init(P + 512, 1280, (bf16*)(ws + LO(WS_MLA_WKVB)) + (size_t)jm * 5120 * 512, 512, c * 64, 64, 20, G, bx);
                    pg8::EpiBf16<1, 0> E{KVv, 5120, rkv_, 0, 1.f};
                    pg8::gemm_phase(lds, 512, 1280, 512, S, E, wave); }
                PH_END
                PH_BEGIN(5)
                {   const float* gk = in_ptr(11) + jm * 192; const int hh = lane >> 2, qq = lane & 3;
                    for (int m = c * CH + gw; m < (c + 1) * CH; m += NGW) {
                        const int pos = m < TPR ? (m & 2047) : ((m - TPR) & 4095);
                        bf16* kp = KVv + (size_t)m * 5120 + hh * 320; const bf16* pr = P + (size_t)m * 1280 + 1024;
                        u32x4 raw[4]; float x[32], x1[8], x2[8]; float s = 0.f;
#pragma unroll
                        for (int j = 0; j < 4; ++j) { raw[j] = *(const u32x4*)(kp + qq * 32 + 8 * j);
#pragma unroll
                            for (int e = 0; e < 4; ++e) { x[8 * j + 2 * e] = bflo(raw[j][e]); x[8 * j + 2 * e + 1] = bfhi(raw[j][e]); } }
                        { const u32x4 r1 = *(const u32x4*)(pr + qq * 8), r2 = *(const u32x4*)(pr + 32 + qq * 8);
#pragma unroll
                          for (int e = 0; e < 4; ++e) { x1[2 * e] = bflo(r1[e]); x1[2 * e + 1] = bfhi(r1[e]); x2[2 * e] = bflo(r2[e]); x2[2 * e + 1] = bfhi(r2[e]); } }
#pragma unroll
                        for (int e = 0; e < 32; ++e) s += x[e] * x[e];
#pragma unroll
                        for (int e = 0; e < 8; ++e) s += x1[e] * x1[e] + x2[e] * x2[e];
                        s += shx(s, 1, lane); s += shx(s, 2, lane);
                        const float r = rsqrtf(s * (1.f / 192.f) + EPS);
#pragma unroll
                        for (int j = 0; j < 4; ++j) { u32x4 w;
#pragma unroll
                            for (int e = 0; e < 4; ++e) w[e] = cvt_pk_bf16(x[8 * j + 2 * e] * r * gk[qq * 32 + 8 * j + 2 * e], x[8 * j + 2 * e + 1] * r * gk[qq * 32 + 8 * j + 2 * e + 1]);
                            *(u32x4*)(kp + qq * 32 + 8 * j) = w; }
                        float y1[8], y2[8];
#pragma unroll
                        for (int e = 0; e < 8; ++e) { const int i = qq * 8 + e; const float cc = ropec[pos * 32 + i], sn = ropes[pos * 32 + i];
                            const float a = x1[e] * r * gk[128 + i], b = x2[e] * r * gk[160 + i]; y1[e] = a * cc - b * sn; y2[e] = a * sn + b * cc; }
                        u32x4 w1, w2;
#pragma unroll
                        for (int e = 0; e < 4; ++e) { w1[e] = cvt_pk_bf16(y1[2 * e], y1[2 * e + 1]); w2[e] = cvt_pk_bf16(y2[2 * e], y2[2 * e + 1]); }
                        *(u32x4*)(kp + 128 + qq * 8) = w1; *(u32x4*)(kp + 160 + qq * 8) = w2;
                    } }
                PH_END
                PH_BEGIN(6)
                {   const int nqb = (c == 0) ? 8 : 16, nun = 1024;
                    for (int idx = vcu; idx < nun; idx += G) {
                        const int qb = idx % nqb, hh = (idx / nqb) & 15, sl = idx / (nqb * 16); const int s = (c == 0) ? sl : 8 + (c - 1) * 4 + sl;
                        const int row0 = seq_row0(s), L = seq_len(s);
                        att::attn_unit<192, true>(Qv + (size_t)(row0 + qb * 256) * 3072 + hh * 192, 3072, KVv + (size_t)row0 * 5120 + hh * 320, 5120, KVv + (size_t)row0 * 5120 + hh * 320 + 192, 5120,
                                                  H + (size_t)(row0 + qb * 256) * D + hh * 128, D, L, in_ptr(10) + jm * 192, ropec, ropes, qb * 256, 0.07216878364870322f, nullptr, (char*)lds_raw, wave);
                    } }
                PH_END
            }
            PH_BEGIN(7)
            {   pg8::TileOrder S; S.init(H, D, (bf16*)(ws + LO(WS_MLA_WO)) + (size_t)jm * 2048 * 2048, D, 0, T / 256, 8, G, bx);
                pg8::EpiResid<false> E{Xb, ssp_, nullptr};
                pg8::gemm_phase(lds, D, D, D, S, E, wave); }
            PH_END
        } else if (kind == 1) {
#pragma unroll 1
            for (int c = 0; c < 3; ++c) {
                PH_BEGIN(8)
                {   pg8::TileOrder S; S.init(Xb, D, ws + WS_HG_WIN, D, c * 64, 64, 40, G, bx);
                    pg8::EpiBf16<1, 0> E{Zv, 10240, rstd_, 0, 1.f};
                    pg8::gemm_phase(lds, D, D, D, S, E, wave); }
                PH_END
                PH_BEGIN(9)
                {
                    if (c == 0) {
                        for (int it = vcu; it < 256; it += G) { const int dir = it & 1, hh = (it >> 1) & 15, s = it >> 5;
                            hgrn_scan_item<128>(Zv, seq_row0(s), seq_len(s), hh, dir, 0, in_ptr(14), dir ? OBv : OFv, lds, lds_raw, tid, lane, wave); }
                    } else {
                        for (int it = vcu; it < 256; it += G) { const int kh = it & 1, dir = (it >> 1) & 1, hh = (it >> 2) & 15, s = 8 + (c - 1) * 4 + (it >> 6);
                            bf16* Oo = kh ? (dir ? OP3v : OP2v) : (dir ? OBv : OFv);
                            hgrn_scan_item<64>(Zv, seq_row0(s), seq_len(s), hh, dir, kh * 64, in_ptr(14), Oo, lds, lds_raw, tid, lane, wave); }
                    } }
                PH_END
                PH_BEGIN(10)
                {   const float* go = in_ptr(15) + (lane & 3) * 32;
                    for (int m = c * CH + gw; m < (c + 1) * CH; m += NGW) {
                        const bf16* pf = OFv + (size_t)m * D + lane * 32; const bf16* pb = OBv + (size_t)m * D + lane * 32; const bf16* pg = Zv + (size_t)m * 10240 + 8192 + lane * 32;
                        const bf16* p2 = OP2v + (size_t)m * D + lane * 32; const bf16* p3 = OP3v + (size_t)m * D + lane * 32;
                        float x[32]; float s = 0.f;
#pragma unroll
                        for (int j = 0; j < 4; ++j) { const u32x4 a = *(const u32x4*)(pf + 8 * j), b = *(const u32x4*)(pb + 8 * j);
#pragma unroll
                            for (int e = 0; e < 4; ++e) { x[8 * j + 2 * e] = bflo(a[e]) + bflo(b[e]); x[8 * j + 2 * e + 1] = bfhi(a[e]) + bfhi(b[e]); }
                            if (c > 0) { const u32x4 a2 = *(const u32x4*)(p2 + 8 * j), b2 = *(const u32x4*)(p3 + 8 * j);
#pragma unroll
                                for (int e = 0; e < 4; ++e) { x[8 * j + 2 * e] += bflo(a2[e]) + bflo(b2[e]); x[8 * j + 2 * e + 1] += bfhi(a2[e]) + bfhi(b2[e]); } } }
#pragma unroll
                        for (int e = 0; e < 32; ++e) s += x[e] * x[e];
                        s += shx(s, 1, lane); s += shx(s, 2, lane);
                        const float r = rsqrtf(s * (1.f / 128.f) + EPS);
#pragma unroll
                        for (int j = 0; j < 4; ++j) { const u32x4 gr = *(const u32x4*)(pg + 8 * j); u32x4 w;
#pragma unroll
                            for (int e = 0; e < 4; ++e) { const float g0 = bflo(gr[e]), g1 = bfhi(gr[e]); const float s0 = g0 / (1.f + __expf(-g0)), s1 = g1 / (1.f + __expf(-g1));
                                w[e] = cvt_pk_bf16(x[8 * j + 2 * e] * r * go[8 * j + 2 * e] * s0, x[8 * j + 2 * e + 1] * r * go[8 * j + 2 * e + 1] * s1); }
                            *(u32x4*)(H + (size_t)m * D + lane * 32 + 8 * j) = w; } } }
                PH_END
            }
            PH_BEGIN(11)
            {   pg8::TileOrder S; S.init(H, D, ws + WS_HG_WO, D, 0, T / 256, 8, G, bx);
                pg8::EpiResid<false> E{Xb, ssp_, nullptr};
                pg8::gemm_phase(lds, D, D, D, S, E, wave); }
            PH_END
        } else {
            struct F1Order { const char* Dc; const char* HEb; const char* HOb; int G, c, smp;
                __device__ __forceinline__ bool next(int i, pg8::Unit& u) const {
                    const int idx = i * G + c; const int npn = smp ? 8 : 4, per = 16 * npn; if (idx >= 8 * per) return false;
                    const int s = (smp ? 8 : 0) + idx / per, rem = idx % per; const int g = rem / (4 * npn), part = (rem / (2 * npn)) & 1, pn = (rem % (2 * npn)) / 2, pm = rem & 1;
                    const int row0 = seq_row0(s), L = seq_len(s);
                    u.pm = pm; u.pn = pn; u.a = Dc + ((size_t)((g * 2 + part) * 512 + pm * 256) * 512) * 2; u.b = (part ? HOb : HEb) + ((size_t)(row0 / 2 + pn * 256) * D + g * 512) * 2;
                    u.ooff = (long)row0 * D + (long)g * 512 * L + (long)part * (L / 2); u.aoff = 0; u.roff = 0; return true; } };
            struct F2Order { const char* DL; const char* T1b; int G, c, smp, half;
                __device__ __forceinline__ bool next(int i, pg8::Unit& u) const {
                    const int idx = i * G + c; const int L = smp ? 4096 : 2048, npm = L / 512; if (idx >= npm * 64) return false;
                    const int pm = idx / 64, sgp = idx % 64; const int s = (smp ? 8 : 0) + sgp / 8, g = (sgp % 8) / 2, pn = sgp % 2; const int row0 = seq_row0(s);
                    u.pm = pm; u.pn = pn; u.a = DL + ((size_t)pm * 256 * L + half * (L / 2)) * 2; u.b = T1b + ((size_t)row0 * D + (size_t)g * 512 * L + (size_t)pn * 256 * L + half * (L / 2)) * 2;
                    u.aoff = (long)(row0 / 2) * D + (long)g * (L / 2) * 512; u.ooff = half ? (long)row0 * D + g * 512 : u.aoff; u.roff = s * D + g * 512; return true; } };
            PH_BEGIN(22)
            {
                bf16* HE = (bf16*)(ws + LO(S_HE)); bf16* HO = (bf16*)(ws + LO(S_HO)); float* xcm = (float*)(ws + LO(WS_XCMID));
                for (int m = gw; m < T / 2; m += NGW) {
                    const int s = m < 8192 ? m / 1024 : 8 + (m - 8192) / 2048; const int row0 = seq_row0(s), L = seq_len(s), j = m - row0 / 2;
                    const bf16* pa = Xb + (size_t)(row0 + j) * D + lane * 32; const bf16* pb = Xb + (size_t)(row0 + (j ? L - j : 0)) * D + lane * 32;
                    const float ra = rstd_[row0 + j], rb = j ? rstd_[row0 + L - j] : 0.f;
#pragma unroll
                    for (int q = 0; q < 4; ++q) { const u32x4 a = *(const u32x4*)(pa + 8 * q), b = *(const u32x4*)(pb + 8 * q); u32x4 we, wo;
#pragma unroll
                        for (int e = 0; e < 4; ++e) { const float a0 = bflo(a[e]) * ra, a1 = bfhi(a[e]) * ra, b0 = bflo(b[e]) * rb, b1 = bfhi(b[e]) * rb; we[e] = cvt_pk_bf16(a0 + b0, a1 + b1); wo[e] = j ? cvt_pk_bf16(a0 - b0, a1 - b1) : 0u; }
                        *(u32x4*)(HE + (size_t)m * D + lane * 32 + 8 * q) = we; *(u32x4*)(HO + (size_t)m * D + lane * 32 + 8 * q) = wo; } }
                const bf16* Dcc = (const bf16*)(ws + LO(WS_DC));
                for (int t = gw; t < 16 * D; t += NGW) { const int s = t >> 11, col = t & 2047, g = col >> 9, cp = col & 511; const int mid = seq_row0(s) + seq_len(s) / 2;
                    const u32x4 dv = *(const u32x4*)(Dcc + ((size_t)(g * 2) * 512 + cp) * 512 + lane * 8), xv = *(const u32x4*)(Xb + (size_t)mid * D + g * 512 + lane * 8); float a = 0.f;
#pragma unroll
                    for (int e = 0; e < 4; ++e) a += bflo(dv[e]) * bflo(xv[e]) + bfhi(dv[e]) * bfhi(xv[e]);
                    a = wave_sum(a, lane); if (lane == 0) xcm[t] = a * rstd_[mid]; } }
            PH_END
            PH_BEGIN(12)
            {   F1Order S{(const char*)(ws + LO(WS_DC)), (const char*)(ws + LO(S_HE)), (const char*)(ws + LO(S_HO)), G, bx, 1}; pg8::EpiBf16<0, 0> E{T1, 4096, nullptr, 0, 1.f};
                pg8::gemm_phase(lds, 512, 512, D, S, E, wave); }
            {   F1Order S{(const char*)(ws + LO(WS_DC)), (const char*)(ws + LO(S_HE)), (const char*)(ws + LO(S_HO)), G, bx, 0}; pg8::EpiBf16<0, 0> E{T1, 2048, nullptr, 0, 1.f};
                pg8::gemm_phase(lds, 512, 512, D, S, E, wave); }
            PH_END
            PH_BEGIN(13)
            {   F2Order S{(const char*)(ws + LO(WS_DL4)), (const char*)T1, G, bx, 1, 0}; pg8::EpiBf16<0, 0> E{(bf16*)(ws + LO(S_HE)), 512, nullptr, 0, 1.f};
                pg8::gemm_phase(lds, 2048, 4096, 4096, S, E, wave); }
            {   F2Order S{(const char*)(ws + LO(WS_DL2)), (const char*)T1, G, bx, 0, 0}; pg8::EpiBf16<0, 0> E{(bf16*)(ws + LO(S_HE)), 512, nullptr, 0, 1.f};
                pg8::gemm_phase(lds, 1024, 2048, 2048, S, E, wave); }
            PH_END
            PH_BEGIN(23)
            {   F2Order S{(const char*)(ws + LO(WS_DL4)), (const char*)T1, G, bx, 1, 1}; pg8::EpiFnetSym E{H, (const bf16*)(ws + LO(S_HE)), (const float*)(ws + LO(WS_XCMID)), 4096, 6.905339660024878e-4f};
                pg8::gemm_phase(lds, 2048, 4096, 4096, S, E, wave); }
            {   F2Order S{(const char*)(ws + LO(WS_DL2)), (const char*)T1, G, bx, 0, 1}; pg8::EpiFnetSym E{H, (const bf16*)(ws + LO(S_HE)), (const float*)(ws + LO(WS_XCMID)), 2048, 9.765625e-4f};
                pg8::gemm_phase(lds, 1024, 2048, 2048, S, E, wave); }
            {
                const float* xcm = (const float*)(ws + LO(WS_XCMID));
                for (int t = gw; t < 16 * D; t += NGW) { const int s = t >> 11, col = t & 2047, g = col >> 9, cp = col & 511; const int row0 = seq_row0(s), L = seq_len(s);
                    const bf16* tp = T1 + (size_t)row0 * D + (size_t)g * 512 * L + (size_t)cp * L; float a = 0.f;
                    for (int j0 = lane * 8; j0 < L / 2; j0 += 512) { const u32x4 v = *(const u32x4*)(tp + j0);
#pragma unroll
                        for (int e = 0; e < 4; ++e) a += bflo(v[e]) - bfhi(v[e]); }
                    a = wave_sum(a, lane);
                    if (lane == 0) H[(size_t)(row0 + L / 2) * D + col] = (bf16)(cvt_pk_bf16((a + xcm[t]) * (L == 4096 ? 6.905339660024878e-4f : 9.765625e-4f), 0.f) & 0xffffu); } }
            PH_END
            PH_BEGIN(14)
            {   pg8::TileOrder S; S.init(H, D, ws + WS_FN_WO, D, 0, T / 256, 8, G, bx);
                pg8::EpiResid<false> E{Xb, ssp_, nullptr};
                pg8::gemm_phase(lds, D, D, D, S, E, wave); }
            PH_END
        }

        {
            PH_BEGIN(16)
            {   pg8::TileOrder S; S.init(Xb, D, (bf16*)(ws + LO(WS_MEM_WQ)) + (size_t)layer * 512 * 2048, D, 0, T / 256, 2, G, bx);
                pg8::EpiBf16<3, 0> E{Qm, 512, ssp_, 0, 1.f};
                pg8::gemm_phase(lds, D, D, D, S, E, wave); }
            PH_END
            PH_BEGIN(17)
            for (int idx = vcu; idx < 768; idx += G) {
                const int hh = idx & 3, rb = idx >> 2; const int s = rb < 64 ? rb / 8 : 8 + (rb - 64) / 16;
                const bf16* kp = memkv + (size_t)(s * 256) * 4096 + layer * 1024 + hh * 128;
                att::attn_unit<128, false>(Qm + (size_t)rb * 256 * 512 + hh * 128, 512, kp, 4096, kp + 512, 4096, Om + (size_t)rb * 256 * 512 + hh * 128, 512, 256,
                                           in_ptr(22) + layer * 128, nullptr, nullptr, 0, 0.08838834764831845f, nullptr, (char*)lds_raw, wave);
            }
            PH_END
            PH_BEGIN(18)
            {   pg8::TileOrder S; S.init(Om, 512, (bf16*)(ws + LO(WS_MEM_WO)) + (size_t)layer * 2048 * 512, 512, 0, T / 256, 8, G, bx);
                pg8::EpiResid<false> E{Xb, ssp_, nullptr};
                pg8::gemm_phase(lds, 512, 512, 512, S, E, wave); }
            PH_END
        }
        {
            PH_BEGIN(19)
            reduce_rstd(ssp_, rstd_, bx * 512 + tid, G * 512);
            PH_END
#pragma unroll 1
            for (int cc = 0; cc < 4; ++cc) {
                PH_BEGIN(20)
                if (cc > 0) { const int c = cc - 1;
                    pg8::TileOrder S; S.init(Hv, DFF, w2t, DFF, c * 64, 64, 8, G, bx);
                    if (layer == 3) { pg8::EpiResid<true> E{Xb, nullptr, X}; pg8::gemm_phase(lds, DFF, DFF, DFF, S, E, wave); }
                    else { pg8::EpiResid<false> E{Xb, ssp_, nullptr}; pg8::gemm_phase(lds, DFF, DFF, DFF, S, E, wave); } }
                if (cc < 3) { const int c = cc;
                    pg8::TileOrder S; S.init(Xb, D, w1t, D, c * 64, 64, 32, G, bx);
                    pg8::EpiBf16<1, 1> E{Hv, DFF, rstd_, 0, 1.f};
                    pg8::gemm_phase(lds, D, D, D, S, E, wave); }
                PH_END
            }
        }
    }
#undef PH_BEGIN
#undef PH_END
}

extern "C" void kernel_launch(void* const* d_in, const int* in_sizes, int n_in, void* d_out, int out_size, void* d_ws, size_t ws_size, hipStream_t stream) {
    static int grid = 0;
    if (grid == 0) {
        if (n_in != 28 || out_size != T * D || ws_size < WS_END) { fprintf(stderr, "kernel_launch: unexpected shapes (n_in %d out %d ws %zu)\n", n_in, out_size, ws_size); grid = -1; return; }
        int dev = 0, cus = 0, per_cu = 0;
        if (hipGetDevice(&dev) != hipSuccess || hipDeviceGetAttribute(&cus, hipDeviceAttributeMultiprocessorCount, dev) != hipSuccess) { grid = -1; return; }
        if (hipFuncSetAttribute((const void*)fwd, hipFuncAttributeMaxDynamicSharedMemorySize, LDS_BYTES) != hipSuccess) { fprintf(stderr, "kernel_launch: hipFuncSetAttribute failed\n"); grid = -1; return; }
        if (hipOccupancyMaxActiveBlocksPerMultiprocessor(&per_cu, (const void*)fwd, NWAVES * 64, LDS_BYTES) != hipSuccess || per_cu < 1) fprintf(stderr, "kernel_launch: occupancy query says %d\n", per_cu);
        (void)hipGetLastError();
        grid = cus;
    }
    if (grid < 0) return;
    (void)hipMemsetAsync((char*)d_ws + WS_CTL, 0, CTL_BYTES, stream);
    Args a{};
    for (int i = 0; i < 28; ++i) a.in[i] = (const float*)d_in[i];
    a.out = (float*)d_out; a.ws = (unsigned char*)d_ws; a.pad = 0;
#if N_LAUNCH_MODE == 0
    a.ph_lo = 0; a.ph_hi = NPH; a.li = 0;
    hipLaunchKernelGGL(fwd, dim3(grid), dim3(NWAVES * 64), LDS_BYTES, stream, a);
#else
    for (int p = 0; p < NPH; ++p) { a.ph_lo = p; a.ph_hi = p + 1; a.li = 0; hipLaunchKernelGGL(fwd, dim3(grid), dim3(NWAVES * 64), LDS_BYTES, stream, a); }
#endif
    const hipError_t le = hipPeekAtLastError();
    if (le != hipSuccess) fprintf(stderr, "kernel_launch: launch failed: %s\n", hipGetErrorName(le));
}
```

```cpp
#include <hip/hip_runtime.h>
#include <cstdio>
#include <cstdint>

#ifndef PHMASK
#define PHMASK 0xFFFFFFFFFFFFFFFFull
#endif
#ifndef REPMASK
#define REPMASK 0x0ull
#endif
#ifndef N_LAUNCH_MODE
#define N_LAUNCH_MODE 0
#endif

#define LAS __attribute__((address_space(3)))
#define GAS __attribute__((address_space(1)))
typedef unsigned short bf16;
typedef short bf16x8 __attribute__((ext_vector_type(8)));
typedef short s16x4 __attribute__((ext_vector_type(4)));
typedef float f32x4 __attribute__((ext_vector_type(4)));
typedef float f32x2 __attribute__((ext_vector_type(2)));
typedef float f32x16 __attribute__((ext_vector_type(16)));
typedef unsigned u32x4 __attribute__((ext_vector_type(4)));
typedef unsigned u32x2 __attribute__((ext_vector_type(2)));

constexpr int D = 2048, T = 49152, TPR = 16384, CH = 16384, DFF = 8192, NWAVES = 8;
constexpr float EPS = 1e-6f;
__host__ __device__ __forceinline__ int seq_row0(int s) { return s < 8 ? s * 2048 : 16384 + (s - 8) * 4096; }
__host__ __device__ __forceinline__ int seq_len(int s) { return s < 8 ? 2048 : 4096; }

constexpr size_t MiB = 1u << 20;
constexpr size_t WS_CTL = 0, CTL_BYTES = 4 * MiB;
constexpr size_t WS_SS0 = 1 * MiB, WS_RSTD = 2 * MiB;
constexpr size_t WS_ROPE = 4 * MiB;
constexpr size_t WS_MEMRS = 5 * MiB;
constexpr size_t WS_MLA_WIN = 6 * MiB, WS_MLA_WQB = 16 * MiB, WS_MLA_WKVB = 22 * MiB, WS_MLA_WO = 32 * MiB;
constexpr size_t WS_HG_WIN = 48 * MiB, WS_HG_WO = 88 * MiB, WS_FN_WO = 96 * MiB;
constexpr size_t WS_MEM_WQ = 104 * MiB, WS_MEM_WKV = 112 * MiB, WS_MEM_WO = 128 * MiB;
constexpr size_t WS_W1 = 136 * MiB, WS_W2 = 168 * MiB;
constexpr size_t WS_DC = 200 * MiB, WS_DL2 = 204 * MiB, WS_DL4 = 220 * MiB;
constexpr size_t WS_MEMB = 284 * MiB, WS_MEMKV = 300 * MiB;
constexpr size_t WS_H = 332 * MiB;
constexpr size_t WS_S = 524 * MiB;
constexpr size_t WS_SSP = 1036 * MiB;
constexpr size_t WS_W1B = 1044 * MiB, WS_W2B = 1076 * MiB;
constexpr size_t WS_END = 1108 * MiB;
constexpr size_t S_P = WS_S, S_QC = WS_S + 120 * MiB, S_KVC = WS_S + 216 * MiB;
constexpr size_t S_Z = WS_S, S_OF = WS_S + 320 * MiB, S_OB = WS_S + 384 * MiB;
constexpr size_t S_HE = WS_S, S_HO = WS_S + 96 * MiB, S_T1 = WS_S + 192 * MiB;
constexpr size_t WS_XCMID = WS_MEMRS + 65536;
constexpr size_t S_QM = WS_S, S_OM = WS_S + 48 * MiB;
constexpr size_t S_HID = WS_S;
constexpr int CW_TMO = 0, CW_BAR = 4096;

typedef __bf16 bf16x2_t __attribute__((ext_vector_type(2)));
__device__ __forceinline__ unsigned cvt_pk_bf16(float lo, float hi) { const f32x2 f = {lo, hi}; const bf16x2_t v = __builtin_convertvector(f, bf16x2_t); return __builtin_bit_cast(unsigned, v); }
__device__ __forceinline__ float bf2f(unsigned short b) { return __uint_as_float(((unsigned)b) << 16); }
__device__ __forceinline__ float bflo(unsigned w) { return __uint_as_float(w << 16); }
__device__ __forceinline__ float bfhi(unsigned w) { return __uint_as_float(w & 0xffff0000u); }
__device__ __forceinline__ float shx(float v, int m, int lane) { return __int_as_float(__builtin_amdgcn_ds_bpermute((lane ^ m) << 2, __float_as_int(v))); }
__device__ __forceinline__ float shl_(float v, int src) { return __int_as_float(__builtin_amdgcn_ds_bpermute(src << 2, __float_as_int(v))); }
__device__ __forceinline__ float wave_sum(float v, int lane) {
#pragma unroll
    for (int o = 1; o < 64; o <<= 1) v += shx(v, o, lane);
    return v;
}
__device__ __forceinline__ int opaque_lane() { unsigned z = 0u; asm volatile("" : "+v"(z)); return (int)__builtin_amdgcn_mbcnt_hi(~0u, __builtin_amdgcn_mbcnt_lo(~0u, z)); }
__device__ __forceinline__ int opaque_tid(int w) { return (w << 6) | opaque_lane(); }
__device__ __forceinline__ const float* in_ptr(int i) {
    const __attribute__((address_space(4))) char* ka = (const __attribute__((address_space(4))) char*)__builtin_amdgcn_kernarg_segment_ptr();
    int off = i * 8; asm volatile("" : "+s"(off));
    const float* p = *(const float* const __attribute__((address_space(4)))*)(ka + off);
    return (const float*)(const __attribute__((address_space(1))) float*)p;
}
__device__ __forceinline__ size_t LO(size_t v) { asm volatile("" : "+s"(v)); return v; }
__device__ __forceinline__ int launder_i(int v) { asm volatile("" : "+s"(v)); return v; }
__device__ __forceinline__ unsigned char* launder_p(unsigned char* p) { unsigned z = 0u; asm volatile("" : "+s"(z)); return p + z; }
#define LDS_WAIT() asm volatile("s_waitcnt lgkmcnt(0)" ::: "memory")
#define VM_WAIT() asm volatile("s_waitcnt vmcnt(0)" ::: "memory")

namespace pg8 {
constexpr int BM = 256, BK = 64, HALF = 128, HTB = HALF * BK * 2, STAGE_BYTES = 8 * HTB, NXCD = 8;
__host__ __device__ __forceinline__ int lds_byte(int r, int c) { const int st = (r >> 4) * 2 + (c >> 5), rr = r & 15, cc = c & 31, ob = rr * 64 + cc * 2; return st * 1024 + (ob ^ (((ob >> 9) & 1) << 5)); }
__host__ __device__ __forceinline__ void stage_rc(int b, int& R, int& C) { const int st = b / 1024, sb = b % 1024, swz = sb ^ (((sb >> 9) & 1) << 5); R = (st >> 1) * 16 + swz / 64; C = (st & 1) * 32 + (swz % 64) / 2; }
__host__ __device__ __forceinline__ int perm32(int rho) { const int n = rho >> 4, i = rho & 15; return 8 * (i >> 2) + 4 * n + (i & 3); }

struct Unit { int pm, pn; const char* a; const char* b; long ooff; long aoff; int roff; };

struct TileOrder {
    const char* A; const char* B; int lda, ldb, nM, nN, nwg, G, c, pm0, WGM;
    __device__ __forceinline__ void init(const void* A_, int lda_, const void* B_, int ldb_, int pm0_, int nM_, int nN_, int G_, int c_, int wgm_ = 4) {
        A = (const char*)A_; B = (const char*)B_; lda = lda_; ldb = ldb_; pm0 = pm0_; nM = nM_; nN = nN_; nwg = nM_ * nN_; G = G_; c = c_; WGM = wgm_; }
    __device__ __forceinline__ bool next(int i, Unit& u) const {
        const long L = (long)i * G + c; if (L >= nwg) return false;
        int wgid = (int)L; { const int q = nwg / NXCD, r = nwg % NXCD, xcd = wgid % NXCD, off = wgid / NXCD; wgid = (xcd < r ? xcd * (q + 1) : r * (q + 1) + (xcd - r) * q) + off; }
        const int nig = WGM * nN, gid = wgid / nig, fm = gid * WGM, gsz = (nM - fm) < WGM ? (nM - fm) : WGM;
        u.pm = pm0 + fm + ((wgid % nig) % gsz); u.pn = (wgid % nig) / gsz;
        u.a = A + (size_t)u.pm * 256 * lda * 2; u.b = B + (size_t)u.pn * 256 * ldb * 2; u.ooff = 0; u.aoff = 0; u.roff = 0; return true;
    }
};

template <int RS  , int ACT  > struct EpiBf16 {
    static constexpr bool PERM = true;
    bf16* O; int ldc; const float* rs; int rsw; float cs;
    __device__ __forceinline__ void pre(const Unit& u, int wr, int fr, float (&pv)[8]) const {
        const int row0 = u.pm * BM + wr * 64 + fr;
#pragma unroll
        for (int i = 0; i < 8; ++i) { const int row = row0 + (i >> 2) * HALF + (i & 3) * 16; pv[i] = RS == 1 ? rs[row] : RS == 2 ? rs[2 * row + rsw] : 0.f; }
    }
    __device__ __forceinline__ void operator()(const f32x4 (&acc)[2][2][4][2], const Unit& u, int wr, int wc, int fr, int fq, const float (&pv)[8]) const {
        const int row0 = u.pm * BM + wr * 64 + fr, col0 = u.pn * BM + wc * 32 + 8 * fq;
#pragma unroll
        for (int ai = 0; ai < 2; ++ai)
#pragma unroll
            for (int m = 0; m < 4; ++m) { const int row = row0 + ai * HALF + m * 16; float s = cs;
                if (RS == 1) s *= pv[ai * 4 + m];
                if (RS == 2) s *= rsqrtf(pv[ai * 4 + m] * (1.0f / 512.0f) + EPS);
                if (RS == 3) { float t = 0.f;
#pragma unroll
                    for (int j = 0; j < 8; ++j) { const float* pp = rs + (size_t)(4 * j) * T + row; t += (pp[0] + pp[T]) + (pp[2 * (size_t)T] + pp[3 * (size_t)T]); }
                    s *= rsqrtf(t * (1.f / D) + EPS); }
                bf16* rowp = O + u.ooff + (size_t)row * ldc + col0;
#pragma unroll
                for (int bj = 0; bj < 2; ++bj) { f32x4 v0 = acc[ai][bj][m][0] * s, v1 = acc[ai][bj][m][1] * s;
                    if (RS == 4) { const f32x4 c0 = *(const f32x4*)(rs + u.roff + col0 + bj * HALF), c1 = *(const f32x4*)(rs + u.roff + col0 + bj * HALF + 4); v0 = v0 * c0; v1 = v1 * c1; }
                    if (RS == 5) { const f32x4 c0 = *(const f32x4*)(rs + u.roff + col0 + bj * HALF), c1 = *(const f32x4*)(rs + u.roff + col0 + bj * HALF + 4); const float sg = (row & 1) ? -s : s; v0 = v0 + c0 * sg; v1 = v1 + c1 * sg; }
                    if (ACT == 1) {
#pragma unroll
                        for (int j = 0; j < 4; ++j) { const float a = fmaxf(v0[j], 0.f), b = fmaxf(v1[j], 0.f); v0[j] = a * a; v1[j] = b * b; } }
                    u32x4 w; w.x = cvt_pk_bf16(v0[0], v0[1]); w.y = cvt_pk_bf16(v0[2], v0[3]); w.z = cvt_pk_bf16(v1[0], v1[1]); w.w = cvt_pk_bf16(v1[2], v1[3]);
                    *(u32x4*)(rowp + bj * HALF) = w; } }
    }
};
template <bool FINAL> struct EpiResid {
    static constexpr bool PERM = true;
    bf16* Xb; float* ssp; float* out;
    __device__ __forceinline__ void pre(const Unit&, int, int, float (&)[8]) const {}
    __device__ __forceinline__ void operator()(const f32x4 (&acc)[2][2][4][2], const Unit& u, int wr, int wc, int fr, int fq, const float (&)[8]) const {
        const int row0 = u.pm * BM + wr * 64 + fr, col0 = u.pn * BM + wc * 32 + 8 * fq, lane_ = fq * 16 + fr;
        u32x4 o[2][4][2];
#pragma unroll
        for (int ai = 0; ai < 2; ++ai)
#pragma unroll
            for (int m = 0; m < 4; ++m)
#pragma unroll
                for (int bj = 0; bj < 2; ++bj) o[ai][m][bj] = *(const u32x4*)(Xb + (size_t)(row0 + ai * HALF + m * 16) * D + col0 + bj * HALF);
#pragma unroll
        for (int ai = 0; ai < 2; ++ai) { float qv[4] = {0.f, 0.f, 0.f, 0.f};
#pragma unroll
            for (int m = 0; m < 4; ++m) { const int row = row0 + ai * HALF + m * 16; bf16* xp = Xb + (size_t)row * D + col0; float q = 0.f;
#pragma unroll
                for (int bj = 0; bj < 2; ++bj) { const u32x4 ov = o[ai][m][bj];
                    f32x4 v0 = acc[ai][bj][m][0], v1 = acc[ai][bj][m][1];
                    v0[0] += bflo(ov[0]); v0[1] += bfhi(ov[0]); v0[2] += bflo(ov[1]); v0[3] += bfhi(ov[1]); v1[0] += bflo(ov[2]); v1[1] += bfhi(ov[2]); v1[2] += bflo(ov[3]); v1[3] += bfhi(ov[3]);
                    if (FINAL) { float* op = out + (size_t)row * D + col0 + bj * HALF; *(f32x4*)op = v0; *(f32x4*)(op + 4) = v1; }
                    else { u32x4 w; w.x = cvt_pk_bf16(v0[0], v0[1]); w.y = cvt_pk_bf16(v0[2], v0[3]); w.z = cvt_pk_bf16(v1[0], v1[1]); w.w = cvt_pk_bf16(v1[2], v1[3]);
                        *(u32x4*)(xp + bj * HALF) = w;
#pragma unroll
                        for (int j = 0; j < 4; ++j) { const float a = bflo(w[j]), b = bfhi(w[j]); q += a * a + b * b; } } }
                if (!FINAL) { q += shx(q, 16, lane_); q += shx(q, 32, lane_); qv[m] = q; } }
            if (!FINAL) { const float v = fq == 0 ? qv[0] : fq == 1 ? qv[1] : fq == 2 ? qv[2] : qv[3];
                ssp[(size_t)(u.pn * 4 + wc) * T + u.pm * BM + ai * HALF + wr * 64 + lane_] = v; }
            asm volatile("" ::: "memory"); }
    }
};

struct EpiFnetSym {
    static constexpr bool PERM = true;
    bf16* Y; const bf16* Ab; const float* xcm; int L; float cs;
    __device__ __forceinline__ void pre(const Unit&, int, int, float (&)[8]) const {}
    __device__ __forceinline__ void operator()(const f32x4 (&acc)[2][2][4][2], const Unit& u, int wr, int wc, int fr, int fq, const float (&)[8]) const {
        const int row0 = u.pm * BM + wr * 64 + fr, col0 = u.pn * BM + wc * 32 + 8 * fq;
        f32x4 b0[2], b1[2];
#pragma unroll
        for (int bj = 0; bj < 2; ++bj) { b0[bj] = *(const f32x4*)(xcm + u.roff + col0 + bj * HALF); b1[bj] = *(const f32x4*)(xcm + u.roff + col0 + bj * HALF + 4); }
#pragma unroll
        for (int ai = 0; ai < 2; ++ai)
#pragma unroll
            for (int m = 0; m < 4; ++m) { const int row = row0 + ai * HALF + m * 16; const float sg = (row & 1) ? -1.f : 1.f;
                const bf16* ap = Ab + u.aoff + (size_t)row * 512 + col0;
                bf16* y1 = Y + u.ooff + (size_t)row * D + col0; bf16* y2 = Y + u.ooff + (size_t)(L - row) * D + col0;
#pragma unroll
                for (int bj = 0; bj < 2; ++bj) { const u32x4 a = *(const u32x4*)(ap + bj * HALF);
                    f32x4 a0 = {bflo(a[0]), bfhi(a[0]), bflo(a[1]), bfhi(a[1])}, a1 = {bflo(a[2]), bfhi(a[2]), bflo(a[3]), bfhi(a[3])};
                    a0 = a0 + b0[bj] * sg; a1 = a1 + b1[bj] * sg;
                    const f32x4 p0 = (a0 + acc[ai][bj][m][0]) * cs, p1 = (a1 + acc[ai][bj][m][1]) * cs, q0 = (a0 - acc[ai][bj][m][0]) * cs, q1 = (a1 - acc[ai][bj][m][1]) * cs;
                    u32x4 w; w.x = cvt_pk_bf16(p0[0], p0[1]); w.y = cvt_pk_bf16(p0[2], p0[3]); w.z = cvt_pk_bf16(p1[0], p1[1]); w.w = cvt_pk_bf16(p1[2], p1[3]);
                    *(u32x4*)(y1 + bj * HALF) = w;
                    if (row > 0) { u32x4 v; v.x = cvt_pk_bf16(q0[0], q0[1]); v.y = cvt_pk_bf16(q0[2], q0[3]); v.z = cvt_pk_bf16(q1[0], q1[1]); v.w = cvt_pk_bf16(q1[2], q1[3]);
                        *(u32x4*)(y2 + bj * HALF) = v; } } }
    }
};

template <class Epi, class Sched>
__device__ __forceinline__ void gemm_phase(LAS unsigned char* lds, const int K, const int lda, const int ldb, const Sched& S, const Epi& E, const int widS) {
    const int tid = opaque_tid(widS), wid = __builtin_amdgcn_readfirstlane(tid >> 6), lane = tid & 63, wr = wid >> 2, wc = wid & 3, fr = lane & 15, fq = lane >> 4;
    const int nt = K / BK;
    unsigned voffA[2], voffB[2];
#pragma unroll
    for (int i = 0; i < 2; ++i) { int R, C; stage_rc(tid * 16 + i * 8192, R, C); const int Rb = Epi::PERM ? ((R & ~31) + perm32(R & 31)) : R;
        voffA[i] = (unsigned)(R * lda + C) * 2u; voffB[i] = (unsigned)(Rb * ldb + C) * 2u; }
    const size_t kstep = (size_t)(BK * 2);
    const size_t hstepA = (size_t)HALF * lda * 2, hstepB = (size_t)HALF * ldb * 2;
    const unsigned ldsw = (unsigned)wid * 1024u;
    const int aoff = lds_byte(wr * 64 + fr, fq * 8), boff = lds_byte(wc * 32 + fr, fq * 8);
#define PG8_SA(b, h) (((b) * 2 + (h)) * HTB)
#define PG8_SB(b, h) ((4 + (b) * 2 + (h)) * HTB)
#define PG8_STAGE(bufoff, gbase, voff) do { _Pragma("unroll") for (int _i = 0; _i < 2; ++_i) \
        __builtin_amdgcn_global_load_lds((const unsigned*)((const char*)(gbase) + (voff)[_i]), (LAS unsigned*)(lds + (bufoff) + ldsw + _i * 8192), 16, 0, 0); } while (0)
#define PG8_LDA(dst, b, h) do { _Pragma("unroll") for (int m = 0; m < 4; ++m) _Pragma("unroll") for (int k = 0; k < 2; ++k) dst[m][k] = *(const LAS bf16x8*)(lds + PG8_SA(b, h) + aoff + m * 2048 + k * 1024); } while (0)
#define PG8_LDB(dst, b, h) do { _Pragma("unroll") for (int n = 0; n < 2; ++n) _Pragma("unroll") for (int k = 0; k < 2; ++k) dst[n][k] = *(const LAS bf16x8*)(lds + PG8_SB(b, h) + boff + n * 2048 + k * 1024); } while (0)
#define PG8_MMA(ai, bj, At, Bt) do { __builtin_amdgcn_s_setprio(1); _Pragma("unroll") for (int m = 0; m < 4; ++m) _Pragma("unroll") for (int n = 0; n < 2; ++n) _Pragma("unroll") for (int k = 0; k < 2; ++k) \
        acc[ai][bj][m][n] = __builtin_amdgcn_mfma_f32_16x16x32_bf16(Bt[n][k], At[m][k], acc[ai][bj][m][n], 0, 0, 0); __builtin_amdgcn_s_setprio(0); } while (0)
#define PG8_WAIT_V(n) asm volatile("s_waitcnt vmcnt(" #n ")" ::: "memory")
#define PG8_WAIT_L(n) asm volatile("s_waitcnt lgkmcnt(" #n ")" ::: "memory")
#define PG8_BAR __builtin_amdgcn_s_barrier()
#define PG8_SCHED __builtin_amdgcn_sched_barrier(0)
    Unit cur, nxt; int ui = 0;
    if (!S.next(0, cur)) return;
    f32x4 acc[2][2][4][2];
#pragma unroll
    for (int a = 0; a < 2; ++a)
#pragma unroll
        for (int b = 0; b < 2; ++b)
#pragma unroll
            for (int m = 0; m < 4; ++m)
#pragma unroll
                for (int n = 0; n < 2; ++n) acc[a][b][m][n] = (f32x4){0.f, 0.f, 0.f, 0.f};
    bf16x8 At[4][2], B0[2][2], B1[2][2];
    const char* cA = cur.a; const char* cB = cur.b;
    float pv[8]; E.pre(cur, wr, fr, pv);
    PG8_STAGE(PG8_SB(0, 0), cB, voffB); PG8_STAGE(PG8_SB(0, 1), cB + hstepB, voffB); PG8_STAGE(PG8_SA(0, 0), cA, voffA); PG8_STAGE(PG8_SA(0, 1), cA + hstepA, voffA);
    PG8_STAGE(PG8_SB(1, 0), cB + kstep, voffB); PG8_STAGE(PG8_SA(1, 0), cA + kstep, voffA); PG8_STAGE(PG8_SB(1, 1), cB + hstepB + kstep, voffB);
    if (wr == 1) PG8_BAR;
    PG8_WAIT_V(8); PG8_BAR;
    PG8_WAIT_V(6); PG8_BAR;
    for (;;) {
        const bool has_next = S.next(ui + 1, nxt);
        const char* nA = has_next ? nxt.a : cA; const char* nB = has_next ? nxt.b : cB;
#define PG8_WAIT_V8R(flag) asm volatile("s_waitcnt vmcnt(24)\n\ts_cmp_eq_u32 %0, 0\n\ts_cbranch_scc0 .Lpg8r_%=\n\ts_waitcnt vmcnt(8)\n.Lpg8r_%=:" :: "s"(flag) : "memory", "scc")
        for (int t = 0; t < nt; t += 2) {
            const bool last = (t == nt - 2);
            const int relax = __builtin_amdgcn_readfirstlane((int)(t == 0) & (int)(ui > 0));
            const char* a1 = cA + (size_t)(t + 1) * kstep;
            const char* a2 = last ? nA : cA + (size_t)(t + 2) * kstep; const char* b2 = last ? nB : cB + (size_t)(t + 2) * kstep;
            const char* a3 = a2 + kstep; const char* b3 = b2 + kstep;
            PG8_LDB(B0, 0, 0); PG8_LDB(B1, 0, 1); PG8_SCHED; PG8_LDA(At, 0, 0); PG8_STAGE(PG8_SA(1, 1), a1 + hstepA, voffA);
            PG8_WAIT_V8R(relax); PG8_WAIT_L(0); PG8_BAR; PG8_MMA(0, 0, At, B0); PG8_MMA(0, 1, At, B1); PG8_BAR; PG8_SCHED;
            PG8_LDA(At, 0, 1); PG8_STAGE(PG8_SB(0, 0), b2, voffB); PG8_STAGE(PG8_SB(0, 1), b2 + hstepB, voffB); PG8_STAGE(PG8_SA(0, 0), a2, voffA);
            PG8_WAIT_V8R(relax); PG8_WAIT_L(0); PG8_BAR; PG8_MMA(1, 0, At, B0); PG8_MMA(1, 1, At, B1); PG8_BAR; PG8_SCHED;
            PG8_LDB(B0, 1, 0); PG8_LDB(B1, 1, 1); PG8_SCHED; PG8_LDA(At, 1, 0); PG8_STAGE(PG8_SA(0, 1), a2 + hstepA, voffA);
            PG8_WAIT_V(8); PG8_WAIT_L(0); PG8_BAR; PG8_MMA(0, 0, At, B0); PG8_MMA(0, 1, At, B1); PG8_BAR; PG8_SCHED;
            PG8_LDA(At, 1, 1); PG8_STAGE(PG8_SB(1, 0), b3, voffB); PG8_STAGE(PG8_SB(1, 1), b3 + hstepB, voffB); PG8_STAGE(PG8_SA(1, 0), a3, voffA);
            PG8_WAIT_V(8); PG8_WAIT_L(0); PG8_BAR; PG8_MMA(1, 0, At, B0); PG8_MMA(1, 1, At, B1); PG8_BAR; PG8_SCHED;
        }
#undef PG8_WAIT_V8R
        if (wr == 0) PG8_BAR;
        E(acc, cur, wr, wc, fr, fq, pv);
        if (!has_next) break;
#pragma unroll
        for (int a = 0; a < 2; ++a)
#pragma unroll
            for (int b = 0; b < 2; ++b)
#pragma unroll
                for (int m = 0; m < 4; ++m)
#pragma unroll
                    for (int n = 0; n < 2; ++n) acc[a][b][m][n] = (f32x4){0.f, 0.f, 0.f, 0.f};
        cur = nxt; cA = nA; cB = nB; ++ui;
        E.pre(cur, wr, fr, pv);
        if (wr == 1) PG8_BAR;
    }
    PG8_WAIT_V(0);
    PG8_BAR;
#undef PG8_SA
#undef PG8_SB
#undef PG8_STAGE
#undef PG8_LDA
#undef PG8_LDB
#undef PG8_MMA
#undef PG8_WAIT_V
#undef PG8_WAIT_L
#undef PG8_BAR
#undef PG8_SCHED
}
}

namespace att {
constexpr int NW = 8, QBLK = 32, KVBLK = 64, DV = 128;
constexpr int SHM_V = KVBLK * DV * 2;
template <int DQK> struct Geo { static constexpr int KROW = DQK * 2, SHM_K = KVBLK * KROW, NQ = DQK / 16, CPR = DQK / 8  , NKI = SHM_K / 8192  ; };
template <int DQK> __device__ __forceinline__ int kswz(int row) { return DQK == 192 ? ((row >> 1) & 7) : (row & 15); }
#define SBAR() __builtin_amdgcn_sched_barrier(0)
__device__ __forceinline__ int crow(int r, int hi) { return (r & 3) + 8 * (r >> 2) + 4 * hi; }
template <bool FIRST>
__device__ __forceinline__ void partialSM(f32x16& p0, f32x16& p1, f32x16& negm, float& alpha, float& l_reg) {
    constexpr float THR2 = 8.f * 1.4426950408889634f;
    float pmax = p0[0];
#pragma unroll
    for (int r = 1; r < 16; ++r) pmax = fmaxf(pmax, p0[r]);
#pragma unroll
    for (int r = 0; r < 16; ++r) pmax = fmaxf(pmax, p1[r]);
    { auto rr = __builtin_amdgcn_permlane32_swap(__float_as_uint(pmax), __float_as_uint(pmax), false, false);
      pmax = fmaxf(__uint_as_float(rr[0]), __uint_as_float(rr[1])); }
    if (!FIRST && __builtin_expect(__all(pmax <= THR2), 1)) { alpha = 1.f; }
    else { const float d = FIRST ? pmax : fmaxf(pmax, 0.f); alpha = FIRST ? 1.f : __builtin_amdgcn_exp2f(-d); if (!FIRST) l_reg *= alpha;
#pragma unroll
        for (int r = 0; r < 16; ++r) { p0[r] -= d; p1[r] -= d; negm[r] -= d; } }
#pragma unroll
    for (int r = 0; r < 16; ++r) p0[r] = __builtin_amdgcn_exp2f(p0[r]);
}
__device__ __forceinline__ void finishSM(f32x16& p0, f32x16& p1, float& l_reg, bf16x8& pa0, bf16x8& pa1, bf16x8& pa2, bf16x8& pa3) {
#pragma unroll
    for (int r = 0; r < 16; ++r) p1[r] = __builtin_amdgcn_exp2f(p1[r]);
    float ps = 0;
#pragma unroll
    for (int r = 0; r < 16; ++r) ps += p0[r];
#pragma unroll
    for (int r = 0; r < 16; ++r) ps += p1[r];
    { auto rr = __builtin_amdgcn_permlane32_swap(__float_as_uint(ps), __float_as_uint(ps), false, false);
      ps = __uint_as_float(rr[0]) + __uint_as_float(rr[1]); }
    l_reg += ps;
#define PK4(P, BASE, OUT) do { u32x4 w; w[0] = cvt_pk_bf16(P[BASE + 0], P[BASE + 1]); w[1] = cvt_pk_bf16(P[BASE + 2], P[BASE + 3]);   \
    w[2] = cvt_pk_bf16(P[BASE + 4], P[BASE + 5]); w[3] = cvt_pk_bf16(P[BASE + 6], P[BASE + 7]);     \
    { auto r0 = __builtin_amdgcn_permlane32_swap(w[0], w[2], false, false); w[0] = r0[0]; w[2] = r0[1]; } \
    { auto r1 = __builtin_amdgcn_permlane32_swap(w[1], w[3], false, false); w[1] = r1[0]; w[3] = r1[1]; } \
    OUT = *reinterpret_cast<bf16x8*>(&w); } while (0)
    PK4(p0, 0, pa0); PK4(p0, 8, pa1); PK4(p1, 0, pa2); PK4(p1, 8, pa3);
#undef PK4
}
template <int DQK> struct KAddr { static constexpr int KB = DQK == 192 ? 4 : 8; };
template <int DQK>
__device__ __forceinline__ void qkt(f32x16& p0, f32x16& p1, const char* Kt  , const int kx  , const bf16x8* qr, const f32x16& negm) {
    constexpr int NQ = Geo<DQK>::NQ, RB = 32 * Geo<DQK>::KROW, KB = KAddr<DQK>::KB;
#define KOFF(d0) (((32 * ((d0) % KB)) ^ kx) + ((d0) / KB) * 32 * KB)
    const char* Ksl = Kt;
    bf16x8 f0[2], f1[2];
    f0[0] = *reinterpret_cast<const bf16x8*>(Ksl + KOFF(0)); f1[0] = *reinterpret_cast<const bf16x8*>(Ksl + KOFF(0) + RB);
    __builtin_amdgcn_sched_group_barrier(0x100, 2, 0);
#pragma unroll
    for (int d0 = 0; d0 < NQ; ++d0) {
        if (d0 + 1 < NQ) { f0[(d0 + 1) & 1] = *reinterpret_cast<const bf16x8*>(Ksl + KOFF(d0 + 1)); f1[(d0 + 1) & 1] = *reinterpret_cast<const bf16x8*>(Ksl + KOFF(d0 + 1) + RB); }
        if (d0 == 0) {
            asm("v_mfma_f32_32x32x16_bf16 %0, %1, %2, %3" : "=&v"(p0) : "v"(f0[0]), "v"(qr[0]), "v"(negm));
            asm("v_mfma_f32_32x32x16_bf16 %0, %1, %2, %3" : "=&v"(p1) : "v"(f1[0]), "v"(qr[0]), "v"(negm));
        } else {
            p0 = __builtin_amdgcn_mfma_f32_32x32x16_bf16(f0[d0 & 1], qr[d0], p0, 0, 0, 0);
            p1 = __builtin_amdgcn_mfma_f32_32x32x16_bf16(f1[d0 & 1], qr[d0], p1, 0, 0, 0); }
        __builtin_amdgcn_sched_group_barrier(0x100, 2, 0); __builtin_amdgcn_sched_group_barrier(0x8, 2, 0); }
#undef KOFF
}
__device__ __forceinline__ int v_st(int k, int c) { const int kk = (k & ~0xC) | ((k & 4) << 1) | ((k & 8) >> 1); return ((kk >> 3) * 4 + (c >> 5)) * 512 + ((kk & 7) * 32 + (c & 31)) * 2; }
__device__ __forceinline__ int v_rd_base(int lane) { return ((lane & 3) << 3) | (((lane >> 2) & 3) << 6) | (((lane >> 4) & 1) << 5) | (((lane >> 5) & 1) << 8); }
constexpr int v_rd_off(int d0, int ks, int half) { return d0 * 512 + ks * 4096 + half * 2048; }
template <int OFF> __device__ __forceinline__ s16x4 tr_read(int vb) {
    s16x4 r; asm volatile("ds_read_b64_tr_b16 %0, %1 offset:%2" : "=&v"(r) : "v"(vb), "i"(OFF) : "memory"); return r;
}
template <int D0> __device__ __forceinline__ void pv_one(f32x16& od, int vb, bf16x8 pa0, bf16x8 pa1, bf16x8 pa2, bf16x8 pa3) {
    const s16x4 l0 = tr_read<v_rd_off(D0, 0, 0)>(vb), h0 = tr_read<v_rd_off(D0, 0, 1)>(vb), l1 = tr_read<v_rd_off(D0, 1, 0)>(vb), h1 = tr_read<v_rd_off(D0, 1, 1)>(vb);
    const s16x4 l2 = tr_read<v_rd_off(D0, 2, 0)>(vb), h2 = tr_read<v_rd_off(D0, 2, 1)>(vb), l3 = tr_read<v_rd_off(D0, 3, 0)>(vb), h3 = tr_read<v_rd_off(D0, 3, 1)>(vb);
    asm volatile("s_waitcnt lgkmcnt(0)" ::: "memory"); SBAR();
#define PK(L, H) (bf16x8){L[0], L[1], L[2], L[3], H[0], H[1], H[2], H[3]}
    od = __builtin_amdgcn_mfma_f32_32x32x16_bf16(pa0, PK(l0, h0), od, 0, 0, 0);
    od = __builtin_amdgcn_mfma_f32_32x32x16_bf16(pa1, PK(l1, h1), od, 0, 0, 0);
    od = __builtin_amdgcn_mfma_f32_32x32x16_bf16(pa2, PK(l2, h2), od, 0, 0, 0);
    od = __builtin_amdgcn_mfma_f32_32x32x16_bf16(pa3, PK(l3, h3), od, 0, 0, 0);
#undef PK
}
__device__ __forceinline__ void pv_d0(f32x16* o, int vb, bf16x8 pa0, bf16x8 pa1, bf16x8 pa2, bf16x8 pa3) {
    pv_one<0>(o[0], vb, pa0, pa1, pa2, pa3); pv_one<1>(o[1], vb, pa0, pa1, pa2, pa3); pv_one<2>(o[2], vb, pa0, pa1, pa2, pa3); pv_one<3>(o[3], vb, pa0, pa1, pa2, pa3);
}

template <int DQK, bool ROPE>
__device__ __forceinline__ void attn_unit(const bf16* __restrict__ Qb, int ldq, const bf16* __restrict__ Kh, int ldk, const bf16* __restrict__ Vh, int ldv,
                                          bf16* __restrict__ Ob, int ldo, int nkeys, const float* __restrict__ qg, const float* __restrict__ ropec, const float* __restrict__ ropes,
                                          int pos0, const float sm_scale, const float* __restrict__ qrs, char* lds, const int widS) {
    using G = Geo<DQK>; constexpr int NQ = G::NQ;
    const int tid = opaque_tid(widS), wid = __builtin_amdgcn_readfirstlane(tid >> 6), lane = tid & 63, r32 = lane & 31, hi = lane >> 5;
    char* V_lds = lds; char* K_lds = lds + 3 * SHM_V;
    float* wsp = (float*)(lds + 3 * SHM_V + 2 * G::SHM_K) + wid * 64; float* li_l = wsp; float* al_l = wsp + 32;
    const float C = sm_scale * 1.4426950408889634f;
    float l_reg = 0; f32x16 o[4] = {}; f32x16 negm = {}; bf16x8 qr[NQ];
    {
        const bf16* Qw = Qb + (long)(wid * QBLK + r32) * ldq + hi * 8;
        u32x4 raw[NQ]; float ssq = 0.f;
#pragma unroll
        for (int d0 = 0; d0 < NQ; ++d0) { raw[d0] = *reinterpret_cast<const u32x4*>(Qw + d0 * 16);
#pragma unroll
            for (int j = 0; j < 4; ++j) { const float a = bflo(raw[d0][j]), b = bfhi(raw[d0][j]); ssq += a * a + b * b; } }
        ssq += shx(ssq, 32, lane);
        const float qs_ = qrs ? qrs[wid * QBLK + r32] : 1.f;
        const float rstd = C * qs_ * rsqrtf(qs_ * qs_ * ssq * (1.0f / DQK) + EPS);
        constexpr int NPLAIN = ROPE ? 8 : NQ;
#pragma unroll
        for (int d0 = 0; d0 < NPLAIN; ++d0) { const f32x4 g0 = *reinterpret_cast<const f32x4*>(qg + d0 * 16 + hi * 8), g1 = *reinterpret_cast<const f32x4*>(qg + d0 * 16 + hi * 8 + 4);
            u32x4 w;
#pragma unroll
            for (int j = 0; j < 4; ++j) { const float gl = j < 2 ? g0[2 * j] : g1[2 * j - 4], gh = j < 2 ? g0[2 * j + 1] : g1[2 * j - 3]; w[j] = cvt_pk_bf16(bflo(raw[d0][j]) * rstd * gl, bfhi(raw[d0][j]) * rstd * gh); }
            qr[d0] = *reinterpret_cast<bf16x8*>(&w); }
        if constexpr (ROPE) {
            const long pos = pos0 + wid * QBLK + r32;
#pragma unroll
            for (int dd = 0; dd < 2; ++dd) { const int d0 = 8 + dd, i0 = dd * 16 + hi * 8;
                float cs[8], sn[8], ga[8], gb[8];
                { const f32x4 c0 = *reinterpret_cast<const f32x4*>(ropec + pos * 32 + i0), c1 = *reinterpret_cast<const f32x4*>(ropec + pos * 32 + i0 + 4);
                  const f32x4 s0 = *reinterpret_cast<const f32x4*>(ropes + pos * 32 + i0), s1 = *reinterpret_cast<const f32x4*>(ropes + pos * 32 + i0 + 4);
                  const f32x4 a0 = *reinterpret_cast<const f32x4*>(qg + d0 * 16 + hi * 8), a1 = *reinterpret_cast<const f32x4*>(qg + d0 * 16 + hi * 8 + 4);
                  const f32x4 b0 = *reinterpret_cast<const f32x4*>(qg + (d0 + 2) * 16 + hi * 8), b1 = *reinterpret_cast<const f32x4*>(qg + (d0 + 2) * 16 + hi * 8 + 4);
#pragma unroll
                  for (int j = 0; j < 4; ++j) { cs[j] = c0[j]; cs[4 + j] = c1[j]; sn[j] = s0[j]; sn[4 + j] = s1[j]; ga[j] = a0[j]; ga[4 + j] = a1[j]; gb[j] = b0[j]; gb[4 + j] = b1[j]; } }
                u32x4 w1, w2;
#pragma unroll
                for (int j = 0; j < 4; ++j) {
                    const float x1l = bflo(raw[d0][j]) * rstd * ga[2 * j], x1h = bfhi(raw[d0][j]) * rstd * ga[2 * j + 1];
                    const float x2l = bflo(raw[d0 + 2][j]) * rstd * gb[2 * j], x2h = bfhi(raw[d0 + 2][j]) * rstd * gb[2 * j + 1];
                    w1[j] = cvt_pk_bf16(x1l * cs[2 * j] - x2l * sn[2 * j], x1h * cs[2 * j + 1] - x2h * sn[2 * j + 1]);
                    w2[j] = cvt_pk_bf16(x1l * sn[2 * j] + x2l * cs[2 * j], x1h * sn[2 * j + 1] + x2h * cs[2 * j + 1]); }
                qr[d0] = *reinterpret_cast<bf16x8*>(&w1); qr[d0 + 2] = *reinterpret_cast<bf16x8*>(&w2); }
        }
    }
    const int vb0 = (int)(uintptr_t)V_lds + v_rd_base(lane);
    unsigned kgo[G::NKI], vgo[1];
#pragma unroll
    for (int t = 0; t < G::NKI; ++t) { const int q = (wid * G::NKI + t) * 64 + lane, row = q / G::CPR, pc = q % G::CPR; kgo[t] = (unsigned)(row * ldk * 2 + ((pc ^ kswz<DQK>(row)) * 16)); }
#pragma unroll
    for (int t = 0; t < 1; ++t) { const int q = (wid * 2 + t) * 64 + lane, sub = q >> 5, within = q & 31;   const int kk = ((sub >> 2) << 3) | (within >> 2), cc = (sub & 3) * 32 + (within & 3) * 8;
        const int key = (kk & ~0xC) | ((kk & 4) << 1) | ((kk & 8) >> 1); vgo[t] = (unsigned)(key * ldv * 2 + cc * 2); }
    const int koffs = r32 * G::KROW + (hi ^ kswz<DQK>(r32)) * 16;
    const char* Kg = (const char*)Kh; const char* Vg = (const char*)Vh;
#define SDMA(tile, kslot, vslot) do { const char* kb_ = Kg + (size_t)(tile) * KVBLK * ldk * 2; const char* vb_ = Vg + (size_t)(tile) * KVBLK * ldv * 2; \
    asm volatile("" : "+s"(kb_), "+s"(vb_));     \
    _Pragma("unroll") for (int t_ = 0; t_ < G::NKI; ++t_) { unsigned ko_ = kgo[t_]; asm volatile("" : "+v"(ko_)); __builtin_amdgcn_global_load_lds((const unsigned*)(kb_ + ko_), (LAS unsigned*)(K_lds + (kslot) * G::SHM_K + (wid * G::NKI + t_) * 1024), 16, 0, 0); } \
    _Pragma("unroll") for (int t_ = 0; t_ < 2; ++t_) { unsigned vo_ = vgo[0] + t_ * 128; asm volatile("" : "+v"(vo_)); __builtin_amdgcn_global_load_lds((const unsigned*)(vb_ + vo_), (LAS unsigned*)(V_lds + (vslot) * SHM_V + (wid * 2 + t_) * 1024), 16, 0, 0); } } while (0)
#define RESC(a) do { if (__any((a) < 1.f)) { if (hi == 0) al_l[r32] = (a); asm volatile("s_waitcnt lgkmcnt(0)" ::: "memory"); \
    _Pragma("unroll") for (int d = 0; d < 4; ++d) _Pragma("unroll") for (int r = 0; r < 16; ++r) o[d][r] *= al_l[crow(r, hi)]; } } while (0)
    f32x16 pA0, pA1, pB0, pB1; bf16x8 pa0, pa1, pa2, pa3; const int NT = nkeys / KVBLK;
    const char* Ksl = K_lds;
    SDMA(0, 0, 0); __syncthreads();
    SDMA(1, 1, 1);
    qkt<DQK>(pA0, pA1, Ksl, koffs, qr, negm); { float al0; partialSM<true>(pA0, pA1, negm, al0, l_reg); }
    __syncthreads();
    int vs = 0;
    for (int j = 1; j + 1 < NT; j += 2) {
        const int v1 = vs == 2 ? 0 : vs + 1, v2 = v1 == 2 ? 0 : v1 + 1;
        SDMA(j + 1, 0, v2);
        SBAR(); qkt<DQK>(pB0, pB1, Ksl + G::SHM_K, koffs, qr, negm);
        finishSM(pA0, pA1, l_reg, pa0, pa1, pa2, pa3); SBAR();
        pv_d0(o, vb0 + vs * SHM_V, pa0, pa1, pa2, pa3); { float al_; partialSM<false>(pB0, pB1, negm, al_, l_reg); RESC(al_); } __syncthreads();
        const int v3 = v2 == 2 ? 0 : v2 + 1;
        SDMA(j + 2, 1, v3);
        SBAR(); qkt<DQK>(pA0, pA1, Ksl, koffs, qr, negm);
        finishSM(pB0, pB1, l_reg, pa0, pa1, pa2, pa3); SBAR();
        pv_d0(o, vb0 + v1 * SHM_V, pa0, pa1, pa2, pa3); { float al_; partialSM<false>(pA0, pA1, negm, al_, l_reg); RESC(al_); } __syncthreads();
        vs = v2;
    }
    {   const int v1 = vs == 2 ? 0 : vs + 1;
        SBAR(); qkt<DQK>(pB0, pB1, Ksl + G::SHM_K, koffs, qr, negm);
        finishSM(pA0, pA1, l_reg, pa0, pa1, pa2, pa3); SBAR();
        pv_d0(o, vb0 + vs * SHM_V, pa0, pa1, pa2, pa3); { float al_; partialSM<false>(pB0, pB1, negm, al_, l_reg); RESC(al_); }
        finishSM(pB0, pB1, l_reg, pa0, pa1, pa2, pa3); SBAR();
        pv_d0(o, vb0 + v1 * SHM_V, pa0, pa1, pa2, pa3); }
    if (hi == 0) li_l[r32] = l_reg; asm volatile("s_waitcnt lgkmcnt(0)" ::: "memory");
    const int lane_e = opaque_lane(), hi_e = lane_e >> 5;
    float rli[16];
#pragma unroll
    for (int r = 0; r < 16; ++r) rli[r] = __builtin_amdgcn_rcpf(li_l[crow(r, hi_e)]);
    bf16* Ow = Ob + (long)(wid * QBLK) * ldo;
    char* ost = lds + 3 * SHM_V + 2 * G::SHM_K + 2048 + wid * 4608;
#pragma unroll
    for (int h = 0; h < 2; ++h) {
#pragma unroll
        for (int r = 0; r < 16; ++r) { const unsigned w = cvt_pk_bf16(o[2 * h][r] * rli[r], o[2 * h + 1][r] * rli[r]); char* q = ost + crow(r, hi_e) * 144 + (lane_e & 31) * 2;
            *(unsigned short*)q = (unsigned short)(w & 0xffffu); *(unsigned short*)(q + 64) = (unsigned short)(w >> 16); }
        asm volatile("s_waitcnt lgkmcnt(0)" ::: "memory");
#pragma unroll
        for (int i = 0; i < 4; ++i) { const int row = (lane_e >> 3) + 8 * i; const u32x4 v = *(const u32x4*)(ost + row * 144 + (lane_e & 7) * 16);
            *(u32x4*)(Ow + (long)row * ldo + h * 64 + (lane_e & 7) * 8) = v; }
    }
    __syncthreads();
#undef SDMA
#undef RESC
}
}

#define XB_TMO      128
#define XB_XCNT(j)  (256  + 64 * (j))
#define XB_XSUB(j)  (1280 + 64 * (j))
#define XB_XGEN(j)  (2304 + 64 * (j))
#define XB_TOP      3328
#define XB_TOPGEN   3392
#define XCD_BAR_WORDS 3456
#define XB_SPIN_CAP (1u << 20)
__device__ __forceinline__ unsigned xb_ld(unsigned* p)              { return __hip_atomic_load(p, __ATOMIC_RELAXED, __HIP_MEMORY_SCOPE_AGENT); }
__device__ __forceinline__ unsigned xb_add(unsigned* p, unsigned v) { return __hip_atomic_fetch_add(p, v, __ATOMIC_RELAXED, __HIP_MEMORY_SCOPE_AGENT); }
__device__ __forceinline__ unsigned xb_xcc_id() { return (unsigned)__builtin_amdgcn_s_getreg((3 << 11) | 20) & 0xFu; }
#define XB_SPIN(cond, bar) do { unsigned _sp = 0; while (cond) { __builtin_amdgcn_s_sleep(1); \
    if ((++_sp & 255u) == 0u) { if (xb_ld(&(bar)[XB_TMO])) break; if (_sp > XB_SPIN_CAP) { atomicAdd(&(bar)[XB_TMO], 1u); break; } } } } while (0)
struct XcdBarrier { unsigned* bar; unsigned x; volatile LAS unsigned* st; int w; };
__device__ __forceinline__ XcdBarrier xcd_barrier_post(unsigned* bar, volatile LAS unsigned* st) {
    XcdBarrier b; b.bar = bar; b.x = xb_xcc_id(); b.st = st;
    if (threadIdx.x == 0) (void)xb_add(&bar[XB_XCNT(b.x)], 1u);
    return b;
}
__device__ __forceinline__ void xcd_barrier_complete(unsigned* bar, unsigned x, unsigned& nloc, unsigned& nx) {
    const unsigned G = gridDim.x * gridDim.y * gridDim.z;
    unsigned sum, cnt, mine, sp = 0u;
    for (;;) {
        sum = 0u; cnt = 0u; mine = 0u;
#pragma unroll
        for (unsigned j = 0; j < 16; ++j) { const unsigned c = xb_ld(&bar[XB_XCNT(j)]); sum += c; cnt += (c > 0u) ? 1u : 0u; mine = (j == x) ? c : mine; }
        if (sum == G) break;
        __builtin_amdgcn_s_sleep(1);
        if ((++sp & 255u) == 0u) { if (xb_ld(&bar[XB_TMO])) break; if (sp > XB_SPIN_CAP) { atomicAdd(&bar[XB_TMO], 1u); break; } }
    }
    nloc = mine > 0u ? mine : 1u; nx = cnt > 0u ? cnt : 1u;
}
__device__ __forceinline__ void xcd_barrier(const XcdBarrier& b) {
    asm volatile("s_waitcnt vmcnt(0)" ::: "memory");
    __syncthreads();
    if (opaque_tid(b.w) == 0) {
        unsigned* bar = b.bar;
        __builtin_amdgcn_s_waitcnt(0);
        unsigned nloc = b.st[0], nx = b.st[1];
        if (nloc == 0u) { xcd_barrier_complete(bar, b.x, nloc, nx); b.st[0] = nloc; b.st[1] = nx; }
        const unsigned old = xb_add(&bar[XB_XSUB(b.x)], 1u);
        const unsigned gen = old / nloc;
        if (old + 1u == (gen + 1u) * nloc) {
            __builtin_amdgcn_fence(__ATOMIC_RELEASE, "agent");
            asm volatile("s_waitcnt vmcnt(0)" ::: "memory");
            const unsigned og = xb_add(&bar[XB_TOP], 1u);
            const unsigned tg = og / nx;
            if (og + 1u == (tg + 1u) * nx) xb_add(&bar[XB_TOPGEN], 1u);
            else XB_SPIN(xb_ld(&bar[XB_TOPGEN]) == tg, bar);
            __builtin_amdgcn_fence(__ATOMIC_ACQUIRE, "agent");
            xb_add(&bar[XB_XGEN(b.x)], 1u);
            asm volatile("s_waitcnt vmcnt(0)" ::: "memory");
        } else {
            XB_SPIN(xb_ld(&bar[XB_XGEN(b.x)]) == gen, bar);
            __builtin_amdgcn_fence(__ATOMIC_ACQUIRE, "agent");
            asm volatile("s_waitcnt vmcnt(0)" ::: "memory");
        }
    }
    __syncthreads();
}

template <int MODE>
__device__ __forceinline__ void transpose_item(const float* __restrict__ W, int K, int N, bf16* __restrict__ WT, const float* __restrict__ gk, LAS float* scr, int item, int lane) {
    const int nblk = N / 32, kb = item / nblk, nb = item % nblk, k0 = 128 * kb, n0 = 32 * nb;
    const int kq = lane >> 3, n4 = (lane & 7) * 4, c = lane & 7; f32x4 w[16];
#pragma unroll
    for (int i = 0; i < 16; ++i) w[i] = *(const f32x4*)(W + (size_t)(k0 + kq + 8 * i) * N + n0 + n4);
    if (gk) {
#pragma unroll
        for (int i = 0; i < 16; ++i) { const float g = gk[k0 + kq + 8 * i]; w[i] = w[i] * g; } }
#pragma unroll
    for (int h = 0; h < 2; ++h) {
#pragma unroll
        for (int i = 0; i < 8; ++i) { LAS float* d = scr + (kq + 8 * i) * 33 + n4; d[0] = w[8 * h + i].x; d[1] = w[8 * h + i].y; d[2] = w[8 * h + i].z; d[3] = w[8 * h + i].w; }
        LDS_WAIT(); asm volatile("" ::: "memory");
#pragma unroll
        for (int j = 0; j < 4; ++j) { const int n = (lane >> 3) + 8 * j; const LAS float* sp = scr + (8 * c) * 33 + n;
            u32x4 o; o.x = cvt_pk_bf16(sp[0 * 33], sp[1 * 33]); o.y = cvt_pk_bf16(sp[2 * 33], sp[3 * 33]); o.z = cvt_pk_bf16(sp[4 * 33], sp[5 * 33]); o.w = cvt_pk_bf16(sp[6 * 33], sp[7 * 33]);
            int nn = n0 + n; if (MODE == 1) { const int hh = nn >> 8, jj = nn & 255; nn = hh * 320 + (jj < 128 ? jj : jj + 64); }
            *(u32x4*)(WT + (size_t)nn * K + k0 + 64 * h + 8 * c) = o; }
        LDS_WAIT(); asm volatile("" ::: "memory");
    }
}
__device__ __forceinline__ void rms_row_to_bf16(const float* __restrict__ xrow, const float* __restrict__ g, bf16* __restrict__ orow, int lane) {
    const f32x4* xr = (const f32x4*)xrow + lane; f32x4 v[8]; float s = 0.f;
#pragma unroll
    for (int j = 0; j < 8; ++j) { v[j] = xr[64 * j]; s += (v[j].x * v[j].x + v[j].y * v[j].y) + (v[j].z * v[j].z + v[j].w * v[j].w); }
    const float r = rsqrtf(wave_sum(s, lane) * (1.f / D) + EPS);
    u32x2* o8 = (u32x2*)orow + lane;
#pragma unroll
    for (int j = 0; j < 8; ++j) { const f32x4 gg = ((const f32x4*)g)[lane + 64 * j]; u32x2 w; w.x = cvt_pk_bf16(v[j].x * r * gg.x, v[j].y * r * gg.y); w.y = cvt_pk_bf16(v[j].z * r * gg.z, v[j].w * r * gg.w); o8[64 * j] = w; }
}

template <int NK>
__device__ __forceinline__ void hgrn_scan_item(const bf16* __restrict__ Zv, int row0, int L, int hh, int dir, int kbase, const float* __restrict__ lbl, bf16* __restrict__ Oo,
                                               LAS unsigned char* lds, const unsigned char* lds_gen, int tid, int lane, int wave) {
    constexpr int NPAIR = NK / 2, NPART = 256 / NPAIR, SPT = 64 / NPART, QROW = NK * 2 + 16, ND0 = NK / 16, NKB = NK / 32;
    constexpr int O_KT = 64 * QROW, O_KTT = 128 * QROW, O_VL = 128 * QROW + NK * 144, O_FAC = O_VL + 16384, BUF = O_FAC + 3 * NK * 4;
    static_assert(2 * BUF + NPART * NK * 4 <= 147328, "HGRN LDS");
    LAS float* TOT = (LAS float*)(lds + 2 * BUF);
    const int nchunk = L >> 6;
#define HG_POS(n) (dir ? (L - 1 - (n)) : (n))
    if (wave >= 4) {
        const int ptid = tid - 256, kp = ptid % NPAIR, part = ptid / NPAIR, vr = ptid >> 4, sc = (ptid & 15) * 8;
        const int zc = hh * 128 + kbase + 2 * kp;
        float lb0, lb1; { const float* lg = lbl + dir * 2048 + zc; const f32x2 l0 = *(const f32x2*)lg, l1 = *(const f32x2*)(lg + 4096), l2 = *(const f32x2*)(lg + 8192), l3 = *(const f32x2*)(lg + 12288);
            { const float mx = fmaxf(fmaxf(l0.x, l1.x), fmaxf(l2.x, l3.x)); const float e0 = __expf(l0.x - mx), e1 = __expf(l1.x - mx), e2 = __expf(l2.x - mx), e3 = __expf(l3.x - mx); lb0 = e1 / (e0 + e1 + e2 + e3); }
            { const float mx = fmaxf(fmaxf(l0.y, l1.y), fmaxf(l2.y, l3.y)); const float e0 = __expf(l0.y - mx), e1 = __expf(l1.y - mx), e2 = __expf(l2.y - mx), e3 = __expf(l3.y - mx); lb1 = e1 / (e0 + e1 + e2 + e3); } }
        int vst[4];
#pragma unroll
        for (int i = 0; i < 4; ++i) vst[i] = att::v_st(vr + 16 * i, sc);
        unsigned hq_[SPT], hz_[SPT]; bf16x8 rv[4];
#define HG_LOAD(ch) do { _Pragma("unroll") for (int i = 0; i < SPT; ++i) { const int n = (ch) * 64 + part * SPT + i; const bf16* zr = Zv + (size_t)(row0 + HG_POS(n)) * 10240 + zc; hq_[i] = *(const unsigned*)zr; hz_[i] = *(const unsigned*)(zr + 2048 + dir * 2048); } \
        _Pragma("unroll") for (int i = 0; i < 4; ++i) rv[i] = *(const bf16x8*)(Zv + (size_t)(row0 + HG_POS((ch) * 64 + vr + 16 * i)) * 10240 + 6144 + hh * 128 + sc); } while (0)
        HG_LOAD(0);
        for (int s = -1; s < nchunk; ++s) {
            const bool work = s + 1 < nchunk; LAS unsigned char* B = lds + ((s + 1) & 1) * BUF;
            float run0[SPT], run1[SPT], kk0[SPT], kk1[SPT]; unsigned qraw[SPT];
            if (work) {
                float a0 = 0.f, a1 = 0.f;
#pragma unroll
                for (int i = 0; i < SPT; ++i) { const float z0 = bflo(hz_[i]), z1 = bfhi(hz_[i]);
                    const float s0 = __builtin_amdgcn_rcpf(1.f + __expf(-z0)), s1 = __builtin_amdgcn_rcpf(1.f + __expf(-z1));
                    const float f0 = lb0 + (1.f - lb0) * s0, f1 = lb1 + (1.f - lb1) * s1;
                    kk0[i] = (1.f - lb0) * (1.f - s0); kk1[i] = (1.f - lb1) * (1.f - s1);
                    a0 += __logf(f0); a1 += __logf(f1); run0[i] = a0; run1[i] = a1; qraw[i] = hq_[i]; }
                *(LAS f32x2*)(TOT + part * NK + 2 * kp) = (f32x2){a0, a1};
#pragma unroll
                for (int i = 0; i < 4; ++i) *(LAS bf16x8*)(B + O_VL + vst[i]) = rv[i];
            }
            __syncthreads();
            if (work) {
                float base0 = 0.f, base1 = 0.f, rr0 = 0.f, rr1 = 0.f, bl0 = 0.f, bl1 = 0.f;
#pragma unroll
                for (int q = 0; q < NPART; ++q) { const f32x2 t = *(const LAS f32x2*)(TOT + q * NK + 2 * kp); if (q < part) { base0 += t.x; base1 += t.y; } if (q < NPART / 2) { rr0 += t.x; rr1 += t.y; } bl0 += t.x; bl1 += t.y; }
                base0 -= rr0; base1 -= rr1;
                unsigned kw0[SPT / 2], kw1[SPT / 2];
#pragma unroll
                for (int i = 0; i < SPT; i += 2) {
                    const float d00 = fminf(fmaxf(base0 + run0[i], -60.f), 60.f), d01 = fminf(fmaxf(base1 + run1[i], -60.f), 60.f);
                    const float d10 = fminf(fmaxf(base0 + run0[i + 1], -60.f), 60.f), d11 = fminf(fmaxf(base1 + run1[i + 1], -60.f), 60.f);
                    const float ka0 = kk0[i] * __expf(-d00), ka1 = kk1[i] * __expf(-d01), kb0 = kk0[i + 1] * __expf(-d10), kb1 = kk1[i + 1] * __expf(-d11);
                    const int st = part * SPT + i;
                    *(LAS unsigned*)(B + st * QROW + kp * 4) = cvt_pk_bf16(bflo(qraw[i]) * __expf(d00), bfhi(qraw[i]) * __expf(d01));
                    *(LAS unsigned*)(B + (st + 1) * QROW + kp * 4) = cvt_pk_bf16(bflo(qraw[i + 1]) * __expf(d10), bfhi(qraw[i + 1]) * __expf(d11));
                    *(LAS unsigned*)(B + O_KT + st * QROW + kp * 4) = cvt_pk_bf16(ka0, ka1);
                    *(LAS unsigned*)(B + O_KT + (st + 1) * QROW + kp * 4) = cvt_pk_bf16(kb0, kb1);
                    kw0[i >> 1] = cvt_pk_bf16(ka0, kb0); kw1[i >> 1] = cvt_pk_bf16(ka1, kb1); }
#pragma unroll
                for (int i = 0; i < SPT / 8; ++i) {
                    *(LAS u32x4*)(B + O_KTT + (2 * kp) * 144 + part * SPT * 2 + 16 * i) = (u32x4){kw0[4 * i], kw0[4 * i + 1], kw0[4 * i + 2], kw0[4 * i + 3]};
                    *(LAS u32x4*)(B + O_KTT + (2 * kp + 1) * 144 + part * SPT * 2 + 16 * i) = (u32x4){kw1[4 * i], kw1[4 * i + 1], kw1[4 * i + 2], kw1[4 * i + 3]}; }
                if (part == 0) { LAS float* FAC = (LAS float*)(B + O_FAC);
                    *(LAS f32x2*)(FAC + 2 * kp) = (f32x2){__expf(rr0), __expf(rr1)}; *(LAS f32x2*)(FAC + NK + 2 * kp) = (f32x2){__expf(bl0), __expf(bl1)}; *(LAS f32x2*)(FAC + 2 * NK + 2 * kp) = (f32x2){__expf(bl0 - rr0), __expf(bl1 - rr1)}; }
                if (s + 2 < nchunk) HG_LOAD(s + 2);
            }
            __syncthreads();
        }
#undef HG_LOAD
    } else {
        const int vb = wave, r32 = lane & 31, hi = lane >> 5;
        const int olane = (dir ? 63 - 4 * hi : 4 * hi) * (D * 2) + r32 * 2;
        f32x16 St[NKB];
#pragma unroll
        for (int i = 0; i < NKB; ++i) St[i] = f32x16{};
#define HG_PK(L_, H_) (bf16x8){L_[0], L_[1], L_[2], L_[3], H_[0], H_[1], H_[2], H_[3]}
#define HG_PK4(P_, BASE_, OUT_) do { unsigned a0_ = cvt_pk_bf16(P_[BASE_ + 0], P_[BASE_ + 1]), a1_ = cvt_pk_bf16(P_[BASE_ + 2], P_[BASE_ + 3]); \
    unsigned b0_ = cvt_pk_bf16(P_[BASE_ + 4], P_[BASE_ + 5]), b1_ = cvt_pk_bf16(P_[BASE_ + 6], P_[BASE_ + 7]); \
    auto r0_ = __builtin_amdgcn_permlane32_swap(a0_, b0_, false, false); auto r1_ = __builtin_amdgcn_permlane32_swap(a1_, b1_, false, false); \
    u32x4 w_ = {r0_[0], r1_[0], r0_[1], r1_[1]}; OUT_ = *reinterpret_cast<bf16x8*>(&w_); } while (0)
        for (int s = -1; s < nchunk; ++s) {
            LAS unsigned char* QT = lds + (s & 1) * BUF; LAS unsigned char* KT = QT + O_KT; LAS unsigned char* KTT = QT + O_KTT; LAS float* FAC = (LAS float*)(QT + O_FAC);
            bf16x8 vf[4]; f32x16 od0 = f32x16{}, od1 = f32x16{};
            if (s >= 0) {
                const int vbase = (int)(uintptr_t)(lds_gen + (s & 1) * BUF + O_VL) + att::v_rd_base(lane) + vb * 512;
                { const s16x4 l0 = att::tr_read<att::v_rd_off(0, 0, 0)>(vbase), h0 = att::tr_read<att::v_rd_off(0, 0, 1)>(vbase), l1 = att::tr_read<att::v_rd_off(0, 1, 0)>(vbase), h1 = att::tr_read<att::v_rd_off(0, 1, 1)>(vbase);
                  const s16x4 l2 = att::tr_read<att::v_rd_off(0, 2, 0)>(vbase), h2 = att::tr_read<att::v_rd_off(0, 2, 1)>(vbase), l3 = att::tr_read<att::v_rd_off(0, 3, 0)>(vbase), h3 = att::tr_read<att::v_rd_off(0, 3, 1)>(vbase);
                  asm volatile("s_waitcnt lgkmcnt(0)" ::: "memory"); __builtin_amdgcn_sched_barrier(0);
                  vf[0] = HG_PK(l0, h0); vf[1] = HG_PK(l1, h1); vf[2] = HG_PK(l2, h2); vf[3] = HG_PK(l3, h3); }
                {
                    f32x16 p0 = f32x16{};
#pragma unroll
                    for (int d0 = 0; d0 < ND0; ++d0) { const int cb = (d0 * 16 + hi * 8) * 2;
                        const bf16x8 a = *(const LAS bf16x8*)(KT + r32 * QROW + cb), b = *(const LAS bf16x8*)(QT + r32 * QROW + cb);
                        p0 = __builtin_amdgcn_mfma_f32_32x32x16_bf16(a, b, p0, 0, 0, 0); }
#pragma unroll
                    for (int r = 0; r < 16; ++r) if (att::crow(r, hi) > r32) p0[r] = 0.f;
                    bf16x8 pa0, pa1; HG_PK4(p0, 0, pa0); HG_PK4(p0, 8, pa1);
                    od0 = __builtin_amdgcn_mfma_f32_32x32x16_bf16(pa0, vf[0], od0, 0, 0, 0); od0 = __builtin_amdgcn_mfma_f32_32x32x16_bf16(pa1, vf[1], od0, 0, 0, 0); }
                {
                    f32x16 p0 = f32x16{}, p1 = f32x16{};
#pragma unroll
                    for (int d0 = 0; d0 < ND0; ++d0) { const int cb = (d0 * 16 + hi * 8) * 2;
                        const bf16x8 a0_ = *(const LAS bf16x8*)(KT + r32 * QROW + cb), a1_ = *(const LAS bf16x8*)(KT + (32 + r32) * QROW + cb), b = *(const LAS bf16x8*)(QT + (32 + r32) * QROW + cb);
                        p0 = __builtin_amdgcn_mfma_f32_32x32x16_bf16(a0_, b, p0, 0, 0, 0); p1 = __builtin_amdgcn_mfma_f32_32x32x16_bf16(a1_, b, p1, 0, 0, 0); }
#pragma unroll
                    for (int r = 0; r < 16; ++r) if (att::crow(r, hi) > r32) p1[r] = 0.f;
                    bf16x8 pa0, pa1, pa2, pa3; HG_PK4(p0, 0, pa0); HG_PK4(p0, 8, pa1); HG_PK4(p1, 0, pa2); HG_PK4(p1, 8, pa3);
                    od1 = __builtin_amdgcn_mfma_f32_32x32x16_bf16(pa0, vf[0], od1, 0, 0, 0); od1 = __builtin_amdgcn_mfma_f32_32x32x16_bf16(pa1, vf[1], od1, 0, 0, 0);
                    od1 = __builtin_amdgcn_mfma_f32_32x32x16_bf16(pa2, vf[2], od1, 0, 0, 0); od1 = __builtin_amdgcn_mfma_f32_32x32x16_bf16(pa3, vf[3], od1, 0, 0, 0); }
            }
            __syncthreads();
            if (s >= 0) {
#pragma unroll
                for (int kb = 0; kb < NKB; ++kb) {
                    float er[16];
#pragma unroll
                    for (int m = 0; m < 4; ++m) { const f32x4 e4 = *(const LAS f32x4*)(FAC + 32 * kb + 8 * m + 4 * hi); er[4 * m] = e4[0]; er[4 * m + 1] = e4[1]; er[4 * m + 2] = e4[2]; er[4 * m + 3] = e4[3]; }
#pragma unroll
                    for (int s2 = 0; s2 < 2; ++s2) {
                        u32x4 bw;
#pragma unroll
                        for (int j = 0; j < 4; ++j) bw[j] = cvt_pk_bf16(St[kb][8 * s2 + 2 * j] * er[8 * s2 + 2 * j], St[kb][8 * s2 + 2 * j + 1] * er[8 * s2 + 2 * j + 1]);
                        const bf16x8 bfr = *reinterpret_cast<bf16x8*>(&bw);
                        const int ko = (32 * kb + 16 * s2 + 4 * hi) * 2;
                        const u32x2 x0 = *(const LAS u32x2*)(QT + r32 * QROW + ko), x1 = *(const LAS u32x2*)(QT + r32 * QROW + ko + 16);
                        const u32x2 y0 = *(const LAS u32x2*)(QT + (32 + r32) * QROW + ko), y1 = *(const LAS u32x2*)(QT + (32 + r32) * QROW + ko + 16);
                        u32x4 aw0 = {x0[0], x0[1], x1[0], x1[1]}, aw1 = {y0[0], y0[1], y1[0], y1[1]};
                        od0 = __builtin_amdgcn_mfma_f32_32x32x16_bf16(*reinterpret_cast<bf16x8*>(&aw0), bfr, od0, 0, 0, 0);
                        od1 = __builtin_amdgcn_mfma_f32_32x32x16_bf16(*reinterpret_cast<bf16x8*>(&aw1), bfr, od1, 0, 0, 0); } }
                {   unsigned char* Ob = (unsigned char*)(Oo + (size_t)(row0 + (dir ? L - 64 - s * 64 : s * 64)) * D + hh * 128 + 32 * vb);
#define HG_ST(SG_) do { _Pragma("unroll") for (int r = 0; r < 16; r += 2) { constexpr int c0 = 0; const int cr = (r & 3) + 8 * (r >> 2) + c0;     \
                        const unsigned w0 = cvt_pk_bf16(od0[r], od0[r + 1]), w1 = cvt_pk_bf16(od1[r], od1[r + 1]); \
                        *(unsigned short*)(Ob + (unsigned)(ol_ + (SG_) * cr * (D * 2))) = (unsigned short)(w0 & 0xffffu); *(unsigned short*)(Ob + (unsigned)(ol_ + (SG_) * (cr + 1) * (D * 2))) = (unsigned short)(w0 >> 16); \
                        *(unsigned short*)(Ob + (unsigned)(ol_ + (SG_) * (cr + 32) * (D * 2))) = (unsigned short)(w1 & 0xffffu); *(unsigned short*)(Ob + (unsigned)(ol_ + (SG_) * (cr + 33) * (D * 2))) = (unsigned short)(w1 >> 16); } } while (0)
                    int ol_ = olane; asm volatile("" : "+v"(ol_));
                    if (dir) HG_ST(-1); else HG_ST(1);
#undef HG_ST
                }
#pragma unroll
                for (int kb = 0; kb < NKB; ++kb) {
                    f32x16 U = f32x16{};
#pragma unroll
                    for (int ks = 0; ks < 4; ++ks) { const bf16x8 a = *(const LAS bf16x8*)(KTT + (32 * kb + r32) * 144 + (16 * ks + 8 * hi) * 2); U = __builtin_amdgcn_mfma_f32_32x32x16_bf16(a, vf[ks], U, 0, 0, 0); }
#pragma unroll
                    for (int m = 0; m < 4; ++m) { const f32x4 el = *(const LAS f32x4*)(FAC + NK + 32 * kb + 8 * m + 4 * hi), elr = *(const LAS f32x4*)(FAC + 2 * NK + 32 * kb + 8 * m + 4 * hi);
#pragma unroll
                        for (int e = 0; e < 4; ++e) St[kb][4 * m + e] = el[e] * St[kb][4 * m + e] + elr[e] * U[4 * m + e]; } }
            }
            __syncthreads();
        }
#undef HG_PK
#undef HG_PK4
    }
#undef HG_POS
    __syncthreads();
}

__device__ __forceinline__ void reduce_rstd(const float* __restrict__ ssp, float* __restrict__ rstd, int i0, int stride) {
    for (int row = i0; row < T; row += stride) { float s = 0.f;
#pragma unroll
        for (int j = 0; j < 8; ++j) { const float* p = ssp + (size_t)(4 * j) * T + row; s += (p[0] + p[T]) + (p[2 * (size_t)T] + p[3 * (size_t)T]); }
        rstd[row] = rsqrtf(s * (1.f / D) + EPS); }
}
struct Args { const float* in[28]; float* out; unsigned char* ws; int ph_lo, ph_hi, li, pad; };
constexpr int RING_BYTES = 131072, LDS_BYTES = 147456, MISC_OFF = LDS_BYTES - 128;

__host__ __device__ constexpr int n_phases() {
    int n = 1;
    for (int layer = 0; layer < 4; ++layer) {
        n += 1;
        if (layer == 0) n += 1;
        const int kind = layer % 3;
        if (kind == 0) n += 2 + 3 * 3 + 1;
        else if (kind == 1) n += 3 * 3 + 1;
        else n += 5;
        n += 3;
        n += 1 + 4;
    }
    return n;
}
constexpr int NPH = n_phases();

#define H      ((bf16*)X)
#define Xb     ((bf16*)(ws + LO(WS_H)))
#define rstd_  ((float*)(ws + LO(WS_RSTD)))
#define ssp_   ((float*)(ws + LO(WS_SSP)))
#define ropec  ((float*)(ws + LO(WS_ROPE)))
#define ropes  ((float*)(ws + LO(WS_ROPE)) + 4096 * 32)
#define mem_rs ((float*)(ws + LO(WS_MEMRS)))
#define mem_b  ((bf16*)(ws + LO(WS_MEMB)))
#define memkv  ((bf16*)(ws + LO(WS_MEMKV)))
#define w1t_(ly) ((bf16*)(ws + (((ly) & 1) ? LO(WS_W1B) : LO(WS_W1))))
#define w2t_(ly) ((bf16*)(ws + (((ly) & 1) ? LO(WS_W2B) : LO(WS_W2))))
#define rq     ((float*)(ws + LO(WS_SS0)))
#define rkv_   ((float*)(ws + LO(WS_SS0) + 262144))
#define P      ((bf16*)(ws + LO(S_P)))
#define Qv     ((bf16*)(ws + LO(S_QC)) - (size_t)c * CH * 3072)
#define KVv    ((bf16*)(ws + LO(S_KVC)) - (size_t)c * CH * 5120)
#define Zv     ((bf16*)(ws + LO(S_Z)) - (size_t)c * CH * 10240)
#define OFv    ((bf16*)(ws + LO(S_OF)) - (size_t)c * CH * D)
#define OBv    ((bf16*)(ws + LO(S_OB)) - (size_t)c * CH * D)
#define OP2v   ((bf16*)X + (size_t)T * D - (size_t)c * CH * D)
#define OP3v   ((bf16*)X + (size_t)T * D + (size_t)CH * D - (size_t)c * CH * D)
#define T1     ((bf16*)(ws + LO(S_T1)))
#define Qm     ((bf16*)(ws + LO(S_QM)))
#define Om     ((bf16*)(ws + LO(S_OM)))
#define Hv     ((bf16*)(ws + LO(S_HID) + (size_t)(c & 1) * 256 * MiB) - (size_t)c * CH * DFF)
__global__ void __launch_bounds__(NWAVES * 64, 2) fwd(Args args) {
    extern __shared__ __attribute__((aligned(16))) unsigned char lds_raw[];
    LAS unsigned char* lds = (LAS unsigned char*)lds_raw;
    const int G0_ = gridDim.x, bx0_ = blockIdx.x, wid0_ = __builtin_amdgcn_readfirstlane((int)(threadIdx.x >> 6));
    const int vcu0_ = (G0_ % 8 == 0) ? (bx0_ % 8) * (G0_ / 8) + bx0_ / 8 : bx0_;
    unsigned* ctl = (unsigned*)(args.ws + WS_CTL);
    volatile LAS unsigned* MISC = (volatile LAS unsigned*)(lds + MISC_OFF);
    if (threadIdx.x < 16) MISC[threadIdx.x] = 0u;
    __syncthreads();
    const int lo = args.ph_lo, hi = args.ph_hi;
    XcdBarrier bar; bar.bar = ctl + CW_BAR + args.li * XCD_BAR_WORDS; bar.x = 0; bar.st = MISC + 8; bar.w = wid0_;
    if (hi - lo > 1) { bar = xcd_barrier_post(ctl + CW_BAR + args.li * XCD_BAR_WORDS, MISC + 8); bar.w = wid0_; }
    int ph = 0;
#define PH_BEGIN(id) asm volatile("" : "+s"(ph)); if (ph >= lo && ph < hi) { if (PHMASK & (1ull << (id))) for (int rep_ = 0; rep_ < (((REPMASK >> (id)) & 1ull) ? 2 : 1); ++rep_) { if (rep_) __syncthreads(); const int G = launder_i(G0_), bx = launder_i(bx0_), vcu = launder_i(vcu0_), NGW = G * NWAVES; (void)bx; (void)NGW; const int wave = launder_i(wid0_), tid = opaque_tid(wave), lane = tid & 63, gw = vcu * NWAVES + wave; (void)lane; (void)gw; unsigned char* ws = launder_p(args.ws); float* X = (float*)launder_p((unsigned char*)args.out); (void)X;
#define PH_END   } if (ph + 1 < hi) { XcdBarrier b2_ = bar; b2_.bar = (unsigned*)launder_p((unsigned char*)bar.bar); xcd_barrier(b2_); } } ++ph;


    PH_BEGIN(0)
    {
        for (int m = gw; m < T; m += NGW) { const float* src_ = (m < TPR ? in_ptr(0) + (size_t)m * D : in_ptr(1) + (size_t)(m - TPR) * D);
            const f32x4* xr = (const f32x4*)src_ + lane; f32x4 v[8]; float s = 0.f;
#pragma unroll
            for (int j = 0; j < 8; ++j) { v[j] = xr[64 * j]; s += (v[j].x * v[j].x + v[j].y * v[j].y) + (v[j].z * v[j].z + v[j].w * v[j].w); }
            s = wave_sum(s, lane); if (lane == 0) rstd_[m] = rsqrtf(s * (1.f / D) + EPS);
            u32x2* o8 = (u32x2*)(Xb + (size_t)m * D) + lane;
#pragma unroll
            for (int j = 0; j < 8; ++j) { u32x2 w; w.x = cvt_pk_bf16(v[j].x, v[j].y); w.y = cvt_pk_bf16(v[j].z, v[j].w); o8[64 * j] = w; } }
        for (int i = bx * 512 + tid; i < 4096 * 32; i += G * 512) { const int p = i >> 5, k = i & 31; const float inv = 1.0f / powf(10000.0f, (float)(2 * k) / 64.0f); const float ang = (float)p * inv; float s, c; sincosf(ang, &s, &c); ropec[i] = c; ropes[i] = s; }
        { bf16* Dc = (bf16*)(ws + LO(WS_DC)); const float* g2 = in_ptr(4) + 2 * D;
          for (int i = bx * 512 + tid; i < 4 * 2 * 512 * 512; i += G * 512) { const int k = i & 511, cp = (i >> 9) & 511, part = (i >> 18) & 1, g = i >> 19; const int r = (cp * k) & 511; const float x = (float)r * (2.0f / 512.0f);
              const float v = (part ? sinpif(x) : cospif(x)) * g2[g * 512 + k]; Dc[i] = (bf16)(cvt_pk_bf16(v, 0.f) & 0xffffu); } }
        { bf16* DL = (bf16*)(ws + LO(WS_DL2)); for (int i = bx * 512 + tid; i < 2048 * 2048; i += G * 512) { const int k = i & 2047, lp = i >> 11; const int j = k & 1023; const int r = (lp * j) & 2047; const float x = (float)r * (2.0f / 2048.0f);
              const float v = (k < 1024) ? cospif(x) : -sinpif(x); DL[i] = (bf16)(cvt_pk_bf16(v, 0.f) & 0xffffu); } }
        { bf16* DL = (bf16*)(ws + LO(WS_DL4)); for (int i = bx * 512 + tid; i < 4096 * 4096; i += G * 512) { const int k = i & 4095, lp = i >> 12; const int j = k & 2047; const int r = (lp * j) & 4095; const float x = (float)r * (2.0f / 4096.0f);
              const float v = (k < 2048) ? cospif(x) : -sinpif(x); DL[i] = (bf16)(cvt_pk_bf16(v, 0.f) & 0xffffu); } }
        for (int m = gw; m < 4096; m += NGW) { const float* src = (m < 2048 ? in_ptr(2) + (size_t)m * D : in_ptr(3) + (size_t)(m - 2048) * D);
            const f32x4* xr = (const f32x4*)src + lane; f32x4 v[8]; float s = 0.f;
#pragma unroll
            for (int j = 0; j < 8; ++j) { v[j] = xr[64 * j]; s += (v[j].x * v[j].x + v[j].y * v[j].y) + (v[j].z * v[j].z + v[j].w * v[j].w); }
            s = wave_sum(s, lane); if (lane == 0) mem_rs[m] = rsqrtf(s * (1.f / D) + EPS);
            u32x2* o8 = (u32x2*)(mem_b + (size_t)m * D) + lane;
#pragma unroll
            for (int j = 0; j < 8; ++j) { u32x2 w; w.x = cvt_pk_bf16(v[j].x, v[j].y); w.y = cvt_pk_bf16(v[j].z, v[j].w); o8[64 * j] = w; } }
        { u32x4 z = {0u, 0u, 0u, 0u};
          for (int i = bx * 512 + tid; i < 2 * 192 * 2048 / 8; i += G * 512) { const int j = i / (192 * 2048 / 8), r = i % (192 * 2048 / 8); *(u32x4*)((bf16*)(ws + LO(WS_MLA_WIN)) + (size_t)j * 1280 * 2048 + (size_t)1088 * 2048 + (size_t)r * 8) = z; }
          for (int i = bx * 512 + tid; i < 2 * 16 * 64 * 512 / 8; i += G * 512) { const int j = i / (16 * 64 * 512 / 8), r = i % (16 * 64 * 512 / 8), hh = r / (64 * 512 / 8), q = r % (64 * 512 / 8);
              *(u32x4*)((bf16*)(ws + LO(WS_MLA_WKVB)) + (size_t)j * 5120 * 512 + (size_t)(hh * 320 + 128) * 512 + (size_t)q * 8) = z; } }
        LAS float* scr = (LAS float*)(lds + wave * 16384);
        {
            constexpr int I_WIN = 16 * 34, I_QB = 4 * 96, I_KVB = 4 * 128, I_WO = 16 * 64, I_HIN = 16 * 320, I_MQ = 16 * 16, I_MKV = 16 * 32, I_MO = 4 * 64;
            constexpr int NIT = 2 * I_WIN + 2 * I_QB + 2 * I_KVB + 2 * I_WO + I_HIN + I_WO + I_WO + 4 * I_MQ + 4 * I_MKV + 4 * I_MO;
            for (int it = gw; it < NIT; it += NGW) {
                int r = it;
                if (r < 2 * I_WIN) { const int j = r / I_WIN; transpose_item<0>(in_ptr(5) + (size_t)j * 2048 * 1088, 2048, 1088, (bf16*)(ws + LO(WS_MLA_WIN)) + (size_t)j * 1280 * 2048, in_ptr(4) + (3 * j) * D, scr, r % I_WIN, lane); continue; } r -= 2 * I_WIN;
                if (r < 2 * I_QB) { const int j = r / I_QB; transpose_item<0>(in_ptr(8) + (size_t)j * 512 * 3072, 512, 3072, (bf16*)(ws + LO(WS_MLA_WQB)) + (size_t)j * 3072 * 512, in_ptr(6) + j * 512, scr, r % I_QB, lane); continue; } r -= 2 * I_QB;
                if (r < 2 * I_KVB) { const int j = r / I_KVB; transpose_item<1>(in_ptr(9) + (size_t)j * 512 * 4096, 512, 4096, (bf16*)(ws + LO(WS_MLA_WKVB)) + (size_t)j * 5120 * 512, in_ptr(7) + j * 512, scr, r % I_KVB, lane); continue; } r -= 2 * I_KVB;
                if (r < 2 * I_WO) { const int j = r / I_WO; transpose_item<0>(in_ptr(12) + (size_t)j * 2048 * 2048, 2048, 2048, (bf16*)(ws + LO(WS_MLA_WO)) + (size_t)j * 2048 * 2048, nullptr, scr, r % I_WO, lane); continue; } r -= 2 * I_WO;
                if (r < I_HIN) { transpose_item<0>(in_ptr(13), 2048, 10240, (bf16*)(ws + LO(WS_HG_WIN)), in_ptr(4) + 1 * D, scr, r, lane); continue; } r -= I_HIN;
                if (r < I_WO) { transpose_item<0>(in_ptr(16), 2048, 2048, (bf16*)(ws + LO(WS_HG_WO)), nullptr, scr, r, lane); continue; } r -= I_WO;
                if (r < I_WO) { transpose_item<0>(in_ptr(17), 2048, 2048, (bf16*)(ws + LO(WS_FN_WO)), nullptr, scr, r, lane); continue; } r -= I_WO;
                if (r < 4 * I_MQ) { const int j = r / I_MQ; transpose_item<0>(in_ptr(20) + (size_t)j * 2048 * 512, 2048, 512, (bf16*)(ws + LO(WS_MEM_WQ)) + (size_t)j * 512 * 2048, in_ptr(18) + j * D, scr, r % I_MQ, lane); continue; } r -= 4 * I_MQ;
                if (r < 4 * I_MKV) { const int j = r / I_MKV; transpose_item<0>(in_ptr(21) + (size_t)j * 2048 * 1024, 2048, 1024, (bf16*)(ws + LO(WS_MEM_WKV)) + (size_t)j * 1024 * 2048, in_ptr(19) + j * 2048, scr, r % I_MKV, lane); continue; } r -= 4 * I_MKV;
                { const int j = r / I_MO; transpose_item<0>(in_ptr(24) + (size_t)j * 512 * 2048, 512, 2048, (bf16*)(ws + LO(WS_MEM_WO)) + (size_t)j * 2048 * 512, nullptr, scr, r % I_MO, lane); }
            }
        }
        __syncthreads();
    }
    PH_END

#pragma unroll 1
    for (int layer = 0; layer < 4; ++layer) {
        const int kind = layer % 3, jm = layer / 3;
        PH_BEGIN(1)
        {
            if (layer > 0) reduce_rstd(ssp_, rstd_, bx * 512 + tid, G * 512);
            if (layer == 0) {
                LAS float* scr = (LAS float*)(lds + wave * 16384);
                constexpr int I_1 = 16 * 256, I_2 = 64 * 64;
                for (int it = gw; it < I_1 + I_2; it += NGW) {
                    if (it < I_1) transpose_item<0>(in_ptr(26), D, DFF, w1t_(0), in_ptr(25), scr, it, lane);
                    else transpose_item<0>(in_ptr(27), DFF, D, w2t_(0), nullptr, scr, it - I_1, lane);
                }
                __syncthreads();
            }
            if (layer == 0) {
                pg8::TileOrder S; S.init(mem_b, D, ws + WS_MEM_WKV, D, 0, 16, 16, G, bx);
                pg8::EpiBf16<1, 0> E{memkv, 4096, mem_rs, 0, 1.f};
                pg8::gemm_phase(lds, D, D, D, S, E, wave);
            }
        }
        PH_END
        if (layer == 0) {
            PH_BEGIN(2)
            for (int m = gw; m < 4096; m += NGW) { const int ly = lane >> 4, hh = (lane >> 2) & 3, qq = lane & 3;
                bf16* p = memkv + (size_t)m * 4096 + ly * 1024 + hh * 128 + qq * 32; const float* g = in_ptr(23) + ly * 128 + qq * 32;
                u32x4 raw[4]; float x[32]; float s = 0.f;
#pragma unroll
                for (int j = 0; j < 4; ++j) { raw[j] = *(const u32x4*)(p + 8 * j);
#pragma unroll
                    for (int e = 0; e < 4; ++e) { x[8 * j + 2 * e] = bflo(raw[j][e]); x[8 * j + 2 * e + 1] = bfhi(raw[j][e]); } }
#pragma unroll
                for (int e = 0; e < 32; ++e) s += x[e] * x[e];
                s += shx(s, 1, lane); s += shx(s, 2, lane);
                const float r = rsqrtf(s * (1.f / 128.f) + EPS);
#pragma unroll
                for (int j = 0; j < 4; ++j) { u32x4 w;
#pragma unroll
                    for (int e = 0; e < 4; ++e) w[e] = cvt_pk_bf16(x[8 * j + 2 * e] * r * g[8 * j + 2 * e], x[8 * j + 2 * e + 1] * r * g[8 * j + 2 * e + 1]);
                    *(u32x4*)(p + 8 * j) = w; } }
            PH_END
        }

        if (kind == 0) {
            PH_BEGIN(3)
            {   pg8::TileOrder S; S.init(Xb, D, (bf16*)(ws + LO(WS_MLA_WIN)) + (size_t)jm * 1280 * 2048, D, 0, T / 256, 5, G, bx);
                pg8::EpiBf16<1, 0> E{P, 1280, rstd_, 0, 1.f};
                pg8::gemm_phase(lds, D, D, D, S, E, wave); }
            PH_END
            PH_BEGIN(24)
            for (int m = gw; m < T; m += NGW) {
                const u32x4 a = *(const u32x4*)(P + (size_t)m * 1280 + lane * 16), b = *(const u32x4*)(P + (size_t)m * 1280 + lane * 16 + 8); float q2 = 0.f;
#pragma unroll
                for (int e = 0; e < 4; ++e) { const float a0 = bflo(a[e]), a1 = bfhi(a[e]), b0 = bflo(b[e]), b1 = bfhi(b[e]); q2 += (a0 * a0 + a1 * a1) + (b0 * b0 + b1 * b1); }
#pragma unroll
                for (int o = 1; o < 32; o <<= 1) q2 += shx(q2, o, lane);
                const float rs_ = rsqrtf(q2 * (1.f / 512.f) + EPS);
                if (lane == 0) rq[m] = rs_; if (lane == 32) rkv_[m] = rs_; }
            PH_END
#pragma unroll 1
            for (int c = 0; c < 3; ++c) {
                PH_BEGIN(4)
                {   pg8::TileOrder S; S.init(P, 1280, (bf16*)(ws + LO(WS_MLA_WQB)) + (size_t)jm * 3072 * 512, 512, c * 64, 64, 12, G, bx);
                    pg8::EpiBf16<1, 0> E{Qv, 3072, rq, 0, 1.f};
                    pg8::gemm_phase(lds, 512, 1280, 512, S, E, wave); }
                {   pg8::TileOrder S; S.init(P + 512, 1280, (bf16*)(ws + LO(WS_MLA_WKVB)) + (size_t)jm * 5120 * 512, 512, c * 64, 64, 20, G, bx);
                    pg8::EpiBf16<1, 0> E{KVv, 5120, rkv_, 0, 1.f};
                    pg8::gemm_phase(lds, 512, 1280, 512, S, E, wave); }
                PH_END
                PH_BEGIN(5)
                {   const float* gk = in_ptr(11) + jm * 192; const int hh = lane >> 2, qq = lane & 3;
                    for (int m = c * CH + gw; m < (c + 1) * CH; m += NGW) {
                        const int pos = m < TPR ? (m & 2047) : ((m - TPR) & 4095);
                        bf16* kp = KVv + (size_t)m * 5120 + hh * 320; const bf16* pr = P + (size_t)m * 1280 + 1024;
                        u32x4 raw[4]; float x[32], x1[8], x2[8]; float s = 0.f;
#pragma unroll
                        for (int j = 0; j < 4; ++j) { raw[j] = *(const u32x4*)(kp + qq * 32 + 8 * j);
#pragma unroll
                            for (int e = 0; e < 4; ++e) { x[8 * j + 2 * e] = bflo(raw[j][e]); x[8 * j + 2 * e + 1] = bfhi(raw[j][e]); } }
                        { const u32x4 r1 = *(const u32x4*)(pr + qq * 8), r2 = *(const u32x4*)(pr + 32 + qq * 8);
#pragma unroll
                          for (int e = 0; e < 4; ++e) { x1[2 * e] = bflo(r1[e]); x1[2 * e + 1] = bfhi(r1[e]); x2[2 * e] = bflo(r2[e]); x2[2 * e + 1] = bfhi(r2[e]); } }
#pragma unroll
                        for (int e = 0; e < 32; ++e) s += x[e] * x[e];
#pragma unroll
                        for (int e = 0; e < 8; ++e) s += x1[e] * x1[e] + x2[e] * x2[e];
                        s += shx(s, 1, lane); s += shx(s, 2, lane);
                        const float r = rsqrtf(s * (1.f / 192.f) + EPS);
#pragma unroll
                        for (int j = 0; j < 4; ++j) { u32x4 w;
#pragma unroll
                            for (int e = 0; e < 4; ++e) w[e] = cvt_pk_bf16(x[8 * j + 2 * e] * r * gk[qq * 32 + 8 * j + 2 * e], x[8 * j + 2 * e + 1] * r * gk[qq * 32 + 8 * j + 2 * e + 1]);
                            *(u32x4*)(kp + qq * 32 + 8 * j) = w; }
                        float y1[8], y2[8];
#pragma unroll
                        for (int e = 0; e < 8; ++e) { const int i = qq * 8 + e; const float cc = ropec[pos * 32 + i], sn = ropes[pos * 32 + i];
                            const float a = x1[e] * r * gk[128 + i], b = x2[e] * r * gk[160 + i]; y1[e] = a * cc - b * sn; y2[e] = a * sn + b * cc; }
                        u32x4 w1, w2;
#pragma unroll
                        for (int e = 0; e < 4; ++e) { w1[e] = cvt_pk_bf16(y1[2 * e], y1[2 * e + 1]); w2[e] = cvt_pk_bf16(y2[2 * e], y2[2 * e + 1]); }
                        *(u32x4*)(kp + 128 + qq * 8) = w1; *(u32x4*)(kp + 160 + qq * 8) = w2;
                    } }
                PH_END
                PH_BEGIN(6)
                {   const int nqb = (c == 0) ? 8 : 16, nun = 1024;
                    for (int idx = vcu; idx < nun; idx += G) {
                        const int qb = idx % nqb, hh = (idx / nqb) & 15, sl = idx / (nqb * 16); const int s = (c == 0) ? sl : 8 + (c - 1) * 4 + sl;
                        const int row0 = seq_row0(s), L = seq_len(s);
                        att::attn_unit<192, true>(Qv + (size_t)(row0 + qb * 256) * 3072 + hh * 192, 3072, KVv + (size_t)row0 * 5120 + hh * 320, 5120, KVv + (size_t)row0 * 5120 + hh * 320 + 192, 5120,
                                                  H + (size_t)(row0 + qb * 256) * D + hh * 128, D, L, in_ptr(10) + jm * 192, ropec, ropes, qb * 256, 0.07216878364870322f, nullptr, (char*)lds_raw, wave);
                    } }
                PH_END
            }
            PH_BEGIN(7)
            {   pg8::TileOrder S; S.init(H, D, (bf16*)(ws + LO(WS_MLA_WO)) + (size_t)jm * 2048 * 2048, D, 0, T / 256, 8, G, bx);
                pg8::EpiResid<false> E{Xb, ssp_, nullptr};
                pg8::gemm_phase(lds, D, D, D, S, E, wave); }
            PH_END
        } else if (kind == 1) {
#pragma unroll 1
            for (int c = 0; c < 3; ++c) {
                PH_BEGIN(8)
                {   pg8::TileOrder S; S.init(Xb, D, ws + WS_HG_WIN, D, c * 64, 64, 40, G, bx);
                    pg8::EpiBf16<1, 0> E{Zv, 10240, rstd_, 0, 1.f};
                    pg8::gemm_phase(lds, D, D, D, S, E, wave); }
                PH_END
                PH_BEGIN(9)
                {
                    if (c == 0) {
                        for (int it = vcu; it < 256; it += G) { const int dir = it & 1, hh = (it >> 1) & 15, s = it >> 5;
                            hgrn_scan_item<128>(Zv, seq_row0(s), seq_len(s), hh, dir, 0, in_ptr(14), dir ? OBv : OFv, lds, lds_raw, tid, lane, wave); }
                    } else {
                        for (int it = vcu; it < 256; it += G) { const int kh = it & 1, dir = (it >> 1) & 1, hh = (it >> 2) & 15, s = 8 + (c - 1) * 4 + (it >> 6);
                            bf16* Oo = kh ? (dir ? OP3v : OP2v) : (dir ? OBv : OFv);
                            hgrn_scan_item<64>(Zv, seq_row0(s), seq_len(s), hh, dir, kh * 64, in_ptr(14), Oo, lds, lds_raw, tid, lane, wave); }
                    } }
                PH_END
                PH_BEGIN(10)
                {   const float* go = in_ptr(15) + (lane & 3) * 32;
                    for (int m = c * CH + gw; m < (c + 1) * CH; m += NGW) {
                        const bf16* pf = OFv + (size_t)m * D + lane * 32; const bf16* pb = OBv + (size_t)m * D + lane * 32; const bf16* pg = Zv + (size_t)m * 10240 + 8192 + lane * 32;
                        const bf16* p2 = OP2v + (size_t)m * D + lane * 32; const bf16* p3 = OP3v + (size_t)m * D + lane * 32;
                        float x[32]; float s = 0.f;
#pragma unroll
                        for (int j = 0; j < 4; ++j) { const u32x4 a = *(const u32x4*)(pf + 8 * j), b = *(const u32x4*)(pb + 8 * j);
#pragma unroll
                            for (int e = 0; e < 4; ++e) { x[8 * j + 2 * e] = bflo(a[e]) + bflo(b[e]); x[8 * j + 2 * e + 1] = bfhi(a[e]) + bfhi(b[e]); }
                            if (c > 0) { const u32x4 a2 = *(const u32x4*)(p2 + 8 * j), b2 = *(const u32x4*)(p3 + 8 * j);
#pragma unroll
                                for (int e = 0; e < 4; ++e) { x[8 * j + 2 * e] += bflo(a2[e]) + bflo(b2[e]); x[8 * j + 2 * e + 1] += bfhi(a2[e]) + bfhi(b2[e]); } } }
#pragma unroll
                        for (int e = 0; e < 32; ++e) s += x[e] * x[e];
                        s += shx(s, 1, lane); s += shx(s, 2, lane);
                        const float r = rsqrtf(s * (1.f / 128.f) + EPS);
#pragma unroll
                        for (int j = 0; j < 4; ++j) { const u32x4 gr = *(const u32x4*)(pg + 8 * j); u32x4 w;
#pragma unroll
                            for (int e = 0; e < 4; ++e) { const float g0 = bflo(gr[e]), g1 = bfhi(gr[e]); const float s0 = g0 / (1.f + __expf(-g0)), s1 = g1 / (1.f + __expf(-g1));
                                w[e] = cvt_pk_bf16(x[8 * j + 2 * e] * r * go[8 * j + 2 * e] * s0, x[8 * j + 2 * e + 1] * r * go[8 * j + 2 * e + 1] * s1); }
                            *(u32x4*)(H + (size_t)m * D + lane * 32 + 8 * j) = w; } } }
                PH_END
            }
            PH_BEGIN(11)
            {   pg8::TileOrder S; S.init(H, D, ws + WS_HG_WO, D, 0, T / 256, 8, G, bx);
                pg8::EpiResid<false> E{Xb, ssp_, nullptr};
                pg8::gemm_phase(lds, D, D, D, S, E, wave); }
            PH_END
        } else {
            struct F1Order { const char* Dc; const char* HEb; const char* HOb; int G, c, smp;
                __device__ __forceinline__ bool next(int i, pg8::Unit& u) const {
                    const int idx = i * G + c; const int npn = smp ? 8 : 4, per = 16 * npn; if (idx >= 8 * per) return false;
                    const int s = (smp ? 8 : 0) + idx / per, rem = idx % per; const int g = rem / (4 * npn), part = (rem / (2 * npn)) & 1, pn = (rem % (2 * npn)) / 2, pm = rem & 1;
                    const int row0 = seq_row0(s), L = seq_len(s);
                    u.pm = pm; u.pn = pn; u.a = Dc + ((size_t)((g * 2 + part) * 512 + pm * 256) * 512) * 2; u.b = (part ? HOb : HEb) + ((size_t)(row0 / 2 + pn * 256) * D + g * 512) * 2;
                    u.ooff = (long)row0 * D + (long)g * 512 * L + (long)part * (L / 2); u.aoff = 0; u.roff = 0; return true; } };
            struct F2Order { const char* DL; const char* T1b; int G, c, smp, half;
                __device__ __forceinline__ bool next(int i, pg8::Unit& u) const {
                    const int idx = i * G + c; const int L = smp ? 4096 : 2048, npm = L / 512; if (idx >= npm * 64) return false;
                    const int pm = idx / 64, sgp = idx % 64; const int s = (smp ? 8 : 0) + sgp / 8, g = (sgp % 8) / 2, pn = sgp % 2; const int row0 = seq_row0(s);
                    u.pm = pm; u.pn = pn; u.a = DL + ((size_t)pm * 256 * L + half * (L / 2)) * 2; u.b = T1b + ((size_t)row0 * D + (size_t)g * 512 * L + (size_t)pn * 256 * L + half * (L / 2)) * 2;
                    u.aoff = (long)(row0 / 2) * D + (long)g * (L / 2) * 512; u.ooff = half ? (long)row0 * D + g * 512 : u.aoff; u.roff = s * D + g * 512; return true; } };
            PH_BEGIN(22)
            {
                bf16* HE = (bf16*)(ws + LO(S_HE)); bf16* HO = (bf16*)(ws + LO(S_HO)); float* xcm = (float*)(ws + LO(WS_XCMID));
                for (int m = gw; m < T / 2; m += NGW) {
                    const int s = m < 8192 ? m / 1024 : 8 + (m - 8192) / 2048; const int row0 = seq_row0(s), L = seq_len(s), j = m - row0 / 2;
                    const bf16* pa = Xb + (size_t)(row0 + j) * D + lane * 32; const bf16* pb = Xb + (size_t)(row0 + (j ? L - j : 0)) * D + lane * 32;
                    const float ra = rstd_[row0 + j], rb = j ? rstd_[row0 + L - j] : 0.f;
#pragma unroll
                    for (int q = 0; q < 4; ++q) { const u32x4 a = *(const u32x4*)(pa + 8 * q), b = *(const u32x4*)(pb + 8 * q); u32x4 we, wo;
#pragma unroll
                        for (int e = 0; e < 4; ++e) { const float a0 = bflo(a[e]) * ra, a1 = bfhi(a[e]) * ra, b0 = bflo(b[e]) * rb, b1 = bfhi(b[e]) * rb; we[e] = cvt_pk_bf16(a0 + b0, a1 + b1); wo[e] = j ? cvt_pk_bf16(a0 - b0, a1 - b1) : 0u; }
                        *(u32x4*)(HE + (size_t)m * D + lane * 32 + 8 * q) = we; *(u32x4*)(HO + (size_t)m * D + lane * 32 + 8 * q) = wo; } }
                const bf16* Dcc = (const bf16*)(ws + LO(WS_DC));
                for (int t = gw; t < 16 * D; t += NGW) { const int s = t >> 11, col = t & 2047, g = col >> 9, cp = col & 511; const int mid = seq_row0(s) + seq_len(s) / 2;
                    const u32x4 dv = *(const u32x4*)(Dcc + ((size_t)(g * 2) * 512 + cp) * 512 + lane * 8), xv = *(const u32x4*)(Xb + (size_t)mid * D + g * 512 + lane * 8); float a = 0.f;
#pragma unroll
                    for (int e = 0; e < 4; ++e) a += bflo(dv[e]) * bflo(xv[e]) + bfhi(dv[e]) * bfhi(xv[e]);
                    a = wave_sum(a, lane); if (lane == 0) xcm[t] = a * rstd_[mid]; } }
            PH_END
            PH_BEGIN(12)
            {   F1Order S{(const char*)(ws + LO(WS_DC)), (const char*)(ws + LO(S_HE)), (const char*)(ws + LO(S_HO)), G, bx, 1}; pg8::EpiBf16<0, 0> E{T1, 4096, nullptr, 0, 1.f};
                pg8::gemm_phase(lds, 512, 512, D, S, E, wave); }
            {   F1Order S{(const char*)(ws + LO(WS_DC)), (const char*)(ws + LO(S_HE)), (const char*)(ws + LO(S_HO)), G, bx, 0}; pg8::EpiBf16<0, 0> E{T1, 2048, nullptr, 0, 1.f};
                pg8::gemm_phase(lds, 512, 512, D, S, E, wave); }
            PH_END
            PH_BEGIN(13)
            {   F2Order S{(const char*)(ws + LO(WS_DL4)), (const char*)T1, G, bx, 1, 0}; pg8::EpiBf16<0, 0> E{(bf16*)(ws + LO(S_HE)), 512, nullptr, 0, 1.f};
                pg8::gemm_phase(lds, 2048, 4096, 4096, S, E, wave); }
            {   F2Order S{(const char*)(ws + LO(WS_DL2)), (const char*)T1, G, bx, 0, 0}; pg8::EpiBf16<0, 0> E{(bf16*)(ws + LO(S_HE)), 512, nullptr, 0, 1.f};
                pg8::gemm_phase(lds, 1024, 2048, 2048, S, E, wave); }
            PH_END
            PH_BEGIN(23)
            {   F2Order S{(const char*)(ws + LO(WS_DL4)), (const char*)T1, G, bx, 1, 1}; pg8::EpiFnetSym E{H, (const bf16*)(ws + LO(S_HE)), (const float*)(ws + LO(WS_XCMID)), 4096, 6.905339660024878e-4f};
                pg8::gemm_phase(lds, 2048, 4096, 4096, S, E, wave); }
            {   F2Order S{(const char*)(ws + LO(WS_DL2)), (const char*)T1, G, bx, 0, 1}; pg8::EpiFnetSym E{H, (const bf16*)(ws + LO(S_HE)), (const float*)(ws + LO(WS_XCMID)), 2048, 9.765625e-4f};
                pg8::gemm_phase(lds, 1024, 2048, 2048, S, E, wave); }
            {
                const float* xcm = (const float*)(ws + LO(WS_XCMID));
                for (int t = gw; t < 16 * D; t += NGW) { const int s = t >> 11, col = t & 2047, g = col >> 9, cp = col & 511; const int row0 = seq_row0(s), L = seq_len(s);
                    const bf16* tp = T1 + (size_t)row0 * D + (size_t)g * 512 * L + (size_t)cp * L; float a = 0.f;
                    for (int j0 = lane * 8; j0 < L / 2; j0 += 512) { const u32x4 v = *(const u32x4*)(tp + j0);
#pragma unroll
                        for (int e = 0; e < 4; ++e) a += bflo(v[e]) - bfhi(v[e]); }
                    a = wave_sum(a, lane);
                    if (lane == 0) H[(size_t)(row0 + L / 2) * D + col] = (bf16)(cvt_pk_bf16((a + xcm[t]) * (L == 4096 ? 6.905339660024878e-4f : 9.765625e-4f), 0.f) & 0xffffu); } }
            PH_END
            PH_BEGIN(14)
            {   pg8::TileOrder S; S.init(H, D, ws + WS_FN_WO, D, 0, T / 256, 8, G, bx);
                pg8::EpiResid<false> E{Xb, ssp_, nullptr};
                pg8::gemm_phase(lds, D, D, D, S, E, wave); }
            PH_END
        }

        {
            PH_BEGIN(16)
            {   pg8::TileOrder S; S.init(Xb, D, (bf16*)(ws + LO(WS_MEM_WQ)) + (size_t)layer * 512 * 2048, D, 0, T / 256, 2, G, bx);
                pg8::EpiBf16<3, 0> E{Qm, 512, ssp_, 0, 1.f};
                pg8::gemm_phase(lds, D, D, D, S, E, wave);
                const int nidle = 2 * G - 384, ncv = (nidle > 0 && nidle < G) ? nidle : G, cv0 = G - ncv;
                if (layer < 3 && bx >= cv0) {
                    LAS float* scr = (LAS float*)(lds + wave * 16384);
                    constexpr int I_1 = 16 * 256, I_2 = 64 * 64;
                    for (int it = (bx - cv0) * NWAVES + wave; it < I_1 + I_2; it += ncv * NWAVES) {
                        if (it < I_1) transpose_item<0>(in_ptr(26) + (size_t)(layer + 1) * D * DFF, D, DFF, w1t_(layer + 1), in_ptr(25) + (layer + 1) * D, scr, it, lane);
                        else transpose_item<0>(in_ptr(27) + (size_t)(layer + 1) * DFF * D, DFF, D, w2t_(layer + 1), nullptr, scr, it - I_1, lane);
                    }
                    __syncthreads();
                } }
            PH_END
            PH_BEGIN(17)
            for (int idx = vcu; idx < 768; idx += G) {
                const int hh = idx & 3, rb = idx >> 2; const int s = rb < 64 ? rb / 8 : 8 + (rb - 64) / 16;
                const bf16* kp = memkv + (size_t)(s * 256) * 4096 + layer * 1024 + hh * 128;
                att::attn_unit<128, false>(Qm + (size_t)rb * 256 * 512 + hh * 128, 512, kp, 4096, kp + 512, 4096, Om + (size_t)rb * 256 * 512 + hh * 128, 512, 256,
                                           in_ptr(22) + layer * 128, nullptr, nullptr, 0, 0.08838834764831845f, nullptr, (char*)lds_raw, wave);
            }
            PH_END
            PH_BEGIN(18)
            {   pg8::TileOrder S; S.init(Om, 512, (bf16*)(ws + LO(WS_MEM_WO)) + (size_t)layer * 2048 * 512, 512, 0, T / 256, 8, G, bx);
                pg8::EpiResid<false> E{Xb, ssp_, nullptr};
                pg8::gemm_phase(lds, 512, 512, 512, S, E, wave); }
            PH_END
        }
        {
            PH_BEGIN(19)
            reduce_rstd(ssp_, rstd_, bx * 512 + tid, G * 512);
            PH_END
#pragma unroll 1
            for (int cc = 0; cc < 4; ++cc) {
                PH_BEGIN(20)
                if (cc > 0) { const int c = cc - 1;
                    pg8::TileOrder S; S.init(Hv, DFF, w2t_(layer), DFF, c * 64, 64, 8, G, bx);
                    if (layer == 3) { pg8::EpiResid<true> E{Xb, nullptr, X}; pg8::gemm_phase(lds, DFF, DFF, DFF, S, E, wave); }
                    else { pg8::EpiResid<false> E{Xb, ssp_, nullptr}; pg8::gemm_phase(lds, DFF, DFF, DFF, S, E, wave); } }
                if (cc < 3) { const int c = cc;
                    pg8::TileOrder S; S.init(Xb, D, w1t_(layer), D, c * 64, 64, 32, G, bx);
                    pg8::EpiBf16<1, 1> E{Hv, DFF, rstd_, 0, 1.f};
                    pg8::gemm_phase(lds, D, D, D, S, E, wave); }
                PH_END
            }
        }
    }
#undef PH_BEGIN
#undef PH_END
}

extern "C" void kernel_launch(void* const* d_in, const int* in_sizes, int n_in, void* d_out, int out_size, void* d_ws, size_t ws_size, hipStream_t stream) {
    static int grid = 0;
    if (grid == 0) {
        if (n_in != 28 || out_size != T * D || ws_size < WS_END) { fprintf(stderr, "kernel_launch: unexpected shapes (n_in %d out %d ws %zu)\n", n_in, out_size, ws_size); grid = -1; return; }
        int dev = 0, cus = 0, per_cu = 0;
        if (hipGetDevice(&dev) != hipSuccess || hipDeviceGetAttribute(&cus, hipDeviceAttributeMultiprocessorCount, dev) != hipSuccess) { grid = -1; return; }
        if (hipFuncSetAttribute((const void*)fwd, hipFuncAttributeMaxDynamicSharedMemorySize, LDS_BYTES) != hipSuccess) { fprintf(stderr, "kernel_launch: hipFuncSetAttribute failed\n"); grid = -1; return; }
        if (hipOccupancyMaxActiveBlocksPerMultiprocessor(&per_cu, (const void*)fwd, NWAVES * 64, LDS_BYTES) != hipSuccess || per_cu < 1) fprintf(stderr, "kernel_launch: occupancy query says %d\n", per_cu);
        (void)hipGetLastError();
        grid = cus;
    }
    if (grid < 0) return;
    (void)hipMemsetAsync((char*)d_ws + WS_CTL, 0, CTL_BYTES, stream);
    Args a{};
    for (int i = 0; i < 28; ++i) a.in[i] = (const float*)d_in[i];
    a.out = (float*)d_out; a.ws = (unsigned char*)d_ws; a.pad = 0;
#if N_LAUNCH_MODE == 0
    a.ph_lo = 0; a.ph_hi = NPH; a.li = 0;
    hipLaunchKernelGGL(fwd, dim3(grid), dim3(NWAVES * 64), LDS_BYTES, stream, a);
#else
    for (int p = 0; p < NPH; ++p) { a.ph_lo = p; a.ph_hi = p + 1; a.li = 0; hipLaunchKernelGGL(fwd, dim3(grid), dim3(NWAVES * 64), LDS_BYTES, stream, a); }
#endif
    const hipError_t le = hipPeekAtLastError();
    if (le != hipSuccess) fprintf(stderr, "kernel_launch: launch failed: %s\n", hipGetErrorName(le));
}
```

```cpp
#include <hip/hip_runtime.h>
#include <cstdio>
#include <cstdint>

#ifndef PHMASK
#define PHMASK 0xFFFFFFFFFFFFFFFFull
#endif
#ifndef REPMASK
#define REPMASK 0x0ull
#endif
#ifndef N_LAUNCH_MODE
#define N_LAUNCH_MODE 0
#endif

#define LAS __attribute__((address_space(3)))
#define GAS __attribute__((address_space(1)))
typedef unsigned short bf16;
typedef short bf16x8 __attribute__((ext_vector_type(8)));
typedef short s16x4 __attribute__((ext_vector_type(4)));
typedef float f32x4 __attribute__((ext_vector_type(4)));
typedef float f32x2 __attribute__((ext_vector_type(2)));
typedef float f32x16 __attribute__((ext_vector_type(16)));
typedef unsigned u32x4 __attribute__((ext_vector_type(4)));
typedef unsigned u32x2 __attribute__((ext_vector_type(2)));

constexpr int D = 2048, T = 49152, TPR = 16384, CH = 16384, DFF = 8192, NWAVES = 8;
constexpr float EPS = 1e-6f;
__host__ __device__ __forceinline__ int seq_row0(int s) { return s < 8 ? s * 2048 : 16384 + (s - 8) * 4096; }
__host__ __device__ __forceinline__ int seq_len(int s) { return s < 8 ? 2048 : 4096; }

constexpr size_t MiB = 1u << 20;
constexpr size_t WS_CTL = 0, CTL_BYTES = 4 * MiB;
constexpr size_t WS_SS0 = 1 * MiB, WS_RSTD = 2 * MiB;
constexpr size_t WS_ROPE = 4 * MiB;
constexpr size_t WS_MEMRS = 5 * MiB;
constexpr size_t WS_MLA_WIN = 6 * MiB, WS_MLA_WQB = 16 * MiB, WS_MLA_WKVB = 22 * MiB, WS_MLA_WO = 32 * MiB;
constexpr size_t WS_HG_WIN = 48 * MiB, WS_HG_WO = 88 * MiB, WS_FN_WO = 96 * MiB;
constexpr size_t WS_MEM_WQ = 104 * MiB, WS_MEM_WKV = 112 * MiB, WS_MEM_WO = 128 * MiB;
constexpr size_t WS_W1 = 136 * MiB, WS_W2 = 168 * MiB;
constexpr size_t WS_DC = 200 * MiB, WS_DL2 = 204 * MiB, WS_DL4 = 220 * MiB;
constexpr size_t WS_MEMB = 284 * MiB, WS_MEMKV = 300 * MiB;
constexpr size_t WS_H = 332 * MiB;
constexpr size_t WS_S = 524 * MiB;
constexpr size_t WS_SSP = 1036 * MiB;
constexpr size_t WS_W1B = 1044 * MiB, WS_W2B = 1076 * MiB;
constexpr size_t WS_END = 1108 * MiB;
constexpr size_t S_P = WS_S, S_QC = WS_S + 120 * MiB, S_KVC = WS_S + 216 * MiB;
constexpr size_t S_Z = WS_S, S_OF = WS_S + 320 * MiB, S_OB = WS_S + 384 * MiB;
constexpr size_t S_HE = WS_S, S_HO = WS_S + 96 * MiB, S_T1 = WS_S + 192 * MiB;
constexpr size_t WS_XCMID = WS_MEMRS + 65536;
constexpr size_t S_QM = WS_S, S_OM = WS_S + 48 * MiB;
constexpr size_t S_HID = WS_S;
constexpr int CW_TMO = 0, CW_BAR = 4096;

typedef __bf16 bf16x2_t __attribute__((ext_vector_type(2)));
__device__ __forceinline__ unsigned cvt_pk_bf16(float lo, float hi) { const f32x2 f = {lo, hi}; const bf16x2_t v = __builtin_convertvector(f, bf16x2_t); return __builtin_bit_cast(unsigned, v); }
__device__ __forceinline__ float bf2f(unsigned short b) { return __uint_as_float(((unsigned)b) << 16); }
__device__ __forceinline__ float bflo(unsigned w) { return __uint_as_float(w << 16); }
__device__ __forceinline__ float bfhi(unsigned w) { return __uint_as_float(w & 0xffff0000u); }
__device__ __forceinline__ float shx(float v, int m, int lane) { return __int_as_float(__builtin_amdgcn_ds_bpermute((lane ^ m) << 2, __float_as_int(v))); }
__device__ __forceinline__ float shl_(float v, int src) { return __int_as_float(__builtin_amdgcn_ds_bpermute(src << 2, __float_as_int(v))); }
__device__ __forceinline__ float wave_sum(float v, int lane) {
#pragma unroll
    for (int o = 1; o < 64; o <<= 1) v += shx(v, o, lane);
    return v;
}
__device__ __forceinline__ int opaque_lane() { unsigned z = 0u; asm volatile("" : "+v"(z)); return (int)__builtin_amdgcn_mbcnt_hi(~0u, __builtin_amdgcn_mbcnt_lo(~0u, z)); }
__device__ __forceinline__ int opaque_tid(int w) { return (w << 6) | opaque_lane(); }
__device__ __forceinline__ const float* in_ptr(int i) {
    const __attribute__((address_space(4))) char* ka = (const __attribute__((address_space(4))) char*)__builtin_amdgcn_kernarg_segment_ptr();
    int off = i * 8; asm volatile("" : "+s"(off));
    const float* p = *(const float* const __attribute__((address_space(4)))*)(ka + off);
    return (const float*)(const __attribute__((address_space(1))) float*)p;
}
__device__ __forceinline__ size_t LO(size_t v) { asm volatile("" : "+s"(v)); return v; }
__device__ __forceinline__ int launder_i(int v) { asm volatile("" : "+s"(v)); return v; }
__device__ __forceinline__ unsigned char* launder_p(unsigned char* p) { unsigned z = 0u; asm volatile("" : "+s"(z)); return p + z; }
#define LDS_WAIT() asm volatile("s_waitcnt lgkmcnt(0)" ::: "memory")
#define VM_WAIT() asm volatile("s_waitcnt vmcnt(0)" ::: "memory")

namespace pg8 {
constexpr int BM = 256, BK = 64, HALF = 128, HTB = HALF * BK * 2, STAGE_BYTES = 8 * HTB, NXCD = 8;
__host__ __device__ __forceinline__ int lds_byte(int r, int c) { const int st = (r >> 4) * 2 + (c >> 5), rr = r & 15, cc = c & 31, ob = rr * 64 + cc * 2; return st * 1024 + (ob ^ (((ob >> 9) & 1) << 5)); }
__host__ __device__ __forceinline__ void stage_rc(int b, int& R, int& C) { const int st = b / 1024, sb = b % 1024, swz = sb ^ (((sb >> 9) & 1) << 5); R = (st >> 1) * 16 + swz / 64; C = (st & 1) * 32 + (swz % 64) / 2; }
__host__ __device__ __forceinline__ int perm32(int rho) { const int n = rho >> 4, i = rho & 15; return 8 * (i >> 2) + 4 * n + (i & 3); }

struct Unit { int pm, pn; const char* a; const char* b; long ooff; long aoff; int roff; };

struct TileOrder {
    const char* A; const char* B; int lda, ldb, nM, nN, nwg, G, c, pm0, WGM;
    __device__ __forceinline__ void init(const void* A_, int lda_, const void* B_, int ldb_, int pm0_, int nM_, int nN_, int G_, int c_, int wgm_ = 4) {
        A = (const char*)A_; B = (const char*)B_; lda = lda_; ldb = ldb_; pm0 = pm0_; nM = nM_; nN = nN_; nwg = nM_ * nN_; G = G_; c = c_; WGM = wgm_; }
    __device__ __forceinline__ bool next(int i, Unit& u) const {
        const long L = (long)i * G + c; if (L >= nwg) return false;
        int wgid = (int)L; { const int q = nwg / NXCD, r = nwg % NXCD, xcd = wgid % NXCD, off = wgid / NXCD; wgid = (xcd < r ? xcd * (q + 1) : r * (q + 1) + (xcd - r) * q) + off; }
        const int nig = WGM * nN, gid = wgid / nig, fm = gid * WGM, gsz = (nM - fm) < WGM ? (nM - fm) : WGM;
        u.pm = pm0 + fm + ((wgid % nig) % gsz); u.pn = (wgid % nig) / gsz;
        u.a = A + (size_t)u.pm * 256 * lda * 2; u.b = B + (size_t)u.pn * 256 * ldb * 2; u.ooff = 0; u.aoff = 0; u.roff = 0; return true;
    }
};

template <int RS  , int ACT  > struct EpiBf16 {
    static constexpr bool PERM = true;
    bf16* O; int ldc; const float* rs; int rsw; float cs;
    __device__ __forceinline__ void pre(const Unit& u, int wr, int fr, int fq, float (&pv)[8]) const {
        const int row0 = u.pm * BM + wr * 64 + fr;
        if (RS == 3) {
            const int lane_ = fq * 16 + fr;
#pragma unroll
            for (int i = 0; i < 8; ++i) { const int row = row0 + (i >> 2) * HALF + (i & 3) * 16; const float* pp = rs + (size_t)(fq * 8) * T + row; float t = 0.f;
#pragma unroll
                for (int j = 0; j < 8; j += 4) t += (pp[(size_t)j * T] + pp[(size_t)(j + 1) * T]) + (pp[(size_t)(j + 2) * T] + pp[(size_t)(j + 3) * T]);
                t += shx(t, 16, lane_); t += shx(t, 32, lane_); pv[i] = rsqrtf(t * (1.f / D) + EPS); }
            return; }
#pragma unroll
        for (int i = 0; i < 8; ++i) { const int row = row0 + (i >> 2) * HALF + (i & 3) * 16; pv[i] = RS == 1 ? rs[row] : RS == 2 ? rs[2 * row + rsw] : 0.f; }
    }
    __device__ __forceinline__ void operator()(const f32x4 (&acc)[2][2][4][2], const Unit& u, int wr, int wc, int fr, int fq, const float (&pv)[8]) const {
        const int row0 = u.pm * BM + wr * 64 + fr, col0 = u.pn * BM + wc * 32 + 8 * fq;
#pragma unroll
        for (int ai = 0; ai < 2; ++ai)
#pragma unroll
            for (int m = 0; m < 4; ++m) { const int row = row0 + ai * HALF + m * 16; float s = cs;
                if (RS == 1) s *= pv[ai * 4 + m];
                if (RS == 2) s *= rsqrtf(pv[ai * 4 + m] * (1.0f / 512.0f) + EPS);
                if (RS == 3) s *= pv[ai * 4 + m];
                bf16* rowp = O + u.ooff + (size_t)row * ldc + col0;
#pragma unroll
                for (int bj = 0; bj < 2; ++bj) { f32x4 v0 = acc[ai][bj][m][0] * s, v1 = acc[ai][bj][m][1] * s;
                    if (RS == 4) { const f32x4 c0 = *(const f32x4*)(rs + u.roff + col0 + bj * HALF), c1 = *(const f32x4*)(rs + u.roff + col0 + bj * HALF + 4); v0 = v0 * c0; v1 = v1 * c1; }
                    if (RS == 5) { const f32x4 c0 = *(const f32x4*)(rs + u.roff + col0 + bj * HALF), c1 = *(const f32x4*)(rs + u.roff + col0 + bj * HALF + 4); const float sg = (row & 1) ? -s : s; v0 = v0 + c0 * sg; v1 = v1 + c1 * sg; }
                    if (ACT == 1) {
#pragma unroll
                        for (int j = 0; j < 4; ++j) { const float a = fmaxf(v0[j], 0.f), b = fmaxf(v1[j], 0.f); v0[j] = a * a; v1[j] = b * b; } }
                    u32x4 w; w.x = cvt_pk_bf16(v0[0], v0[1]); w.y = cvt_pk_bf16(v0[2], v0[3]); w.z = cvt_pk_bf16(v1[0], v1[1]); w.w = cvt_pk_bf16(v1[2], v1[3]);
                    *(u32x4*)(rowp + bj * HALF) = w; } }
    }
};
template <bool FINAL> struct EpiResid {
    static constexpr bool PERM = true;
    bf16* Xb; float* ssp; float* out;
    __device__ __forceinline__ void pre(const Unit&, int, int, int, float (&)[8]) const {}
    __device__ __forceinline__ void operator()(const f32x4 (&acc)[2][2][4][2], const Unit& u, int wr, int wc, int fr, int fq, const float (&)[8]) const {
        const int row0 = u.pm * BM + wr * 64 + fr, col0 = u.pn * BM + wc * 32 + 8 * fq, lane_ = fq * 16 + fr;
        u32x4 o[2][4][2];
#pragma unroll
        for (int ai = 0; ai < 2; ++ai)
#pragma unroll
            for (int m = 0; m < 4; ++m)
#pragma unroll
                for (int bj = 0; bj < 2; ++bj) o[ai][m][bj] = *(const u32x4*)(Xb + (size_t)(row0 + ai * HALF + m * 16) * D + col0 + bj * HALF);
#pragma unroll
        for (int ai = 0; ai < 2; ++ai) { float qv[4] = {0.f, 0.f, 0.f, 0.f};
#pragma unroll
            for (int m = 0; m < 4; ++m) { const int row = row0 + ai * HALF + m * 16; bf16* xp = Xb + (size_t)row * D + col0; float q = 0.f;
#pragma unroll
                for (int bj = 0; bj < 2; ++bj) { const u32x4 ov = o[ai][m][bj];
                    f32x4 v0 = acc[ai][bj][m][0], v1 = acc[ai][bj][m][1];
                    v0[0] += bflo(ov[0]); v0[1] += bfhi(ov[0]); v0[2] += bflo(ov[1]); v0[3] += bfhi(ov[1]); v1[0] += bflo(ov[2]); v1[1] += bfhi(ov[2]); v1[2] += bflo(ov[3]); v1[3] += bfhi(ov[3]);
                    if (FINAL) { float* op = out + (size_t)row * D + col0 + bj * HALF; *(f32x4*)op = v0; *(f32x4*)(op + 4) = v1; }
                    else { u32x4 w; w.x = cvt_pk_bf16(v0[0], v0[1]); w.y = cvt_pk_bf16(v0[2], v0[3]); w.z = cvt_pk_bf16(v1[0], v1[1]); w.w = cvt_pk_bf16(v1[2], v1[3]);
                        *(u32x4*)(xp + bj * HALF) = w;
#pragma unroll
                        for (int j = 0; j < 4; ++j) { const float a = bflo(w[j]), b = bfhi(w[j]); q += a * a + b * b; } } }
                if (!FINAL) { q += shx(q, 16, lane_); q += shx(q, 32, lane_); qv[m] = q; } }
            if (!FINAL) { const float v = fq == 0 ? qv[0] : fq == 1 ? qv[1] : fq == 2 ? qv[2] : qv[3];
                ssp[(size_t)(u.pn * 4 + wc) * T + u.pm * BM + ai * HALF + wr * 64 + lane_] = v; }
            asm volatile("" ::: "memory"); }
    }
};

struct EpiFnetSym {
    static constexpr bool PERM = true;
    bf16* Y; const bf16* Ab; const float* xcm; int L; float cs;
    __device__ __forceinline__ void pre(const Unit&, int, int, int, float (&)[8]) const {}
    __device__ __forceinline__ void operator()(const f32x4 (&acc)[2][2][4][2], const Unit& u, int wr, int wc, int fr, int fq, const float (&)[8]) const {
        const int row0 = u.pm * BM + wr * 64 + fr, col0 = u.pn * BM + wc * 32 + 8 * fq;
        f32x4 b0[2], b1[2];
#pragma unroll
        for (int bj = 0; bj < 2; ++bj) { b0[bj] = *(const f32x4*)(xcm + u.roff + col0 + bj * HALF); b1[bj] = *(const f32x4*)(xcm + u.roff + col0 + bj * HALF + 4); }
#pragma unroll
        for (int ai = 0; ai < 2; ++ai)
#pragma unroll
            for (int m = 0; m < 4; ++m) { const int row = row0 + ai * HALF + m * 16; const float sg = (row & 1) ? -1.f : 1.f;
                const bf16* ap = Ab + u.aoff + (size_t)row * 512 + col0;
                bf16* y1 = Y + u.ooff + (size_t)row * D + col0; bf16* y2 = Y + u.ooff + (size_t)(L - row) * D + col0;
#pragma unroll
                for (int bj = 0; bj < 2; ++bj) { const u32x4 a = *(const u32x4*)(ap + bj * HALF);
                    f32x4 a0 = {bflo(a[0]), bfhi(a[0]), bflo(a[1]), bfhi(a[1])}, a1 = {bflo(a[2]), bfhi(a[2]), bflo(a[3]), bfhi(a[3])};
                    a0 = a0 + b0[bj] * sg; a1 = a1 + b1[bj] * sg;
                    const f32x4 p0 = (a0 + acc[ai][bj][m][0]) * cs, p1 = (a1 + acc[ai][bj][m][1]) * cs, q0 = (a0 - acc[ai][bj][m][0]) * cs, q1 = (a1 - acc[ai][bj][m][1]) * cs;
                    u32x4 w; w.x = cvt_pk_bf16(p0[0], p0[1]); w.y = cvt_pk_bf16(p0[2], p0[3]); w.z = cvt_pk_bf16(p1[0], p1[1]); w.w = cvt_pk_bf16(p1[2], p1[3]);
                    *(u32x4*)(y1 + bj * HALF) = w;
                    if (row > 0) { u32x4 v; v.x = cvt_pk_bf16(q0[0], q0[1]); v.y = cvt_pk_bf16(q0[2], q0[3]); v.z = cvt_pk_bf16(q1[0], q1[1]); v.w = cvt_pk_bf16(q1[2], q1[3]);
                        *(u32x4*)(y2 + bj * HALF) = v; } } }
    }
};

template <class Epi, class Sched>
__device__ __forceinline__ void gemm_phase(LAS unsigned char* lds, const int K, const int lda, const int ldb, const Sched& S, const Epi& E, const int widS) {
    const int tid = opaque_tid(widS), wid = __builtin_amdgcn_readfirstlane(tid >> 6), lane = tid & 63, wr = wid >> 2, wc = wid & 3, fr = lane & 15, fq = lane >> 4;
    const int nt = K / BK;
    unsigned voffA[2], voffB[2];
#pragma unroll
    for (int i = 0; i < 2; ++i) { int R, C; stage_rc(tid * 16 + i * 8192, R, C); const int Rb = Epi::PERM ? ((R & ~31) + perm32(R & 31)) : R;
        voffA[i] = (unsigned)(R * lda + C) * 2u; voffB[i] = (unsigned)(Rb * ldb + C) * 2u; }
    const size_t kstep = (size_t)(BK * 2);
    const size_t hstepA = (size_t)HALF * lda * 2, hstepB = (size_t)HALF * ldb * 2;
    const unsigned ldsw = (unsigned)wid * 1024u;
    const int aoff = lds_byte(wr * 64 + fr, fq * 8), boff = lds_byte(wc * 32 + fr, fq * 8);
#define PG8_SA(b, h) (((b) * 2 + (h)) * HTB)
#define PG8_SB(b, h) ((4 + (b) * 2 + (h)) * HTB)
#define PG8_STAGE(bufoff, gbase, voff) do { _Pragma("unroll") for (int _i = 0; _i < 2; ++_i) \
        __builtin_amdgcn_global_load_lds((const unsigned*)((const char*)(gbase) + (voff)[_i]), (LAS unsigned*)(lds + (bufoff) + ldsw + _i * 8192), 16, 0, 0); } while (0)
#define PG8_LDA(dst, b, h) do { _Pragma("unroll") for (int m = 0; m < 4; ++m) _Pragma("unroll") for (int k = 0; k < 2; ++k) dst[m][k] = *(const LAS bf16x8*)(lds + PG8_SA(b, h) + aoff + m * 2048 + k * 1024); } while (0)
#define PG8_LDB(dst, b, h) do { _Pragma("unroll") for (int n = 0; n < 2; ++n) _Pragma("unroll") for (int k = 0; k < 2; ++k) dst[n][k] = *(const LAS bf16x8*)(lds + PG8_SB(b, h) + boff + n * 2048 + k * 1024); } while (0)
#define PG8_MMA(ai, bj, At, Bt) do { __builtin_amdgcn_s_setprio(1); _Pragma("unroll") for (int m = 0; m < 4; ++m) _Pragma("unroll") for (int n = 0; n < 2; ++n) _Pragma("unroll") for (int k = 0; k < 2; ++k) \
        acc[ai][bj][m][n] = __builtin_amdgcn_mfma_f32_16x16x32_bf16(Bt[n][k], At[m][k], acc[ai][bj][m][n], 0, 0, 0); __builtin_amdgcn_s_setprio(0); } while (0)
#define PG8_WAIT_V(n) asm volatile("s_waitcnt vmcnt(" #n ")" ::: "memory")
#define PG8_WAIT_L(n) asm volatile("s_waitcnt lgkmcnt(" #n ")" ::: "memory")
#define PG8_BAR __builtin_amdgcn_s_barrier()
#define PG8_SCHED __builtin_amdgcn_sched_barrier(0)
    Unit cur, nxt; int ui = 0;
    if (!S.next(0, cur)) return;
    f32x4 acc[2][2][4][2];
#pragma unroll
    for (int a = 0; a < 2; ++a)
#pragma unroll
        for (int b = 0; b < 2; ++b)
#pragma unroll
            for (int m = 0; m < 4; ++m)
#pragma unroll
                for (int n = 0; n < 2; ++n) acc[a][b][m][n] = (f32x4){0.f, 0.f, 0.f, 0.f};
    bf16x8 At[4][2], B0[2][2], B1[2][2];
    const char* cA = cur.a; const char* cB = cur.b;
    float pv[8]; E.pre(cur, wr, fr, fq, pv);
    PG8_STAGE(PG8_SB(0, 0), cB, voffB); PG8_STAGE(PG8_SB(0, 1), cB + hstepB, voffB); PG8_STAGE(PG8_SA(0, 0), cA, voffA); PG8_STAGE(PG8_SA(0, 1), cA + hstepA, voffA);
    PG8_STAGE(PG8_SB(1, 0), cB + kstep, voffB); PG8_STAGE(PG8_SA(1, 0), cA + kstep, voffA); PG8_STAGE(PG8_SB(1, 1), cB + hstepB + kstep, voffB);
    if (wr == 1) PG8_BAR;
    PG8_WAIT_V(8); PG8_BAR;
    PG8_WAIT_V(6); PG8_BAR;
    for (;;) {
        const bool has_next = S.next(ui + 1, nxt);
        const char* nA = has_next ? nxt.a : cA; const char* nB = has_next ? nxt.b : cB;
#define PG8_WAIT_V8R(flag) asm volatile("s_waitcnt vmcnt(24)\n\ts_cmp_eq_u32 %0, 0\n\ts_cbranch_scc0 .Lpg8r_%=\n\ts_waitcnt vmcnt(8)\n.Lpg8r_%=:" :: "s"(flag) : "memory", "scc")
        for (int t = 0; t < nt; t += 2) {
            const bool last = (t == nt - 2);
            const int relax = __builtin_amdgcn_readfirstlane((int)(t == 0) & (int)(ui > 0));
            const char* a1 = cA + (size_t)(t + 1) * kstep;
            const char* a2 = last ? nA : cA + (size_t)(t + 2) * kstep; const char* b2 = last ? nB : cB + (size_t)(t + 2) * kstep;
            const char* a3 = a2 + kstep; const char* b3 = b2 + kstep;
            PG8_LDB(B0, 0, 0); PG8_LDB(B1, 0, 1); PG8_SCHED; PG8_LDA(At, 0, 0); PG8_STAGE(PG8_SA(1, 1), a1 + hstepA, voffA);
            PG8_WAIT_V8R(relax); PG8_WAIT_L(0); PG8_BAR; PG8_MMA(0, 0, At, B0); PG8_MMA(0, 1, At, B1); PG8_BAR; PG8_SCHED;
            PG8_LDA(At, 0, 1); PG8_STAGE(PG8_SB(0, 0), b2, voffB); PG8_STAGE(PG8_SB(0, 1), b2 + hstepB, voffB); PG8_STAGE(PG8_SA(0, 0), a2, voffA);
            PG8_WAIT_V8R(relax); PG8_WAIT_L(0); PG8_BAR; PG8_MMA(1, 0, At, B0); PG8_MMA(1, 1, At, B1); PG8_BAR; PG8_SCHED;
            PG8_LDB(B0, 1, 0); PG8_LDB(B1, 1, 1); PG8_SCHED; PG8_LDA(At, 1, 0); PG8_STAGE(PG8_SA(0, 1), a2 + hstepA, voffA);
            PG8_WAIT_V(8); PG8_WAIT_L(0); PG8_BAR; PG8_MMA(0, 0, At, B0); PG8_MMA(0, 1, At, B1); PG8_BAR; PG8_SCHED;
            PG8_LDA(At, 1, 1); PG8_STAGE(PG8_SB(1, 0), b3, voffB); PG8_STAGE(PG8_SB(1, 1), b3 + hstepB, voffB); PG8_STAGE(PG8_SA(1, 0), a3, voffA);
            PG8_WAIT_V(8); PG8_WAIT_L(0); PG8_BAR; PG8_MMA(1, 0, At, B0); PG8_MMA(1, 1, At, B1); PG8_BAR; PG8_SCHED;
        }
#undef PG8_WAIT_V8R
        if (wr == 0) PG8_BAR;
        E(acc, cur, wr, wc, fr, fq, pv);
        if (!has_next) break;
#pragma unroll
        for (int a = 0; a < 2; ++a)
#pragma unroll
            for (int b = 0; b < 2; ++b)
#pragma unroll
                for (int m = 0; m < 4; ++m)
#pragma unroll
                    for (int n = 0; n < 2; ++n) acc[a][b][m][n] = (f32x4){0.f, 0.f, 0.f, 0.f};
        cur = nxt; cA = nA; cB = nB; ++ui;
        E.pre(cur, wr, fr, fq, pv);
        if (wr == 1) PG8_BAR;
    }
    PG8_WAIT_V(0);
    PG8_BAR;
#undef PG8_SA
#undef PG8_SB
#undef PG8_STAGE
#undef PG8_LDA
#undef PG8_LDB
#undef PG8_MMA
#undef PG8_WAIT_V
#undef PG8_WAIT_L
#undef PG8_BAR
#undef PG8_SCHED
}
}

namespace att {
constexpr int NW = 8, QBLK = 32, KVBLK = 64, DV = 128;
constexpr int SHM_V = KVBLK * DV * 2;
template <int DQK> struct Geo { static constexpr int KROW = DQK * 2, SHM_K = KVBLK * KROW, NQ = DQK / 16, CPR = DQK / 8  , NKI = SHM_K / 8192  ; };
template <int DQK> __device__ __forceinline__ int kswz(int row) { return DQK == 192 ? ((row >> 1) & 7) : (row & 15); }
#define SBAR() __builtin_amdgcn_sched_barrier(0)
__device__ __forceinline__ int crow(int r, int hi) { return (r & 3) + 8 * (r >> 2) + 4 * hi; }
template <bool FIRST>
__device__ __forceinline__ void partialSM(f32x16& p0, f32x16& p1, f32x16& negm, float& alpha, float& l_reg) {
    constexpr float THR2 = 8.f * 1.4426950408889634f;
    float pmax = p0[0];
#pragma unroll
    for (int r = 1; r < 16; ++r) pmax = fmaxf(pmax, p0[r]);
#pragma unroll
    for (int r = 0; r < 16; ++r) pmax = fmaxf(pmax, p1[r]);
    { auto rr = __builtin_amdgcn_permlane32_swap(__float_as_uint(pmax), __float_as_uint(pmax), false, false);
      pmax = fmaxf(__uint_as_float(rr[0]), __uint_as_float(rr[1])); }
    if (!FIRST && __builtin_expect(__all(pmax <= THR2), 1)) { alpha = 1.f; }
    else { const float d = FIRST ? pmax : fmaxf(pmax, 0.f); alpha = FIRST ? 1.f : __builtin_amdgcn_exp2f(-d); if (!FIRST) l_reg *= alpha;
#pragma unroll
        for (int r = 0; r < 16; ++r) { p0[r] -= d; p1[r] -= d; negm[r] -= d; } }
#pragma unroll
    for (int r = 0; r < 16; ++r) p0[r] = __builtin_amdgcn_exp2f(p0[r]);
}
__device__ __forceinline__ void finishSM(f32x16& p0, f32x16& p1, float& l_reg, bf16x8& pa0, bf16x8& pa1, bf16x8& pa2, bf16x8& pa3) {
#pragma unroll
    for (int r = 0; r < 16; ++r) p1[r] = __builtin_amdgcn_exp2f(p1[r]);
    float ps = 0;
#pragma unroll
    for (int r = 0; r < 16; ++r) ps += p0[r];
#pragma unroll
    for (int r = 0; r < 16; ++r) ps += p1[r];
    { auto rr = __builtin_amdgcn_permlane32_swap(__float_as_uint(ps), __float_as_uint(ps), false, false);
      ps = __uint_as_float(rr[0]) + __uint_as_float(rr[1]); }
    l_reg += ps;
#define PK4(P, BASE, OUT) do { u32x4 w; w[0] = cvt_pk_bf16(P[BASE + 0], P[BASE + 1]); w[1] = cvt_pk_bf16(P[BASE + 2], P[BASE + 3]);   \
    w[2] = cvt_pk_bf16(P[BASE + 4], P[BASE + 5]); w[3] = cvt_pk_bf16(P[BASE + 6], P[BASE + 7]);     \
    { auto r0 = __builtin_amdgcn_permlane32_swap(w[0], w[2], false, false); w[0] = r0[0]; w[2] = r0[1]; } \
    { auto r1 = __builtin_amdgcn_permlane32_swap(w[1], w[3], false, false); w[1] = r1[0]; w[3] = r1[1]; } \
    OUT = *reinterpret_cast<bf16x8*>(&w); } while (0)
    PK4(p0, 0, pa0); PK4(p0, 8, pa1); PK4(p1, 0, pa2); PK4(p1, 8, pa3);
#undef PK4
}
template <int DQK> struct KAddr { static constexpr int KB = DQK == 192 ? 4 : 8; };
template <int DQK>
__device__ __forceinline__ void qkt(f32x16& p0, f32x16& p1, const char* Kt  , const int kx  , const bf16x8* qr, const f32x16& negm) {
    constexpr int NQ = Geo<DQK>::NQ, RB = 32 * Geo<DQK>::KROW, KB = KAddr<DQK>::KB;
#define KOFF(d0) (((32 * ((d0) % KB)) ^ kx) + ((d0) / KB) * 32 * KB)
    const char* Ksl = Kt;
    bf16x8 f0[2], f1[2];
    f0[0] = *reinterpret_cast<const bf16x8*>(Ksl + KOFF(0)); f1[0] = *reinterpret_cast<const bf16x8*>(Ksl + KOFF(0) + RB);
    __builtin_amdgcn_sched_group_barrier(0x100, 2, 0);
#pragma unroll
    for (int d0 = 0; d0 < NQ; ++d0) {
        if (d0 + 1 < NQ) { f0[(d0 + 1) & 1] = *reinterpret_cast<const bf16x8*>(Ksl + KOFF(d0 + 1)); f1[(d0 + 1) & 1] = *reinterpret_cast<const bf16x8*>(Ksl + KOFF(d0 + 1) + RB); }
        if (d0 == 0) {
            asm("v_mfma_f32_32x32x16_bf16 %0, %1, %2, %3" : "=&v"(p0) : "v"(f0[0]), "v"(qr[0]), "v"(negm));
            asm("v_mfma_f32_32x32x16_bf16 %0, %1, %2, %3" : "=&v"(p1) : "v"(f1[0]), "v"(qr[0]), "v"(negm));
        } else {
            p0 = __builtin_amdgcn_mfma_f32_32x32x16_bf16(f0[d0 & 1], qr[d0], p0, 0, 0, 0);
            p1 = __builtin_amdgcn_mfma_f32_32x32x16_bf16(f1[d0 & 1], qr[d0], p1, 0, 0, 0); }
        __builtin_amdgcn_sched_group_barrier(0x100, 2, 0); __builtin_amdgcn_sched_group_barrier(0x8, 2, 0); }
#undef KOFF
}
__device__ __forceinline__ int v_st(int k, int c) { const int kk = (k & ~0xC) | ((k & 4) << 1) | ((k & 8) >> 1); return ((kk >> 3) * 4 + (c >> 5)) * 512 + ((kk & 7) * 32 + (c & 31)) * 2; }
__device__ __forceinline__ int v_rd_base(int lane) { return ((lane & 3) << 3) | (((lane >> 2) & 3) << 6) | (((lane >> 4) & 1) << 5) | (((lane >> 5) & 1) << 8); }
constexpr int v_rd_off(int d0, int ks, int half) { return d0 * 512 + ks * 4096 + half * 2048; }
template <int OFF> __device__ __forceinline__ s16x4 tr_read(int vb) {
    s16x4 r; asm volatile("ds_read_b64_tr_b16 %0, %1 offset:%2" : "=&v"(r) : "v"(vb), "i"(OFF) : "memory"); return r;
}
template <int D0> __device__ __forceinline__ void pv_one(f32x16& od, int vb, bf16x8 pa0, bf16x8 pa1, bf16x8 pa2, bf16x8 pa3) {
    const s16x4 l0 = tr_read<v_rd_off(D0, 0, 0)>(vb), h0 = tr_read<v_rd_off(D0, 0, 1)>(vb), l1 = tr_read<v_rd_off(D0, 1, 0)>(vb), h1 = tr_read<v_rd_off(D0, 1, 1)>(vb);
    const s16x4 l2 = tr_read<v_rd_off(D0, 2, 0)>(vb), h2 = tr_read<v_rd_off(D0, 2, 1)>(vb), l3 = tr_read<v_rd_off(D0, 3, 0)>(vb), h3 = tr_read<v_rd_off(D0, 3, 1)>(vb);
    asm volatile("s_waitcnt lgkmcnt(0)" ::: "memory"); SBAR();
#define PK(L, H) (bf16x8){L[0], L[1], L[2], L[3], H[0], H[1], H[2], H[3]}
    od = __builtin_amdgcn_mfma_f32_32x32x16_bf16(pa0, PK(l0, h0), od, 0, 0, 0);
    od = __builtin_amdgcn_mfma_f32_32x32x16_bf16(pa1, PK(l1, h1), od, 0, 0, 0);
    od = __builtin_amdgcn_mfma_f32_32x32x16_bf16(pa2, PK(l2, h2), od, 0, 0, 0);
    od = __builtin_amdgcn_mfma_f32_32x32x16_bf16(pa3, PK(l3, h3), od, 0, 0, 0);
#undef PK
}
__device__ __forceinline__ void pv_d0(f32x16* o, int vb, bf16x8 pa0, bf16x8 pa1, bf16x8 pa2, bf16x8 pa3) {
    pv_one<0>(o[0], vb, pa0, pa1, pa2, pa3); pv_one<1>(o[1], vb, pa0, pa1, pa2, pa3); pv_one<2>(o[2], vb, pa0, pa1, pa2, pa3); pv_one<3>(o[3], vb, pa0, pa1, pa2, pa3);
}

template <int DQK, bool ROPE>
__device__ __forceinline__ void attn_unit(const bf16* __restrict__ Qb, int ldq, const bf16* __restrict__ Kh, int ldk, const bf16* __restrict__ Vh, int ldv,
                                          bf16* __restrict__ Ob, int ldo, int nkeys, const float* __restrict__ qg, const float* __restrict__ ropec, const float* __restrict__ ropes,
                                          int pos0, const float sm_scale, const float* __restrict__ qrs, char* lds, const int widS) {
    using G = Geo<DQK>; constexpr int NQ = G::NQ;
    const int tid = opaque_tid(widS), wid = __builtin_amdgcn_readfirstlane(tid >> 6), lane = tid & 63, r32 = lane & 31, hi = lane >> 5;
    char* V_lds = lds; char* K_lds = lds + 3 * SHM_V;
    float* wsp = (float*)(lds + 3 * SHM_V + 2 * G::SHM_K) + wid * 64; float* li_l = wsp; float* al_l = wsp + 32;
    const float C = sm_scale * 1.4426950408889634f;
    float l_reg = 0; f32x16 o[4] = {}; f32x16 negm = {}; bf16x8 qr[NQ];
    {
        const bf16* Qw = Qb + (long)(wid * QBLK + r32) * ldq + hi * 8;
        u32x4 raw[NQ]; float ssq = 0.f;
#pragma unroll
        for (int d0 = 0; d0 < NQ; ++d0) { raw[d0] = *reinterpret_cast<const u32x4*>(Qw + d0 * 16);
#pragma unroll
            for (int j = 0; j < 4; ++j) { const float a = bflo(raw[d0][j]), b = bfhi(raw[d0][j]); ssq += a * a + b * b; } }
        ssq += shx(ssq, 32, lane);
        const float qs_ = qrs ? qrs[wid * QBLK + r32] : 1.f;
        const float rstd = C * qs_ * rsqrtf(qs_ * qs_ * ssq * (1.0f / DQK) + EPS);
        constexpr int NPLAIN = ROPE ? 8 : NQ;
#pragma unroll
        for (int d0 = 0; d0 < NPLAIN; ++d0) { const f32x4 g0 = *reinterpret_cast<const f32x4*>(qg + d0 * 16 + hi * 8), g1 = *reinterpret_cast<const f32x4*>(qg + d0 * 16 + hi * 8 + 4);
            u32x4 w;
#pragma unroll
            for (int j = 0; j < 4; ++j) { const float gl = j < 2 ? g0[2 * j] : g1[2 * j - 4], gh = j < 2 ? g0[2 * j + 1] : g1[2 * j - 3]; w[j] = cvt_pk_bf16(bflo(raw[d0][j]) * rstd * gl, bfhi(raw[d0][j]) * rstd * gh); }
            qr[d0] = *reinterpret_cast<bf16x8*>(&w); }
        if constexpr (ROPE) {
            const long pos = pos0 + wid * QBLK + r32;
#pragma unroll
            for (int dd = 0; dd < 2; ++dd) { const int d0 = 8 + dd, i0 = dd * 16 + hi * 8;
                float cs[8], sn[8], ga[8], gb[8];
                { const f32x4 c0 = *reinterpret_cast<const f32x4*>(ropec + pos * 32 + i0), c1 = *reinterpret_cast<const f32x4*>(ropec + pos * 32 + i0 + 4);
                  const f32x4 s0 = *reinterpret_cast<const f32x4*>(ropes + pos * 32 + i0), s1 = *reinterpret_cast<const f32x4*>(ropes + pos * 32 + i0 + 4);
                  const f32x4 a0 = *reinterpret_cast<const f32x4*>(qg + d0 * 16 + hi * 8), a1 = *reinterpret_cast<const f32x4*>(qg + d0 * 16 + hi * 8 + 4);
                  const f32x4 b0 = *reinterpret_cast<const f32x4*>(qg + (d0 + 2) * 16 + hi * 8), b1 = *reinterpret_cast<const f32x4*>(qg + (d0 + 2) * 16 + hi * 8 + 4);
#pragma unroll
                  for (int j = 0; j < 4; ++j) { cs[j] = c0[j]; cs[4 + j] = c1[j]; sn[j] = s0[j]; sn[4 + j] = s1[j]; ga[j] = a0[j]; ga[4 + j] = a1[j]; gb[j] = b0[j]; gb[4 + j] = b1[j]; } }
                u32x4 w1, w2;
#pragma unroll
                for (int j = 0; j < 4; ++j) {
                    const float x1l = bflo(raw[d0][j]) * rstd * ga[2 * j], x1h = bfhi(raw[d0][j]) * rstd * ga[2 * j + 1];
                    const float x2l = bflo(raw[d0 + 2][j]) * rstd * gb[2 * j], x2h = bfhi(raw[d0 + 2][j]) * rstd * gb[2 * j + 1];
                    w1[j] = cvt_pk_bf16(x1l * cs[2 * j] - x2l * sn[2 * j], x1h * cs[2 * j + 1] - x2h * sn[2 * j + 1]);
                    w2[j] = cvt_pk_bf16(x1l * sn[2 * j] + x2l * cs[2 * j], x1h * sn[2 * j + 1] + x2h * cs[2 * j + 1]); }
                qr[d0] = *reinterpret_cast<bf16x8*>(&w1); qr[d0 + 2] = *reinterpret_cast<bf16x8*>(&w2); }
        }
    }
    const int vb0 = (int)(uintptr_t)V_lds + v_rd_base(lane);
    unsigned kgo[G::NKI], vgo[1];
#pragma unroll
    for (int t = 0; t < G::NKI; ++t) { const int q = (wid * G::NKI + t) * 64 + lane, row = q / G::CPR, pc = q % G::CPR; kgo[t] = (unsigned)(row * ldk * 2 + ((pc ^ kswz<DQK>(row)) * 16)); }
#pragma unroll
    for (int t = 0; t < 1; ++t) { const int q = (wid * 2 + t) * 64 + lane, sub = q >> 5, within = q & 31;   const int kk = ((sub >> 2) << 3) | (within >> 2), cc = (sub & 3) * 32 + (within & 3) * 8;
        const int key = (kk & ~0xC) | ((kk & 4) << 1) | ((kk & 8) >> 1); vgo[t] = (unsigned)(key * ldv * 2 + cc * 2); }
    const int koffs = r32 * G::KROW + (hi ^ kswz<DQK>(r32)) * 16;
    const char* Kg = (const char*)Kh; const char* Vg = (const char*)Vh;
#define SDMA(tile, kslot, vslot) do { const char* kb_ = Kg + (size_t)(tile) * KVBLK * ldk * 2; const char* vb_ = Vg + (size_t)(tile) * KVBLK * ldv * 2; \
    asm volatile("" : "+s"(kb_), "+s"(vb_));     \
    _Pragma("unroll") for (int t_ = 0; t_ < G::NKI; ++t_) { unsigned ko_ = kgo[t_]; asm volatile("" : "+v"(ko_)); __builtin_amdgcn_global_load_lds((const unsigned*)(kb_ + ko_), (LAS unsigned*)(K_lds + (kslot) * G::SHM_K + (wid * G::NKI + t_) * 1024), 16, 0, 0); } \
    _Pragma("unroll") for (int t_ = 0; t_ < 2; ++t_) { unsigned vo_ = vgo[0] + t_ * 128; asm volatile("" : "+v"(vo_)); __builtin_amdgcn_global_load_lds((const unsigned*)(vb_ + vo_), (LAS unsigned*)(V_lds + (vslot) * SHM_V + (wid * 2 + t_) * 1024), 16, 0, 0); } } while (0)
#define RESC(a) do { if (__any((a) < 1.f)) { if (hi == 0) al_l[r32] = (a); asm volatile("s_waitcnt lgkmcnt(0)" ::: "memory"); \
    _Pragma("unroll") for (int d = 0; d < 4; ++d) _Pragma("unroll") for (int r = 0; r < 16; ++r) o[d][r] *= al_l[crow(r, hi)]; } } while (0)
    f32x16 pA0, pA1, pB0, pB1; bf16x8 pa0, pa1, pa2, pa3; const int NT = nkeys / KVBLK;
    const char* Ksl = K_lds;
    SDMA(0, 0, 0); __syncthreads();
    SDMA(1, 1, 1);
    qkt<DQK>(pA0, pA1, Ksl, koffs, qr, negm); { float al0; partialSM<true>(pA0, pA1, negm, al0, l_reg); }
    __syncthreads();
    int vs = 0;
    for (int j = 1; j + 1 < NT; j += 2) {
        const int v1 = vs == 2 ? 0 : vs + 1, v2 = v1 == 2 ? 0 : v1 + 1;
        SDMA(j + 1, 0, v2);
        SBAR(); qkt<DQK>(pB0, pB1, Ksl + G::SHM_K, koffs, qr, negm);
        finishSM(pA0, pA1, l_reg, pa0, pa1, pa2, pa3); SBAR();
        pv_d0(o, vb0 + vs * SHM_V, pa0, pa1, pa2, pa3); { float al_; partialSM<false>(pB0, pB1, negm, al_, l_reg); RESC(al_); } __syncthreads();
        const int v3 = v2 == 2 ? 0 : v2 + 1;
        SDMA(j + 2, 1, v3);
        SBAR(); qkt<DQK>(pA0, pA1, Ksl, koffs, qr, negm);
        finishSM(pB0, pB1, l_reg, pa0, pa1, pa2, pa3); SBAR();
        pv_d0(o, vb0 + v1 * SHM_V, pa0, pa1, pa2, pa3); { float al_; partialSM<false>(pA0, pA1, negm, al_, l_reg); RESC(al_); } __syncthreads();
        vs = v2;
    }
    {   const int v1 = vs == 2 ? 0 : vs + 1;
        SBAR(); qkt<DQK>(pB0, pB1, Ksl + G::SHM_K, koffs, qr, negm);
        finishSM(pA0, pA1, l_reg, pa0, pa1, pa2, pa3); SBAR();
        pv_d0(o, vb0 + vs * SHM_V, pa0, pa1, pa2, pa3); { float al_; partialSM<false>(pB0, pB1, negm, al_, l_reg); RESC(al_); }
        finishSM(pB0, pB1, l_reg, pa0, pa1, pa2, pa3); SBAR();
        pv_d0(o, vb0 + v1 * SHM_V, pa0, pa1, pa2, pa3); }
    if (hi == 0) li_l[r32] = l_reg; asm volatile("s_waitcnt lgkmcnt(0)" ::: "memory");
    const int lane_e = opaque_lane(), hi_e = lane_e >> 5;
    float rli[16];
#pragma unroll
    for (int r = 0; r < 16; ++r) rli[r] = __builtin_amdgcn_rcpf(li_l[crow(r, hi_e)]);
    bf16* Ow = Ob + (long)(wid * QBLK) * ldo;
    char* ost = lds + 3 * SHM_V + 2 * G::SHM_K + 2048 + wid * 4608;
#pragma unroll
    for (int h = 0; h < 2; ++h) {
#pragma unroll
        for (int r = 0; r < 16; ++r) { const unsigned w = cvt_pk_bf16(o[2 * h][r] * rli[r], o[2 * h + 1][r] * rli[r]); char* q = ost + crow(r, hi_e) * 144 + (lane_e & 31) * 2;
            *(unsigned short*)q = (unsigned short)(w & 0xffffu); *(unsigned short*)(q + 64) = (unsigned short)(w >> 16); }
        asm volatile("s_waitcnt lgkmcnt(0)" ::: "memory");
#pragma unroll
        for (int i = 0; i < 4; ++i) { const int row = (lane_e >> 3) + 8 * i; const u32x4 v = *(const u32x4*)(ost + row * 144 + (lane_e & 7) * 16);
            *(u32x4*)(Ow + (long)row * ldo + h * 64 + (lane_e & 7) * 8) = v; }
    }
    __syncthreads();
#undef SDMA
#undef RESC
}
}

#define XB_TMO      128
#define XB_XCNT(j)  (256  + 64 * (j))
#define XB_XSUB(j)  (1280 + 64 * (j))
#define XB_XGEN(j)  (2304 + 64 * (j))
#define XB_TOP      3328
#define XB_TOPGEN   3392
#define XCD_BAR_WORDS 3456
#define XB_SPIN_CAP (1u << 20)
__device__ __forceinline__ unsigned xb_ld(unsigned* p)              { return __hip_atomic_load(p, __ATOMIC_RELAXED, __HIP_MEMORY_SCOPE_AGENT); }
__device__ __forceinline__ unsigned xb_add(unsigned* p, unsigned v) { return __hip_atomic_fetch_add(p, v, __ATOMIC_RELAXED, __HIP_MEMORY_SCOPE_AGENT); }
__device__ __forceinline__ unsigned xb_xcc_id() { return (unsigned)__builtin_amdgcn_s_getreg((3 << 11) | 20) & 0xFu; }
#define XB_SPIN(cond, bar) do { unsigned _sp = 0; while (cond) { __builtin_amdgcn_s_sleep(1); \
    if ((++_sp & 255u) == 0u) { if (xb_ld(&(bar)[XB_TMO])) break; if (_sp > XB_SPIN_CAP) { atomicAdd(&(bar)[XB_TMO], 1u); break; } } } } while (0)
struct XcdBarrier { unsigned* bar; unsigned x; volatile LAS unsigned* st; int w; };
__device__ __forceinline__ XcdBarrier xcd_barrier_post(unsigned* bar, volatile LAS unsigned* st) {
    XcdBarrier b; b.bar = bar; b.x = xb_xcc_id(); b.st = st;
    if (threadIdx.x == 0) (void)xb_add(&bar[XB_XCNT(b.x)], 1u);
    return b;
}
__device__ __forceinline__ void xcd_barrier_complete(unsigned* bar, unsigned x, unsigned& nloc, unsigned& nx) {
    const unsigned G = gridDim.x * gridDim.y * gridDim.z;
    unsigned sum, cnt, mine, sp = 0u;
    for (;;) {
        sum = 0u; cnt = 0u; mine = 0u;
#pragma unroll
        for (unsigned j = 0; j < 16; ++j) { const unsigned c = xb_ld(&bar[XB_XCNT(j)]); sum += c; cnt += (c > 0u) ? 1u : 0u; mine = (j == x) ? c : mine; }
        if (sum == G) break;
        __builtin_amdgcn_s_sleep(1);
        if ((++sp & 255u) == 0u) { if (xb_ld(&bar[XB_TMO])) break; if (sp > XB_SPIN_CAP) { atomicAdd(&bar[XB_TMO], 1u); break; } }
    }
    nloc = mine > 0u ? mine : 1u; nx = cnt > 0u ? cnt : 1u;
}
__device__ __forceinline__ void xcd_barrier(const XcdBarrier& b) {
    asm volatile("s_waitcnt vmcnt(0)" ::: "memory");
    __syncthreads();
    if (opaque_tid(b.w) == 0) {
        unsigned* bar = b.bar;
        __builtin_amdgcn_s_waitcnt(0);
        unsigned nloc = b.st[0], nx = b.st[1];
        if (nloc == 0u) { xcd_barrier_complete(bar, b.x, nloc, nx); b.st[0] = nloc; b.st[1] = nx; }
        const unsigned old = xb_add(&bar[XB_XSUB(b.x)], 1u);
        const unsigned gen = old / nloc;
        if (old + 1u == (gen + 1u) * nloc) {
            __builtin_amdgcn_fence(__ATOMIC_RELEASE, "agent");
            asm volatile("s_waitcnt vmcnt(0)" ::: "memory");
            const unsigned og = xb_add(&bar[XB_TOP], 1u);
            const unsigned tg = og / nx;
            if (og + 1u == (tg + 1u) * nx) xb_add(&bar[XB_TOPGEN], 1u);
            else XB_SPIN(xb_ld(&bar[XB_TOPGEN]) == tg, bar);
            __builtin_amdgcn_fence(__ATOMIC_ACQUIRE, "agent");
            xb_add(&bar[XB_XGEN(b.x)], 1u);
            asm volatile("s_waitcnt vmcnt(0)" ::: "memory");
        } else {
            XB_SPIN(xb_ld(&bar[XB_XGEN(b.x)]) == gen, bar);
            __builtin_amdgcn_fence(__ATOMIC_ACQUIRE, "agent");
            asm volatile("s_waitcnt vmcnt(0)" ::: "memory");
        }
    }
    __syncthreads();
}

template <int MODE>
__device__ __forceinline__ void transpose_item(const float* __restrict__ W, int K, int N, bf16* __restrict__ WT, const float* __restrict__ gk, LAS float* scr, int item, int lane) {
    const int nblk = N / 32, kb = item / nblk, nb = item % nblk, k0 = 128 * kb, n0 = 32 * nb;
    const int kq = lane >> 3, n4 = (lane & 7) * 4, c = lane & 7; f32x4 w[16];
#pragma unroll
    for (int i = 0; i < 16; ++i) w[i] = *(const f32x4*)(W + (size_t)(k0 + kq + 8 * i) * N + n0 + n4);
    if (gk) {
#pragma unroll
        for (int i = 0; i < 16; ++i) { const float g = gk[k0 + kq + 8 * i]; w[i] = w[i] * g; } }
#pragma unroll
    for (int h = 0; h < 2; ++h) {
#pragma unroll
        for (int i = 0; i < 8; ++i) { LAS float* d = scr + (kq + 8 * i) * 33 + n4; d[0] = w[8 * h + i].x; d[1] = w[8 * h + i].y; d[2] = w[8 * h + i].z; d[3] = w[8 * h + i].w; }
        LDS_WAIT(); asm volatile("" ::: "memory");
#pragma unroll
        for (int j = 0; j < 4; ++j) { const int n = (lane >> 3) + 8 * j; const LAS float* sp = scr + (8 * c) * 33 + n;
            u32x4 o; o.x = cvt_pk_bf16(sp[0 * 33], sp[1 * 33]); o.y = cvt_pk_bf16(sp[2 * 33], sp[3 * 33]); o.z = cvt_pk_bf16(sp[4 * 33], sp[5 * 33]); o.w = cvt_pk_bf16(sp[6 * 33], sp[7 * 33]);
            int nn = n0 + n; if (MODE == 1) { const int hh = nn >> 8, jj = nn & 255; nn = hh * 320 + (jj < 128 ? jj : jj + 64); }
            *(u32x4*)(WT + (size_t)nn * K + k0 + 64 * h + 8 * c) = o; }
        LDS_WAIT(); asm volatile("" ::: "memory");
    }
}
__device__ __forceinline__ void rms_row_to_bf16(const float* __restrict__ xrow, const float* __restrict__ g, bf16* __restrict__ orow, int lane) {
    const f32x4* xr = (const f32x4*)xrow + lane; f32x4 v[8]; float s = 0.f;
#pragma unroll
    for (int j = 0; j < 8; ++j) { v[j] = xr[64 * j]; s += (v[j].x * v[j].x + v[j].y * v[j].y) + (v[j].z * v[j].z + v[j].w * v[j].w); }
    const float r = rsqrtf(wave_sum(s, lane) * (1.f / D) + EPS);
    u32x2* o8 = (u32x2*)orow + lane;
#pragma unroll
    for (int j = 0; j < 8; ++j) { const f32x4 gg = ((const f32x4*)g)[lane + 64 * j]; u32x2 w; w.x = cvt_pk_bf16(v[j].x * r * gg.x, v[j].y * r * gg.y); w.y = cvt_pk_bf16(v[j].z * r * gg.z, v[j].w * r * gg.w); o8[64 * j] = w; }
}

template <int NK>
__device__ __forceinline__ void hgrn_scan_item(const bf16* __restrict__ Zv, int row0, int L, int hh, int dir, int kbase, const float* __restrict__ lbl, bf16* __restrict__ Oo,
                                               LAS unsigned char* lds, const unsigned char* lds_gen, int tid, int lane, int wave) {
    constexpr int NPAIR = NK / 2, NPART = 256 / NPAIR, SPT = 64 / NPART, QROW = NK * 2 + 16, ND0 = NK / 16, NKB = NK / 32;
    constexpr int O_KT = 64 * QROW, O_KTT = 128 * QROW, O_VL = 128 * QROW + NK * 144, O_FAC = O_VL + 16384, BUF = O_FAC + 3 * NK * 4;
    static_assert(2 * BUF + NPART * NK * 4 <= 147328, "HGRN LDS");
    LAS float* TOT = (LAS float*)(lds + 2 * BUF);
    const int nchunk = L >> 6;
#define HG_POS(n) (dir ? (L - 1 - (n)) : (n))
    if (wave >= 4) {
        const int ptid = tid - 256, kp = ptid % NPAIR, part = ptid / NPAIR, vr = ptid >> 4, sc = (ptid & 15) * 8;
        const int zc = hh * 128 + kbase + 2 * kp;
        float lb0, lb1; { const float* lg = lbl + dir * 2048 + zc; const f32x2 l0 = *(const f32x2*)lg, l1 = *(const f32x2*)(lg + 4096), l2 = *(const f32x2*)(lg + 8192), l3 = *(const f32x2*)(lg + 12288);
            { const float mx = fmaxf(fmaxf(l0.x, l1.x), fmaxf(l2.x, l3.x)); const float e0 = __expf(l0.x - mx), e1 = __expf(l1.x - mx), e2 = __expf(l2.x - mx), e3 = __expf(l3.x - mx); lb0 = e1 / (e0 + e1 + e2 + e3); }
            { const float mx = fmaxf(fmaxf(l0.y, l1.y), fmaxf(l2.y, l3.y)); const float e0 = __expf(l0.y - mx), e1 = __expf(l1.y - mx), e2 = __expf(l2.y - mx), e3 = __expf(l3.y - mx); lb1 = e1 / (e0 + e1 + e2 + e3); } }
        int vst[4];
#pragma unroll
        for (int i = 0; i < 4; ++i) vst[i] = att::v_st(vr + 16 * i, sc);
        unsigned hq_[SPT], hz_[SPT]; bf16x8 rv[4];
#define HG_LOAD(ch) do { _Pragma("unroll") for (int i = 0; i < SPT; ++i) { const int n = (ch) * 64 + part * SPT + i; const bf16* zr = Zv + (size_t)(row0 + HG_POS(n)) * 10240 + zc; hq_[i] = *(const unsigned*)zr; hz_[i] = *(const unsigned*)(zr + 2048 + dir * 2048); } \
        _Pragma("unroll") for (int i = 0; i < 4; ++i) rv[i] = *(const bf16x8*)(Zv + (size_t)(row0 + HG_POS((ch) * 64 + vr + 16 * i)) * 10240 + 6144 + hh * 128 + sc); } while (0)
        HG_LOAD(0);
        for (int s = -1; s < nchunk; ++s) {
            const bool work = s + 1 < nchunk; LAS unsigned char* B = lds + ((s + 1) & 1) * BUF;
            float run0[SPT], run1[SPT], kk0[SPT], kk1[SPT]; unsigned qraw[SPT];
            if (work) {
                float a0 = 0.f, a1 = 0.f;
#pragma unroll
                for (int i = 0; i < SPT; ++i) { const float z0 = bflo(hz_[i]), z1 = bfhi(hz_[i]);
                    const float s0 = __builtin_amdgcn_rcpf(1.f + __expf(-z0)), s1 = __builtin_amdgcn_rcpf(1.f + __expf(-z1));
                    const float f0 = lb0 + (1.f - lb0) * s0, f1 = lb1 + (1.f - lb1) * s1;
                    kk0[i] = (1.f - lb0) * (1.f - s0); kk1[i] = (1.f - lb1) * (1.f - s1);
                    a0 += __logf(f0); a1 += __logf(f1); run0[i] = a0; run1[i] = a1; qraw[i] = hq_[i]; }
                *(LAS f32x2*)(TOT + part * NK + 2 * kp) = (f32x2){a0, a1};
#pragma unroll
                for (int i = 0; i < 4; ++i) *(LAS bf16x8*)(B + O_VL + vst[i]) = rv[i];
            }
            __syncthreads();
            if (work) {
                float base0 = 0.f, base1 = 0.f, rr0 = 0.f, rr1 = 0.f, bl0 = 0.f, bl1 = 0.f;
#pragma unroll
                for (int q = 0; q < NPART; ++q) { const f32x2 t = *(const LAS f32x2*)(TOT + q * NK + 2 * kp); if (q < part) { base0 += t.x; base1 += t.y; } if (q < NPART / 2) { rr0 += t.x; rr1 += t.y; } bl0 += t.x; bl1 += t.y; }
                base0 -= rr0; base1 -= rr1;
                unsigned kw0[SPT / 2], kw1[SPT / 2];
#pragma unroll
                for (int i = 0; i < SPT; i += 2) {
                    const float d00 = fminf(fmaxf(base0 + run0[i], -60.f), 60.f), d01 = fminf(fmaxf(base1 + run1[i], -60.f), 60.f);
                    const float d10 = fminf(fmaxf(base0 + run0[i + 1], -60.f), 60.f), d11 = fminf(fmaxf(base1 + run1[i + 1], -60.f), 60.f);
                    const float ka0 = kk0[i] * __expf(-d00), ka1 = kk1[i] * __expf(-d01), kb0 = kk0[i + 1] * __expf(-d10), kb1 = kk1[i + 1] * __expf(-d11);
                    const int st = part * SPT + i;
                    *(LAS unsigned*)(B + st * QROW + kp * 4) = cvt_pk_bf16(bflo(qraw[i]) * __expf(d00), bfhi(qraw[i]) * __expf(d01));
                    *(LAS unsigned*)(B + (st + 1) * QROW + kp * 4) = cvt_pk_bf16(bflo(qraw[i + 1]) * __expf(d10), bfhi(qraw[i + 1]) * __expf(d11));
                    *(LAS unsigned*)(B + O_KT + st * QROW + kp * 4) = cvt_pk_bf16(ka0, ka1);
                    *(LAS unsigned*)(B + O_KT + (st + 1) * QROW + kp * 4) = cvt_pk_bf16(kb0, kb1);
                    kw0[i >> 1] = cvt_pk_bf16(ka0, kb0); kw1[i >> 1] = cvt_pk_bf16(ka1, kb1); }
#pragma unroll
                for (int i = 0; i < SPT / 8; ++i) {
                    *(LAS u32x4*)(B + O_KTT + (2 * kp) * 144 + part * SPT * 2 + 16 * i) = (u32x4){kw0[4 * i], kw0[4 * i + 1], kw0[4 * i + 2], kw0[4 * i + 3]};
                    *(LAS u32x4*)(B + O_KTT + (2 * kp + 1) * 144 + part * SPT * 2 + 16 * i) = (u32x4){kw1[4 * i], kw1[4 * i + 1], kw1[4 * i + 2], kw1[4 * i + 3]}; }
                if (part == 0) { LAS float* FAC = (LAS float*)(B + O_FAC);
                    *(LAS f32x2*)(FAC + 2 * kp) = (f32x2){__expf(rr0), __expf(rr1)}; *(LAS f32x2*)(FAC + NK + 2 * kp) = (f32x2){__expf(bl0), __expf(bl1)}; *(LAS f32x2*)(FAC + 2 * NK + 2 * kp) = (f32x2){__expf(bl0 - rr0), __expf(bl1 - rr1)}; }
                if (s + 2 < nchunk) HG_LOAD(s + 2);
            }
            __syncthreads();
        }
#undef HG_LOAD
    } else {
        const int vb = wave, r32 = lane & 31, hi = lane >> 5;
        const int olane = (dir ? 63 - 4 * hi : 4 * hi) * (D * 2) + r32 * 2;
        f32x16 St[NKB];
#pragma unroll
        for (int i = 0; i < NKB; ++i) St[i] = f32x16{};
#define HG_PK(L_, H_) (bf16x8){L_[0], L_[1], L_[2], L_[3], H_[0], H_[1], H_[2], H_[3]}
#define HG_PK4(P_, BASE_, OUT_) do { unsigned a0_ = cvt_pk_bf16(P_[BASE_ + 0], P_[BASE_ + 1]), a1_ = cvt_pk_bf16(P_[BASE_ + 2], P_[BASE_ + 3]); \
    unsigned b0_ = cvt_pk_bf16(P_[BASE_ + 4], P_[BASE_ + 5]), b1_ = cvt_pk_bf16(P_[BASE_ + 6], P_[BASE_ + 7]); \
    auto r0_ = __builtin_amdgcn_permlane32_swap(a0_, b0_, false, false); auto r1_ = __builtin_amdgcn_permlane32_swap(a1_, b1_, false, false); \
    u32x4 w_ = {r0_[0], r1_[0], r0_[1], r1_[1]}; OUT_ = *reinterpret_cast<bf16x8*>(&w_); } while (0)
        for (int s = -1; s < nchunk; ++s) {
            LAS unsigned char* QT = lds + (s & 1) * BUF; LAS unsigned char* KT = QT + O_KT; LAS unsigned char* KTT = QT + O_KTT; LAS float* FAC = (LAS float*)(QT + O_FAC);
            bf16x8 vf[4]; f32x16 od0 = f32x16{}, od1 = f32x16{};
            if (s >= 0) {
                const int vbase = (int)(uintptr_t)(lds_gen + (s & 1) * BUF + O_VL) + att::v_rd_base(lane) + vb * 512;
                { const s16x4 l0 = att::tr_read<att::v_rd_off(0, 0, 0)>(vbase), h0 = att::tr_read<att::v_rd_off(0, 0, 1)>(vbase), l1 = att::tr_read<att::v_rd_off(0, 1, 0)>(vbase), h1 = att::tr_read<att::v_rd_off(0, 1, 1)>(vbase);
                  const s16x4 l2 = att::tr_read<att::v_rd_off(0, 2, 0)>(vbase), h2 = att::tr_read<att::v_rd_off(0, 2, 1)>(vbase), l3 = att::tr_read<att::v_rd_off(0, 3, 0)>(vbase), h3 = att::tr_read<att::v_rd_off(0, 3, 1)>(vbase);
                  asm volatile("s_waitcnt lgkmcnt(0)" ::: "memory"); __builtin_amdgcn_sched_barrier(0);
                  vf[0] = HG_PK(l0, h0); vf[1] = HG_PK(l1, h1); vf[2] = HG_PK(l2, h2); vf[3] = HG_PK(l3, h3); }
                {
                    f32x16 p0 = f32x16{};
#pragma unroll
                    for (int d0 = 0; d0 < ND0; ++d0) { const int cb = (d0 * 16 + hi * 8) * 2;
                        const bf16x8 a = *(const LAS bf16x8*)(KT + r32 * QROW + cb), b = *(const LAS bf16x8*)(QT + r32 * QROW + cb);
                        p0 = __builtin_amdgcn_mfma_f32_32x32x16_bf16(a, b, p0, 0, 0, 0); }
#pragma unroll
                    for (int r = 0; r < 16; ++r) if (att::crow(r, hi) > r32) p0[r] = 0.f;
                    bf16x8 pa0, pa1; HG_PK4(p0, 0, pa0); HG_PK4(p0, 8, pa1);
                    od0 = __builtin_amdgcn_mfma_f32_32x32x16_bf16(pa0, vf[0], od0, 0, 0, 0); od0 = __builtin_amdgcn_mfma_f32_32x32x16_bf16(pa1, vf[1], od0, 0, 0, 0); }
                {
                    f32x16 p0 = f32x16{}, p1 = f32x16{};
#pragma unroll
                    for (int d0 = 0; d0 < ND0; ++d0) { const int cb = (d0 * 16 + hi * 8) * 2;
                        const bf16x8 a0_ = *(const LAS bf16x8*)(KT + r32 * QROW + cb), a1_ = *(const LAS bf16x8*)(KT + (32 + r32) * QROW + cb), b = *(const LAS bf16x8*)(QT + (32 + r32) * QROW + cb);
                        p0 = __builtin_amdgcn_mfma_f32_32x32x16_bf16(a0_, b, p0, 0, 0, 0); p1 = __builtin_amdgcn_mfma_f32_32x32x16_bf16(a1_, b, p1, 0, 0, 0); }
#pragma unroll
                    for (int r = 0; r < 16; ++r) if (att::crow(r, hi) > r32) p1[r] = 0.f;
                    bf16x8 pa0, pa1, pa2, pa3; HG_PK4(p0, 0, pa0); HG_PK4(p0, 8, pa1); HG_PK4(p1, 0, pa2); HG_PK4(p1, 8, pa3);
                    od1 = __builtin_amdgcn_mfma_f32_32x32x16_bf16(pa0, vf[0], od1, 0, 0, 0); od1 = __builtin_amdgcn_mfma_f32_32x32x16_bf16(pa1, vf[1], od1, 0, 0, 0);
                    od1 = __builtin_amdgcn_mfma_f32_32x32x16_bf16(pa2, vf[2], od1, 0, 0, 0); od1 = __builtin_amdgcn_mfma_f32_32x32x16_bf16(pa3, vf[3], od1, 0, 0, 0); }
            }
            __syncthreads();
            if (s >= 0) {
#pragma unroll
                for (int kb = 0; kb < NKB; ++kb) {
                    float er[16];
#pragma unroll
                    for (int m = 0; m < 4; ++m) { const f32x4 e4 = *(const LAS f32x4*)(FAC + 32 * kb + 8 * m + 4 * hi); er[4 * m] = e4[0]; er[4 * m + 1] = e4[1]; er[4 * m + 2] = e4[2]; er[4 * m + 3] = e4[3]; }
#pragma unroll
                    for (int s2 = 0; s2 < 2; ++s2) {
                        u32x4 bw;
#pragma unroll
                        for (int j = 0; j < 4; ++j) bw[j] = cvt_pk_bf16(St[kb][8 * s2 + 2 * j] * er[8 * s2 + 2 * j], St[kb][8 * s2 + 2 * j + 1] * er[8 * s2 + 2 * j + 1]);
                        const bf16x8 bfr = *reinterpret_cast<bf16x8*>(&bw);
                        const int ko = (32 * kb + 16 * s2 + 4 * hi) * 2;
                        const u32x2 x0 = *(const LAS u32x2*)(QT + r32 * QROW + ko), x1 = *(const LAS u32x2*)(QT + r32 * QROW + ko + 16);
                        const u32x2 y0 = *(const LAS u32x2*)(QT + (32 + r32) * QROW + ko), y1 = *(const LAS u32x2*)(QT + (32 + r32) * QROW + ko + 16);
                        u32x4 aw0 = {x0[0], x0[1], x1[0], x1[1]}, aw1 = {y0[0], y0[1], y1[0], y1[1]};
                        od0 = __builtin_amdgcn_mfma_f32_32x32x16_bf16(*reinterpret_cast<bf16x8*>(&aw0), bfr, od0, 0, 0, 0);
                        od1 = __builtin_amdgcn_mfma_f32_32x32x16_bf16(*reinterpret_cast<bf16x8*>(&aw1), bfr, od1, 0, 0, 0); } }
                {   unsigned char* Ob = (unsigned char*)(Oo + (size_t)(row0 + (dir ? L - 64 - s * 64 : s * 64)) * D + hh * 128 + 32 * vb);
#define HG_ST(SG_) do { _Pragma("unroll") for (int r = 0; r < 16; r += 2) { constexpr int c0 = 0; const int cr = (r & 3) + 8 * (r >> 2) + c0;     \
                        const unsigned w0 = cvt_pk_bf16(od0[r], od0[r + 1]), w1 = cvt_pk_bf16(od1[r], od1[r + 1]); \
                        *(unsigned short*)(Ob + (unsigned)(ol_ + (SG_) * cr * (D * 2))) = (unsigned short)(w0 & 0xffffu); *(unsigned short*)(Ob + (unsigned)(ol_ + (SG_) * (cr + 1) * (D * 2))) = (unsigned short)(w0 >> 16); \
                        *(unsigned short*)(Ob + (unsigned)(ol_ + (SG_) * (cr + 32) * (D * 2))) = (unsigned short)(w1 & 0xffffu); *(unsigned short*)(Ob + (unsigned)(ol_ + (SG_) * (cr + 33) * (D * 2))) = (unsigned short)(w1 >> 16); } } while (0)
                    int ol_ = olane; asm volatile("" : "+v"(ol_));
                    if (dir) HG_ST(-1); else HG_ST(1);
#undef HG_ST
                }
#pragma unroll
                for (int kb = 0; kb < NKB; ++kb) {
                    f32x16 U = f32x16{};
#pragma unroll
                    for (int ks = 0; ks < 4; ++ks) { const bf16x8 a = *(const LAS bf16x8*)(KTT + (32 * kb + r32) * 144 + (16 * ks + 8 * hi) * 2); U = __builtin_amdgcn_mfma_f32_32x32x16_bf16(a, vf[ks], U, 0, 0, 0); }
#pragma unroll
                    for (int m = 0; m < 4; ++m) { const f32x4 el = *(const LAS f32x4*)(FAC + NK + 32 * kb + 8 * m + 4 * hi), elr = *(const LAS f32x4*)(FAC + 2 * NK + 32 * kb + 8 * m + 4 * hi);
#pragma unroll
                        for (int e = 0; e < 4; ++e) St[kb][4 * m + e] = el[e] * St[kb][4 * m + e] + elr[e] * U[4 * m + e]; } }
            }
            __syncthreads();
        }
#undef HG_PK
#undef HG_PK4
    }
#undef HG_POS
    __syncthreads();
}

__device__ __forceinline__ void reduce_rstd(const float* __restrict__ ssp, float* __restrict__ rstd, int i0, int stride) {
    for (int row = i0; row < T; row += stride) { float s = 0.f;
#pragma unroll
        for (int j = 0; j < 8; ++j) { const float* p = ssp + (size_t)(4 * j) * T + row; s += (p[0] + p[T]) + (p[2 * (size_t)T] + p[3 * (size_t)T]); }
        rstd[row] = rsqrtf(s * (1.f / D) + EPS); }
}
struct Args { const float* in[28]; float* out; unsigned char* ws; int ph_lo, ph_hi, li, pad; };
constexpr int RING_BYTES = 131072, LDS_BYTES = 147456, MISC_OFF = LDS_BYTES - 128;

__host__ __device__ constexpr int n_phases() {
    int n = 1;
    for (int layer = 0; layer < 4; ++layer) {
        n += 1;
        if (layer == 0) n += 1;
        const int kind = layer % 3;
        if (kind == 0) n += 2 + 3 * 3 + 1;
        else if (kind == 1) n += 3 * 3 + 1;
        else n += 5;
        n += 3;
        n += 1 + 4;
    }
    return n;
}
constexpr int NPH = n_phases();

#define H      ((bf16*)X)
#define Xb     ((bf16*)(ws + LO(WS_H)))
#define rstd_  ((float*)(ws + LO(WS_RSTD)))
#define ssp_   ((float*)(ws + LO(WS_SSP)))
#define ropec  ((float*)(ws + LO(WS_ROPE)))
#define ropes  ((float*)(ws + LO(WS_ROPE)) + 4096 * 32)
#define mem_rs ((float*)(ws + LO(WS_MEMRS)))
#define mem_b  ((bf16*)(ws + LO(WS_MEMB)))
#define memkv  ((bf16*)(ws + LO(WS_MEMKV)))
#define w1t_(ly) ((bf16*)(ws + (((ly) & 1) ? LO(WS_W1B) : LO(WS_W1))))
#define w2t_(ly) ((bf16*)(ws + (((ly) & 1) ? LO(WS_W2B) : LO(WS_W2))))
#define rq     ((float*)(ws + LO(WS_SS0)))
#define rkv_   ((float*)(ws + LO(WS_SS0) + 262144))
#define P      ((bf16*)(ws + LO(S_P)))
#define Qv     ((bf16*)(ws + LO(S_QC)) - (size_t)c * CH * 3072)
#define KVv    ((bf16*)(ws + LO(S_KVC)) - (size_t)c * CH * 5120)
#define Zv     ((bf16*)(ws + LO(S_Z)) - (size_t)c * CH * 10240)
#define OFv    ((bf16*)(ws + LO(S_OF)) - (size_t)c * CH * D)
#define OBv    ((bf16*)(ws + LO(S_OB)) - (size_t)c * CH * D)
#define OP2v   ((bf16*)X + (size_t)T * D - (size_t)c * CH * D)
#define OP3v   ((bf16*)X + (size_t)T * D + (size_t)CH * D - (size_t)c * CH * D)
#define T1     ((bf16*)(ws + LO(S_T1)))
#define Qm     ((bf16*)(ws + LO(S_QM)))
#define Om     ((bf16*)(ws + LO(S_OM)))
#define Hv     ((bf16*)(ws + LO(S_HID) + (size_t)(c & 1) * 256 * MiB) - (size_t)c * CH * DFF)
__global__ void __launch_bounds__(NWAVES * 64, 2) fwd(Args args) {
    extern __shared__ __attribute__((aligned(16))) unsigned char lds_raw[];
    LAS unsigned char* lds = (LAS unsigned char*)lds_raw;
    const int G0_ = gridDim.x, bx0_ = blockIdx.x, wid0_ = __builtin_amdgcn_readfirstlane((int)(threadIdx.x >> 6));
    const int vcu0_ = (G0_ % 8 == 0) ? (bx0_ % 8) * (G0_ / 8) + bx0_ / 8 : bx0_;
    unsigned* ctl = (unsigned*)(args.ws + WS_CTL);
    volatile LAS unsigned* MISC = (volatile LAS unsigned*)(lds + MISC_OFF);
    if (threadIdx.x < 16) MISC[threadIdx.x] = 0u;
    __syncthreads();
    const int lo = args.ph_lo, hi = args.ph_hi;
    XcdBarrier bar; bar.bar = ctl + CW_BAR + args.li * XCD_BAR_WORDS; bar.x = 0; bar.st = MISC + 8; bar.w = wid0_;
    if (hi - lo > 1) { bar = xcd_barrier_post(ctl + CW_BAR + args.li * XCD_BAR_WORDS, MISC + 8); bar.w = wid0_; }
    int ph = 0;
#define PH_BEGIN(id) asm volatile("" : "+s"(ph)); if (ph >= lo && ph < hi) { if (PHMASK & (1ull << (id))) for (int rep_ = 0; rep_ < (((REPMASK >> (id)) & 1ull) ? 2 : 1); ++rep_) { if (rep_) __syncthreads(); const int G = launder_i(G0_), bx = launder_i(bx0_), vcu = launder_i(vcu0_), NGW = G * NWAVES; (void)bx; (void)NGW; const int wave = launder_i(wid0_), tid = opaque_tid(wave), lane = tid & 63, gw = vcu * NWAVES + wave; (void)lane; (void)gw; unsigned char* ws = launder_p(args.ws); float* X = (float*)launder_p((unsigned char*)args.out); (void)X;
#define PH_END   } if (ph + 1 < hi) { XcdBarrier b2_ = bar; b2_.bar = (unsigned*)launder_p((unsigned char*)bar.bar); xcd_barrier(b2_); } } ++ph;


    PH_BEGIN(0)
    {
        for (int m = gw; m < T; m += NGW) { const float* src_ = (m < TPR ? in_ptr(0) + (size_t)m * D : in_ptr(1) + (size_t)(m - TPR) * D);
            const f32x4* xr = (const f32x4*)src_ + lane; f32x4 v[8]; float s = 0.f;
#pragma unroll
            for (int j = 0; j < 8; ++j) { v[j] = xr[64 * j]; s += (v[j].x * v[j].x + v[j].y * v[j].y) + (v[j].z * v[j].z + v[j].w * v[j].w); }
            s = wave_sum(s, lane); if (lane == 0) rstd_[m] = rsqrtf(s * (1.f / D) + EPS);
            u32x2* o8 = (u32x2*)(Xb + (size_t)m * D) + lane;
#pragma unroll
            for (int j = 0; j < 8; ++j) { u32x2 w; w.x = cvt_pk_bf16(v[j].x, v[j].y); w.y = cvt_pk_bf16(v[j].z, v[j].w); o8[64 * j] = w; } }
        for (int i = bx * 512 + tid; i < 4096 * 32; i += G * 512) { const int p = i >> 5, k = i & 31; const float inv = 1.0f / powf(10000.0f, (float)(2 * k) / 64.0f); const float ang = (float)p * inv; float s, c; sincosf(ang, &s, &c); ropec[i] = c; ropes[i] = s; }
        { bf16* Dc = (bf16*)(ws + LO(WS_DC)); const float* g2 = in_ptr(4) + 2 * D;
          for (int i = bx * 512 + tid; i < 4 * 2 * 512 * 512; i += G * 512) { const int k = i & 511, cp = (i >> 9) & 511, part = (i >> 18) & 1, g = i >> 19; const int r = (cp * k) & 511; const float x = (float)r * (2.0f / 512.0f);
              const float v = (part ? sinpif(x) : cospif(x)) * g2[g * 512 + k]; Dc[i] = (bf16)(cvt_pk_bf16(v, 0.f) & 0xffffu); } }
        { bf16* DL = (bf16*)(ws + LO(WS_DL2)); for (int i = bx * 512 + tid; i < 2048 * 2048; i += G * 512) { const int k = i & 2047, lp = i >> 11; const int j = k & 1023; const int r = (lp * j) & 2047; const float x = (float)r * (2.0f / 2048.0f);
              const float v = (k < 1024) ? cospif(x) : -sinpif(x); DL[i] = (bf16)(cvt_pk_bf16(v, 0.f) & 0xffffu); } }
        { bf16* DL = (bf16*)(ws + LO(WS_DL4)); for (int i = bx * 512 + tid; i < 4096 * 4096; i += G * 512) { const int k = i & 4095, lp = i >> 12; const int j = k & 2047; const int r = (lp * j) & 4095; const float x = (float)r * (2.0f / 4096.0f);
              const float v = (k < 2048) ? cospif(x) : -sinpif(x); DL[i] = (bf16)(cvt_pk_bf16(v, 0.f) & 0xffffu); } }
        for (int m = gw; m < 4096; m += NGW) { const float* src = (m < 2048 ? in_ptr(2) + (size_t)m * D : in_ptr(3) + (size_t)(m - 2048) * D);
            const f32x4* xr = (const f32x4*)src + lane; f32x4 v[8]; float s = 0.f;
#pragma unroll
            for (int j = 0; j < 8; ++j) { v[j] = xr[64 * j]; s += (v[j].x * v[j].x + v[j].y * v[j].y) + (v[j].z * v[j].z + v[j].w * v[j].w); }
            s = wave_sum(s, lane); if (lane == 0) mem_rs[m] = rsqrtf(s * (1.f / D) + EPS);
            u32x2* o8 = (u32x2*)(mem_b + (size_t)m * D) + lane;
#pragma unroll
            for (int j = 0; j < 8; ++j) { u32x2 w; w.x = cvt_pk_bf16(v[j].x, v[j].y); w.y = cvt_pk_bf16(v[j].z, v[j].w); o8[64 * j] = w; } }
        { u32x4 z = {0u, 0u, 0u, 0u};
          for (int i = bx * 512 + tid; i < 2 * 192 * 2048 / 8; i += G * 512) { const int j = i / (192 * 2048 / 8), r = i % (192 * 2048 / 8); *(u32x4*)((bf16*)(ws + LO(WS_MLA_WIN)) + (size_t)j * 1280 * 2048 + (size_t)1088 * 2048 + (size_t)r * 8) = z; }
          for (int i = bx * 512 + tid; i < 2 * 16 * 64 * 512 / 8; i += G * 512) { const int j = i / (16 * 64 * 512 / 8), r = i % (16 * 64 * 512 / 8), hh = r / (64 * 512 / 8), q = r % (64 * 512 / 8);
              *(u32x4*)((bf16*)(ws + LO(WS_MLA_WKVB)) + (size_t)j * 5120 * 512 + (size_t)(hh * 320 + 128) * 512 + (size_t)q * 8) = z; } }
        LAS float* scr = (LAS float*)(lds + wave * 16384);
        {
            constexpr int I_WIN = 16 * 34, I_QB = 4 * 96, I_KVB = 4 * 128, I_WO = 16 * 64, I_HIN = 16 * 320, I_MQ = 16 * 16, I_MKV = 16 * 32, I_MO = 4 * 64;
            constexpr int NIT = 2 * I_WIN + 2 * I_QB + 2 * I_KVB + 2 * I_WO + I_HIN + I_WO + I_WO + 4 * I_MQ + 4 * I_MKV + 4 * I_MO;
            for (int it = gw; it < NIT; it += NGW) {
                int r = it;
                if (r < 2 * I_WIN) { const int j = r / I_WIN; transpose_item<0>(in_ptr(5) + (size_t)j * 2048 * 1088, 2048, 1088, (bf16*)(ws + LO(WS_MLA_WIN)) + (size_t)j * 1280 * 2048, in_ptr(4) + (3 * j) * D, scr, r % I_WIN, lane); continue; } r -= 2 * I_WIN;
                if (r < 2 * I_QB) { const int j = r / I_QB; transpose_item<0>(in_ptr(8) + (size_t)j * 512 * 3072, 512, 3072, (bf16*)(ws + LO(WS_MLA_WQB)) + (size_t)j * 3072 * 512, in_ptr(6) + j * 512, scr, r % I_QB, lane); continue; } r -= 2 * I_QB;
                if (r < 2 * I_KVB) { const int j = r / I_KVB; transpose_item<1>(in_ptr(9) + (size_t)j * 512 * 4096, 512, 4096, (bf16*)(ws + LO(WS_MLA_WKVB)) + (size_t)j * 5120 * 512, in_ptr(7) + j * 512, scr, r % I_KVB, lane); continue; } r -= 2 * I_KVB;
                if (r < 2 * I_WO) { const int j = r / I_WO; transpose_item<0>(in_ptr(12) + (size_t)j * 2048 * 2048, 2048, 2048, (bf16*)(ws + LO(WS_MLA_WO)) + (size_t)j * 2048 * 2048, nullptr, scr, r % I_WO, lane); continue; } r -= 2 * I_WO;
                if (r < I_HIN) { transpose_item<0>(in_ptr(13), 2048, 10240, (bf16*)(ws + LO(WS_HG_WIN)), in_ptr(4) + 1 * D, scr, r, lane); continue; } r -= I_HIN;
                if (r < I_WO) { transpose_item<0>(in_ptr(16), 2048, 2048, (bf16*)(ws + LO(WS_HG_WO)), nullptr, scr, r, lane); continue; } r -= I_WO;
                if (r < I_WO) { transpose_item<0>(in_ptr(17), 2048, 2048, (bf16*)(ws + LO(WS_FN_WO)), nullptr, scr, r, lane); continue; } r -= I_WO;
                if (r < 4 * I_MQ) { const int j = r / I_MQ; transpose_item<0>(in_ptr(20) + (size_t)j * 2048 * 512, 2048, 512, (bf16*)(ws + LO(WS_MEM_WQ)) + (size_t)j * 512 * 2048, in_ptr(18) + j * D, scr, r % I_MQ, lane); continue; } r -= 4 * I_MQ;
                if (r < 4 * I_MKV) { const int j = r / I_MKV; transpose_item<0>(in_ptr(21) + (size_t)j * 2048 * 1024, 2048, 1024, (bf16*)(ws + LO(WS_MEM_WKV)) + (size_t)j * 1024 * 2048, in_ptr(19) + j * 2048, scr, r % I_MKV, lane); continue; } r -= 4 * I_MKV;
                { const int j = r / I_MO; transpose_item<0>(in_ptr(24) + (size_t)j * 512 * 2048, 512, 2048, (bf16*)(ws + LO(WS_MEM_WO)) + (size_t)j * 2048 * 512, nullptr, scr, r % I_MO, lane); }
            }
        }
        __syncthreads();
    }
    PH_END

#pragma unroll 1
    for (int layer = 0; layer < 4; ++layer) {
        const int kind = layer % 3, jm = layer / 3;
        PH_BEGIN(1)
        {
            if (layer > 0) reduce_rstd(ssp_, rstd_, bx * 512 + tid, G * 512);
            if (layer == 0) {
                LAS float* scr = (LAS float*)(lds + wave * 16384);
                constexpr int I_1 = 16 * 256, I_2 = 64 * 64;
                for (int it = gw; it < I_1 + I_2; it += NGW) {
                    if (it < I_1) transpose_item<0>(in_ptr(26), D, DFF, w1t_(0), in_ptr(25), scr, it, lane);
                    else transpose_item<0>(in_ptr(27), DFF, D, w2t_(0), nullptr, scr, it - I_1, lane);
                }
                __syncthreads();
            }
            if (layer == 0) {
                pg8::TileOrder S; S.init(mem_b, D, ws + WS_MEM_WKV, D, 0, 16, 16, G, bx);
                pg8::EpiBf16<1, 0> E{memkv, 4096, mem_rs, 0, 1.f};
                pg8::gemm_phase(lds, D, D, D, S, E, wave);
            }
        }
        PH_END
        if (layer == 0) {
            PH_BEGIN(2)
            for (int m = gw; m < 4096; m += NGW) { const int ly = lane >> 4, hh = (lane >> 2) & 3, qq = lane & 3;
                bf16* p = memkv + (size_t)m * 4096 + ly * 1024 + hh * 128 + qq * 32; const float* g = in_ptr(23) + ly * 128 + qq * 32;
                u32x4 raw[4]; float x[32]; float s = 0.f;
#pragma unroll
                for (int j = 0; j < 4; ++j) { raw[j] = *(const u32x4*)(p + 8 * j);
#pragma unroll
                    for (int e = 0; e < 4; ++e) { x[8 * j + 2 * e] = bflo(raw[j][e]); x[8 * j + 2 * e + 1] = bfhi(raw[j][e]); } }
#pragma unroll
                for (int e = 0; e < 32; ++e) s += x[e] * x[e];
                s += shx(s, 1, lane); s += shx(s, 2, lane);
                const float r = rsqrtf(s * (1.f / 128.f) + EPS);
#pragma unroll
                for (int j = 0; j < 4; ++j) { u32x4 w;
#pragma unroll
                    for (int e = 0; e < 4; ++e) w[e] = cvt_pk_bf16(x[8 * j + 2 * e] * r * g[8 * j + 2 * e], x[8 * j + 2 * e + 1] * r * g[8 * j + 2 * e + 1]);
                    *(u32x4*)(p + 8 * j) = w; } }
            PH_END
        }

        if (kind == 0) {
            PH_BEGIN(3)
            {   pg8::TileOrder S; S.init(Xb, D, (bf16*)(ws + LO(WS_MLA_WIN)) + (size_t)jm * 1280 * 2048, D, 0, T / 256, 5, G, bx);
                pg8::EpiBf16<1, 0> E{P, 1280, rstd_, 0, 1.f};
                pg8::gemm_phase(lds, D, D, D, S, E, wave); }
            PH_END
            PH_BEGIN(24)
            for (int m = gw; m < T; m += NGW) {
                const u32x4 a = *(const u32x4*)(P + (size_t)m * 1280 + lane * 16), b = *(const u32x4*)(P + (size_t)m * 1280 + lane * 16 + 8); float q2 = 0.f;
#pragma unroll
                for (int e = 0; e < 4; ++e) { const float a0 = bflo(a[e]), a1 = bfhi(a[e]), b0 = bflo(b[e]), b1 = bfhi(b[e]); q2 += (a0 * a0 + a1 * a1) + (b0 * b0 + b1 * b1); }
#pragma unroll
                for (int o = 1; o < 32; o <<= 1) q2 += shx(q2, o, lane);
                const float rs_ = rsqrtf(q2 * (1.f / 512.f) + EPS);
                if (lane == 0) rq[m] = rs_; if (lane == 32) rkv_[m] = rs_; }
            PH_END
#pragma unroll 1
            for (int c = 0; c < 3; ++c) {
                PH_BEGIN(4)
                {   pg8::TileOrder S; S.init(P, 1280, (bf16*)(ws + LO(WS_MLA_WQB)) + (size_t)jm * 3072 * 512, 512, c * 64, 64, 12, G, bx);
                    pg8::EpiBf16<1, 0> E{Qv, 3072, rq, 0, 1.f};
                    pg8::gemm_phase(lds, 512, 1280, 512, S, E, wave); }
                {   pg8::TileOrder S; S.init(P + 512, 1280, (bf16*)(ws + LO(WS_MLA_WKVB)) + (size_t)jm * 5120 * 512, 512, c * 64, 64, 20, G, bx);
                    pg8::EpiBf16<1, 0> E{KVv, 5120, rkv_, 0, 1.f};
                    pg8::gemm_phase(lds, 512, 1280, 512, S, E, wave); }
                PH_END
                PH_BEGIN(5)
                {   const float* gk = in_ptr(11) + jm * 192; const int hh = lane >> 2, qq = lane & 3;
                    for (int m = c * CH + gw; m < (c + 1) * CH; m += NGW) {
                        const int pos = m < TPR ? (m & 2047) : ((m - TPR) & 4095);
                        bf16* kp = KVv + (size_t)m * 5120 + hh * 320; const bf16* pr = P + (size_t)m * 1280 + 1024;
                        u32x4 raw[4]; float x[32], x1[8], x2[8]; float s = 0.f;
#pragma unroll
                        for (int j = 0; j < 4; ++j) { raw[j] = *(const u32x4*)(kp + qq * 32 + 8 * j);
#pragma unroll
                            for (int e = 0; e < 4; ++e) { x[8 * j + 2 * e] = bflo(raw[j][e]); x[8 * j + 2 * e + 1] = bfhi(raw[j][e]); } }
                        { const u32x4 r1 = *(const u32x4*)(pr + qq * 8), r2 = *(const u32x4*)(pr + 32 + qq * 8);
#pragma unroll
                          for (int e = 0; e < 4; ++e) { x1[2 * e] = bflo(r1[e]); x1[2 * e + 1] = bfhi(r1[e]); x2[2 * e] = bflo(r2[e]); x2[2 * e + 1] = bfhi(r2[e]); } }
#pragma unroll
                        for (int e = 0; e < 32; ++e) s += x[e] * x[e];
#pragma unroll
                        for (int e = 0; e < 8; ++e) s += x1[e] * x1[e] + x2[e] * x2[e];
                        s += shx(s, 1, lane); s += shx(s, 2, lane);
                        const float r = rsqrtf(s * (1.f / 192.f) + EPS);
#pragma unroll
                        for (int j = 0; j < 4; ++j) { u32x4 w;
#pragma unroll
                            for (int e = 0; e < 4; ++e) w[e] = cvt_pk_bf16(x[8 * j + 2 * e] * r * gk[qq * 32 + 8 * j + 2 * e], x[8 * j + 2 * e + 1] * r * gk[qq * 32 + 8 * j + 2 * e + 1]);
                            *(u32x4*)(kp + qq * 32 + 8 * j) = w; }
                        float y1[8], y2[8];
#pragma unroll
                        for (int e = 0; e < 8; ++e) { const int i = qq * 8 + e; const float cc = ropec[pos * 32 + i], sn = ropes[pos * 32 + i];
                            const float a = x1[e] * r * gk[128 + i], b = x2[e] * r * gk[160 + i]; y1[e] = a * cc - b * sn; y2[e] = a * sn + b * cc; }
                        u32x4 w1, w2;
#pragma unroll
                        for (int e = 0; e < 4; ++e) { w1[e] = cvt_pk_bf16(y1[2 * e], y1[2 * e + 1]); w2[e] = cvt_pk_bf16(y2[2 * e], y2[2 * e + 1]); }
                        *(u32x4*)(kp + 128 + qq * 8) = w1; *(u32x4*)(kp + 160 + qq * 8) = w2;
                    } }
                PH_END
                PH_BEGIN(6)
                {   const int nqb = (c == 0) ? 8 : 16, nun = 1024;
                    for (int idx = vcu; idx < nun; idx += G) {
                        const int qb = idx % nqb, hh = (idx / nqb) & 15, sl = idx / (nqb * 16); const int s = (c == 0) ? sl : 8 + (c - 1) * 4 + sl;
                        const int row0 = seq_row0(s), L = seq_len(s);
                        att::attn_unit<192, true>(Qv + (size_t)(row0 + qb * 256) * 3072 + hh * 192, 3072, KVv + (size_t)row0 * 5120 + hh * 320, 5120, KVv + (size_t)row0 * 5120 + hh * 320 + 192, 5120,
                                                  H + (size_t)(row0 + qb * 256) * D + hh * 128, D, L, in_ptr(10) + jm * 192, ropec, ropes, qb * 256, 0.07216878364870322f, nullptr, (char*)lds_raw, wave);
                    } }
                PH_END
            }
            PH_BEGIN(7)
            {   pg8::TileOrder S; S.init(H, D, (bf16*)(ws + LO(WS_MLA_WO)) + (size_t)jm * 2048 * 2048, D, 0, T / 256, 8, G, bx);
                pg8::EpiResid<false> E{Xb, ssp_, nullptr};
                pg8::gemm_phase(lds, D, D, D, S, E, wave); }
            PH_END
        } else if (kind == 1) {
#pragma unroll 1
            for (int c = 0; c < 3; ++c) {
                PH_BEGIN(8)
                {   pg8::TileOrder S; S.init(Xb, D, ws + WS_HG_WIN, D, c * 64, 64, 40, G, bx);
                    pg8::EpiBf16<1, 0> E{Zv, 10240, rstd_, 0, 1.f};
                    pg8::gemm_phase(lds, D, D, D, S, E, wave); }
                PH_END
                PH_BEGIN(9)
                {
                    if (c == 0) {
                        for (int it = vcu; it < 256; it += G) { const int dir = it & 1, hh = (it >> 1) & 15, s = it >> 5;
                            hgrn_scan_item<128>(Zv, seq_row0(s), seq_len(s), hh, dir, 0, in_ptr(14), dir ? OBv : OFv, lds, lds_raw, tid, lane, wave); }
                    } else {
                        for (int it = vcu; it < 256; it += G) { const int kh = it & 1, dir = (it >> 1) & 1, hh = (it >> 2) & 15, s = 8 + (c - 1) * 4 + (it >> 6);
                            bf16* Oo = kh ? (dir ? OP3v : OP2v) : (dir ? OBv : OFv);
                            hgrn_scan_item<64>(Zv, seq_row0(s), seq_len(s), hh, dir, kh * 64, in_ptr(14), Oo, lds, lds_raw, tid, lane, wave); }
                    } }
                PH_END
                PH_BEGIN(10)
                {   const float* go = in_ptr(15) + (lane & 3) * 32;
                    for (int m = c * CH + gw; m < (c + 1) * CH; m += NGW) {
                        const bf16* pf = OFv + (size_t)m * D + lane * 32; const bf16* pb = OBv + (size_t)m * D + lane * 32; const bf16* pg = Zv + (size_t)m * 10240 + 8192 + lane * 32;
                        const bf16* p2 = OP2v + (size_t)m * D + lane * 32; const bf16* p3 = OP3v + (size_t)m * D + lane * 32;
                        float x[32]; float s = 0.f;
#pragma unroll
                        for (int j = 0; j < 4; ++j) { const u32x4 a = *(const u32x4*)(pf + 8 * j), b = *(const u32x4*)(pb + 8 * j);
#pragma unroll
                            for (int e = 0; e < 4; ++e) { x[8 * j + 2 * e] = bflo(a[e]) + bflo(b[e]); x[8 * j + 2 * e + 1] = bfhi(a[e]) + bfhi(b[e]); }
                            if (c > 0) { const u32x4 a2 = *(const u32x4*)(p2 + 8 * j), b2 = *(const u32x4*)(p3 + 8 * j);
#pragma unroll
                                for (int e = 0; e < 4; ++e) { x[8 * j + 2 * e] += bflo(a2[e]) + bflo(b2[e]); x[8 * j + 2 * e + 1] += bfhi(a2[e]) + bfhi(b2[e]); } } }
#pragma unroll
                        for (int e = 0; e < 32; ++e) s += x[e] * x[e];
                        s += shx(s, 1, lane); s += shx(s, 2, lane);
                        const float r = rsqrtf(s * (1.f / 128.f) + EPS);
#pragma unroll
                        for (int j = 0; j < 4; ++j) { const u32x4 gr = *(const u32x4*)(pg + 8 * j); u32x4 w;
#pragma unroll
                            for (int e = 0; e < 4; ++e) { const float g0 = bflo(gr[e]), g1 = bfhi(gr[e]); const float s0 = g0 / (1.f + __expf(-g0)), s1 = g1 / (1.f + __expf(-g1));
                                w[e] = cvt_pk_bf16(x[8 * j + 2 * e] * r * go[8 * j + 2 * e] * s0, x[8 * j + 2 * e + 1] * r * go[8 * j + 2 * e + 1] * s1); }
                            *(u32x4*)(H + (size_t)m * D + lane * 32 + 8 * j) = w; } } }
                PH_END
            }
            PH_BEGIN(11)
            {   pg8::TileOrder S; S.init(H, D, ws + WS_HG_WO, D, 0, T / 256, 8, G, bx);
                pg8::EpiResid<false> E{Xb, ssp_, nullptr};
                pg8::gemm_phase(lds, D, D, D, S, E, wave); }
            PH_END
        } else {
            struct F1Order { const char* Dc; const char* HEb; const char* HOb; int G, c, smp;
                __device__ __forceinline__ bool next(int i, pg8::Unit& u) const {
                    const int idx = i * G + c; const int npn = smp ? 8 : 4, per = 16 * npn; if (idx >= 8 * per) return false;
                    const int s = (smp ? 8 : 0) + idx / per, rem = idx % per; const int g = rem / (4 * npn), part = (rem / (2 * npn)) & 1, pn = (rem % (2 * npn)) / 2, pm = rem & 1;
                    const int row0 = seq_row0(s), L = seq_len(s);
                    u.pm = pm; u.pn = pn; u.a = Dc + ((size_t)((g * 2 + part) * 512 + pm * 256) * 512) * 2; u.b = (part ? HOb : HEb) + ((size_t)(row0 / 2 + pn * 256) * D + g * 512) * 2;
                    u.ooff = (long)row0 * D + (long)g * 512 * L + (long)part * (L / 2); u.aoff = 0; u.roff = 0; return true; } };
            struct F2Order { const char* DL; const char* T1b; int G, c, smp, half;
                __device__ __forceinline__ bool next(int i, pg8::Unit& u) const {
                    const int idx = i * G + c; const int L = smp ? 4096 : 2048, npm = L / 512; if (idx >= npm * 64) return false;
                    const int pm = idx / 64, sgp = idx % 64; const int s = (smp ? 8 : 0) + sgp / 8, g = (sgp % 8) / 2, pn = sgp % 2; const int row0 = seq_row0(s);
                    u.pm = pm; u.pn = pn; u.a = DL + ((size_t)pm * 256 * L + half * (L / 2)) * 2; u.b = T1b + ((size_t)row0 * D + (size_t)g * 512 * L + (size_t)pn * 256 * L + half * (L / 2)) * 2;
                    u.aoff = (long)(row0 / 2) * D + (long)g * (L / 2) * 512; u.ooff = half ? (long)row0 * D + g * 512 : u.aoff; u.roff = s * D + g * 512; return true; } };
            PH_BEGIN(22)
            {
                bf16* HE = (bf16*)(ws + LO(S_HE)); bf16* HO = (bf16*)(ws + LO(S_HO)); float* xcm = (float*)(ws + LO(WS_XCMID));
                for (int m = gw; m < T / 2; m += NGW) {
                    const int s = m < 8192 ? m / 1024 : 8 + (m - 8192) / 2048; const int row0 = seq_row0(s), L = seq_len(s), j = m - row0 / 2;
                    const bf16* pa = Xb + (size_t)(row0 + j) * D + lane * 32; const bf16* pb = Xb + (size_t)(row0 + (j ? L - j : 0)) * D + lane * 32;
                    const float ra = rstd_[row0 + j], rb = j ? rstd_[row0 + L - j] : 0.f;
#pragma unroll
                    for (int q = 0; q < 4; ++q) { const u32x4 a = *(const u32x4*)(pa + 8 * q), b = *(const u32x4*)(pb + 8 * q); u32x4 we, wo;
#pragma unroll
                        for (int e = 0; e < 4; ++e) { const float a0 = bflo(a[e]) * ra, a1 = bfhi(a[e]) * ra, b0 = bflo(b[e]) * rb, b1 = bfhi(b[e]) * rb; we[e] = cvt_pk_bf16(a0 + b0, a1 + b1); wo[e] = j ? cvt_pk_bf16(a0 - b0, a1 - b1) : 0u; }
                        *(u32x4*)(HE + (size_t)m * D + lane * 32 + 8 * q) = we; *(u32x4*)(HO + (size_t)m * D + lane * 32 + 8 * q) = wo; } }
                const bf16* Dcc = (const bf16*)(ws + LO(WS_DC));
                for (int t = gw; t < 16 * D; t += NGW) { const int s = t >> 11, col = t & 2047, g = col >> 9, cp = col & 511; const int mid = seq_row0(s) + seq_len(s) / 2;
                    const u32x4 dv = *(const u32x4*)(Dcc + ((size_t)(g * 2) * 512 + cp) * 512 + lane * 8), xv = *(const u32x4*)(Xb + (size_t)mid * D + g * 512 + lane * 8); float a = 0.f;
#pragma unroll
                    for (int e = 0; e < 4; ++e) a += bflo(dv[e]) * bflo(xv[e]) + bfhi(dv[e]) * bfhi(xv[e]);
                    a = wave_sum(a, lane); if (lane == 0) xcm[t] = a * rstd_[mid]; } }
            PH_END
            PH_BEGIN(12)
            {   F1Order S{(const char*)(ws + LO(WS_DC)), (const char*)(ws + LO(S_HE)), (const char*)(ws + LO(S_HO)), G, bx, 1}; pg8::EpiBf16<0, 0> E{T1, 4096, nullptr, 0, 1.f};
                pg8::gemm_phase(lds, 512, 512, D, S, E, wave); }
            {   F1Order S{(const char*)(ws + LO(WS_DC)), (const char*)(ws + LO(S_HE)), (const char*)(ws + LO(S_HO)), G, bx, 0}; pg8::EpiBf16<0, 0> E{T1, 2048, nullptr, 0, 1.f};
                pg8::gemm_phase(lds, 512, 512, D, S, E, wave); }
            PH_END
            PH_BEGIN(13)
            {   F2Order S{(const char*)(ws + LO(WS_DL4)), (const char*)T1, G, bx, 1, 0}; pg8::EpiBf16<0, 0> E{(bf16*)(ws + LO(S_HE)), 512, nullptr, 0, 1.f};
                pg8::gemm_phase(lds, 2048, 4096, 4096, S, E, wave); }
            {   F2Order S{(const char*)(ws + LO(WS_DL2)), (const char*)T1, G, bx, 0, 0}; pg8::EpiBf16<0, 0> E{(bf16*)(ws + LO(S_HE)), 512, nullptr, 0, 1.f};
                pg8::gemm_phase(lds, 1024, 2048, 2048, S, E, wave); }
            PH_END
            PH_BEGIN(23)
            {   F2Order S{(const char*)(ws + LO(WS_DL4)), (const char*)T1, G, bx, 1, 1}; pg8::EpiFnetSym E{H, (const bf16*)(ws + LO(S_HE)), (const float*)(ws + LO(WS_XCMID)), 4096, 6.905339660024878e-4f};
                pg8::gemm_phase(lds, 2048, 4096, 4096, S, E, wave); }
            {   F2Order S{(const char*)(ws + LO(WS_DL2)), (const char*)T1, G, bx, 0, 1}; pg8::EpiFnetSym E{H, (const bf16*)(ws + LO(S_HE)), (const float*)(ws + LO(WS_XCMID)), 2048, 9.765625e-4f};
                pg8::gemm_phase(lds, 1024, 2048, 2048, S, E, wave); }
            {
                const float* xcm = (const float*)(ws + LO(WS_XCMID));
                for (int t = gw; t < 16 * D; t += NGW) { const int s = t >> 11, col = t & 2047, g = col >> 9, cp = col & 511; const int row0 = seq_row0(s), L = seq_len(s);
                    const bf16* tp = T1 + (size_t)row0 * D + (size_t)g * 512 * L + (size_t)cp * L; float a = 0.f;
                    for (int j0 = lane * 8; j0 < L / 2; j0 += 512) { const u32x4 v = *(const u32x4*)(tp + j0);
#pragma unroll
                        for (int e = 0; e < 4; ++e) a += bflo(v[e]) - bfhi(v[e]); }
                    a = wave_sum(a, lane);
                    if (lane == 0) H[(size_t)(row0 + L / 2) * D + col] = (bf16)(cvt_pk_bf16((a + xcm[t]) * (L == 4096 ? 6.905339660024878e-4f : 9.765625e-4f), 0.f) & 0xffffu); } }
            PH_END
            PH_BEGIN(14)
            {   pg8::TileOrder S; S.init(H, D, ws + WS_FN_WO, D, 0, T / 256, 8, G, bx);
                pg8::EpiResid<false> E{Xb, ssp_, nullptr};
                pg8::gemm_phase(lds, D, D, D, S, E, wave); }
            PH_END
        }

        {
            PH_BEGIN(16)
            {   pg8::TileOrder S; S.init(Xb, D, (bf16*)(ws + LO(WS_MEM_WQ)) + (size_t)layer * 512 * 2048, D, 0, T / 256, 2, G, bx);
                pg8::EpiBf16<3, 0> E{Qm, 512, ssp_, 0, 1.f};
                pg8::gemm_phase(lds, D, D, D, S, E, wave);
                const int nidle = 2 * G - 384, ncv = (nidle > 0 && nidle < G) ? nidle : G, cv0 = G - ncv;
                if (layer < 3 && bx >= cv0) {
                    LAS float* scr = (LAS float*)(lds + wave * 16384);
                    constexpr int I_1 = 16 * 256, I_2 = 64 * 64;
                    for (int it = (bx - cv0) * NWAVES + wave; it < I_1 + I_2; it += ncv * NWAVES) {
                        if (it < I_1) transpose_item<0>(in_ptr(26) + (size_t)(layer + 1) * D * DFF, D, DFF, w1t_(layer + 1), in_ptr(25) + (layer + 1) * D, scr, it, lane);
                        else transpose_item<0>(in_ptr(27) + (size_t)(layer + 1) * DFF * D, DFF, D, w2t_(layer + 1), nullptr, scr, it - I_1, lane);
                    }
                    __syncthreads();
                } }
            PH_END
            PH_BEGIN(17)
            for (int idx = vcu; idx < 768; idx += G) {
                const int hh = idx & 3, rb = idx >> 2; const int s = rb < 64 ? rb / 8 : 8 + (rb - 64) / 16;
                const bf16* kp = memkv + (size_t)(s * 256) * 4096 + layer * 1024 + hh * 128;
                att::attn_unit<128, false>(Qm + (size_t)rb * 256 * 512 + hh * 128, 512, kp, 4096, kp + 512, 4096, Om + (size_t)rb * 256 * 512 + hh * 128, 512, 256,
                                           in_ptr(22) + layer * 128, nullptr, nullptr, 0, 0.08838834764831845f, nullptr, (char*)lds_raw, wave);
            }
            PH_END
            PH_BEGIN(18)
            {   pg8::TileOrder S; S.init(Om, 512, (bf16*)(ws + LO(WS_MEM_WO)) + (size_t)layer * 2048 * 512, 512, 0, T / 256, 8, G, bx);
                pg8::EpiResid<false> E{Xb, ssp_, nullptr};
                pg8::gemm_phase(lds, 512, 512, 512, S, E, wave); }
            PH_END
        }
        {
            PH_BEGIN(19)
            reduce_rstd(ssp_, rstd_, bx * 512 + tid, G * 512);
            PH_END
#pragma unroll 1
            for (int cc = 0; cc < 4; ++cc) {
                PH_BEGIN(20)
                if (cc > 0) { const int c = cc - 1;
                    pg8::TileOrder S; S.init(Hv, DFF, w2t_(layer), DFF, c * 64, 64, 8, G, bx);
                    if (layer == 3) { pg8::EpiResid<true> E{Xb, nullptr, X}; pg8::gemm_phase(lds, DFF, DFF, DFF, S, E, wave); }
                    else { pg8::EpiResid<false> E{Xb, ssp_, nullptr}; pg8::gemm_phase(lds, DFF, DFF, DFF, S, E, wave); } }
                if (cc < 3) { const int c = cc;
                    pg8::TileOrder S; S.init(Xb, D, w1t_(layer), D, c * 64, 64, 32, G, bx);
                    pg8::EpiBf16<1, 1> E{Hv, DFF, rstd_, 0, 1.f};
                    pg8::gemm_phase(lds, D, D, D, S, E, wave); }
                PH_END
            }
        }
    }
#undef PH_BEGIN
#undef PH_END
}

extern "C" void kernel_launch(void* const* d_in, const int* in_sizes, int n_in, void* d_out, int out_size, void* d_ws, size_t ws_size, hipStream_t stream) {
    static int grid = 0;
    if (grid == 0) {
        if (n_in != 28 || out_size != T * D || ws_size < WS_END) { fprintf(stderr, "kernel_launch: unexpected shapes (n_in %d out %d ws %zu)\n", n_in, out_size, ws_size); grid = -1; return; }
        int dev = 0, cus = 0, per_cu = 0;
        if (hipGetDevice(&dev) != hipSuccess || hipDeviceGetAttribute(&cus, hipDeviceAttributeMultiprocessorCount, dev) != hipSuccess) { grid = -1; return; }
        if (hipFuncSetAttribute((const void*)fwd, hipFuncAttributeMaxDynamicSharedMemorySize, LDS_BYTES) != hipSuccess) { fprintf(stderr, "kernel_launch: hipFuncSetAttribute failed\n"); grid = -1; return; }
        if (hipOccupancyMaxActiveBlocksPerMultiprocessor(&per_cu, (const void*)fwd, NWAVES * 64, LDS_BYTES) != hipSuccess || per_cu < 1) fprintf(stderr, "kernel_launch: occupancy query says %d\n", per_cu);
        (void)hipGetLastError();
        grid = cus;
    }
    if (grid < 0) return;
    (void)hipMemsetAsync((char*)d_ws + WS_CTL, 0, CTL_BYTES, stream);
    Args a{};
    for (int i = 0; i < 28; ++i) a.in[i] = (const float*)d_in[i];
    a.out = (float*)d_out; a.ws = (unsigned char*)d_ws; a.pad = 0;
#if N_LAUNCH_MODE == 0
    a.ph_lo = 0; a.ph_hi = NPH; a.li = 0;
    hipLaunchKernelGGL(fwd, dim3(grid), dim3(NWAVES * 64), LDS_BYTES, stream, a);
#else
    for (int p = 0; p < NPH; ++p) { a.ph_lo = p; a.ph_hi = p + 1; a.li = 0; hipLaunchKernelGGL(fwd, dim3(grid), dim3(NWAVES * 64), LDS_BYTES, stream, a); }
#endif
    const hipError_t le = hipPeekAtLastError();
    if (le != hipSuccess) fprintf(stderr, "kernel_launch: launch failed: %s\n", hipGetErrorName(le));
}
```
